# Optimizing an MI355X kernel written in HIP

```python
import jax, jax.numpy as jnp
from jax import lax
import numpy as np

D_MODEL = 1024
BATCH = 4
SEQ = 8192
DEPTH = 4

GRID_W = 64
CTX_LEN = 256
EPS = 1e-6
ROPE_THETA = 10000.0
Q_BLOCK = 128
N_MOD = 6

CHUNK = 128
A_GROUPS = 4
A_WIDTH = 512
A_HEAD = A_WIDTH // A_GROUPS
B_WIDTH = 512
POOL_WINDOWS = (2, 4, 8, 16)
B_GROUP = B_WIDTH // len(POOL_WINDOWS)
AB_IN = 2 * A_WIDTH + B_WIDTH
AB_OUT = A_WIDTH + B_WIDTH

HEAD_DIM = 64
C_HEADS = 8
C_KV_HEADS = 2
C_Q = C_HEADS * HEAD_DIM
C_KV = C_KV_HEADS * HEAD_DIM
D_HEADS = 8
D_NOPE = 64
D_ROPE = 32
D_V = 64
Q_RANK = 384
KV_RANK = 256
OFF_KC = C_Q
OFF_VC = OFF_KC + C_KV
OFF_CQ = OFF_VC + C_KV
OFF_CKV = OFF_CQ + Q_RANK
OFF_KR = OFF_CKV + KV_RANK
CD_IN = OFF_KR + D_ROPE
CD_OUT = C_HEADS * HEAD_DIM + D_HEADS * D_V

D_FF = 2816
N_EXPERTS = 8
TOP_K = 2
D_FF_EXPERT = 2816

kernel_name = "hybrid_diffusion_prefix_trunk"


def rmsnorm(x, gain=None):
    xf = x.astype(jnp.float32)
    y = xf * lax.rsqrt(jnp.mean(xf * xf, axis=-1, keepdims=True) + EPS)
    if gain is not None:
        y = y * gain.astype(jnp.float32)
    return y.astype(x.dtype)


def modulate(x, shift, scale):
    return rmsnorm(x) * (1 + scale) + shift


def adaln(cvec, w, b):
    m = jax.nn.silu(cvec) @ w + b
    return tuple(jnp.split(m[:, None, :], N_MOD, axis=-1))


def axial_rope(length, rot_dim):
    rows = length // GRID_W
    row = jnp.repeat(jnp.arange(rows), GRID_W).astype(jnp.float32)
    col = jnp.tile(jnp.arange(GRID_W), rows).astype(jnp.float32)
    axis_dim = rot_dim // 2
    inv = ROPE_THETA ** (-jnp.arange(0, axis_dim, 2, dtype=jnp.float32) / axis_dim)
    ang = jnp.concatenate([row[:, None] * inv, col[:, None] * inv], axis=-1)
    return jnp.cos(ang), jnp.sin(ang)


def apply_rope(x, cos, sin):
    half = x.shape[-1] // 2
    shape = (1, x.shape[1]) + (1,) * (x.ndim - 3) + (half,)
    c = cos.reshape(shape).astype(x.dtype)
    s = sin.reshape(shape).astype(x.dtype)
    x1, x2 = x[..., :half], x[..., half:]
    return jnp.concatenate([x1 * c - x2 * s, x1 * s + x2 * c], axis=-1)


def block_attention(q, k, v, scale):
    b, lq, hkv, g, dk = q.shape
    nb = lq // Q_BLOCK
    qb = q.reshape(b, nb, Q_BLOCK, hkv, g, dk).transpose(1, 0, 2, 3, 4, 5)

    def one_block(qblk):
        s = jnp.einsum('bqhgd,bkhd->bhgqk', qblk, k, preferred_element_type=jnp.float32) * scale
        p = jax.nn.softmax(s, axis=-1).astype(v.dtype)
        return jnp.einsum('bhgqk,bkhd->bqhgd', p, v)

    o = lax.map(one_block, qb)
    return o.transpose(1, 0, 2, 3, 4, 5).reshape(b, lq, -1)


def chunk_gmlp(a, v_gain, w_s, b_s):
    u, v = a[..., :A_WIDTH], a[..., A_WIDTH:]
    v = rmsnorm(v, v_gain)
    b, l, _ = v.shape
    vc = v.reshape(b, l // CHUNK, CHUNK, A_GROUPS, A_HEAD)
    s = jnp.einsum('gpq,bcqgd->bcpgd', w_s, vc) + b_s.T[:, :, None]
    return u * s.reshape(b, l, A_WIDTH)


def multiscale_pool(z, w_pool, scale):
    b, l, _ = z.shape
    zf = z.astype(jnp.float32)
    cs = jnp.concatenate([jnp.zeros((b, 1, B_WIDTH), jnp.float32), jnp.cumsum(zf, axis=1)], axis=1)
    pos = jnp.arange(l)
    outs = []
    for g, w in enumerate(POOL_WINDOWS):
        lo = jnp.clip(pos - w // 2, 0, l)
        hi = jnp.clip(pos - w // 2 + w, 0, l)
        sl = slice(g * B_GROUP, (g + 1) * B_GROUP)
        csg = cs[..., sl]
        mean = (jnp.take(csg, hi, axis=1) - jnp.take(csg, lo, axis=1)) / (hi - lo).astype(jnp.float32)[None, :, None]
        outs.append((mean - zf[..., sl]).astype(z.dtype))
    pooled = jnp.stack(outs, axis=2)
    y = jnp.einsum('blgi,gio->blgo', pooled, w_pool).reshape(b, l, B_WIDTH)
    return y * scale


def ab_mixer(h, w_in, v_gain, w_s, b_s, w_pool, p_scale, w_out):
    z = h @ w_in
    ya = chunk_gmlp(jax.nn.gelu(z[..., :2 * A_WIDTH], approximate=False), v_gain, w_s, b_s)
    yb = multiscale_pool(z[..., 2 * A_WIDTH:], w_pool, p_scale)
    return jnp.concatenate([ya, yb], axis=-1) @ w_out


def cd_queries(z, q_gain, cq_gain, w_uq, rope_c, rope_d):
    b, l, _ = z.shape
    qc = rmsnorm(z[..., :OFF_KC].reshape(b, l, C_HEADS, HEAD_DIM), q_gain)
    qd = (rmsnorm(z[..., OFF_CQ:OFF_CKV], cq_gain) @ w_uq).reshape(b, l, D_HEADS, D_NOPE + D_ROPE)
    q_nope, q_rope = qd[..., :D_NOPE], qd[..., D_NOPE:]
    if rope_c is not None:
        qc = apply_rope(qc, *rope_c)
        q_rope = apply_rope(q_rope, *rope_d)
    qc = qc.reshape(b, l, C_KV_HEADS, C_HEADS // C_KV_HEADS, HEAD_DIM)
    qd = jnp.concatenate([q_nope, q_rope], axis=-1)[:, :, :, None, :]
    return qc, qd


def cd_keys(z, k_gain, ckv_gain, w_ukv, rope_c, rope_d):
    b, l, _ = z.shape
    kc = rmsnorm(z[..., OFF_KC:OFF_VC].reshape(b, l, C_KV_HEADS, HEAD_DIM), k_gain)
    vc = z[..., OFF_VC:OFF_CQ].reshape(b, l, C_KV_HEADS, HEAD_DIM)
    kv = (rmsnorm(z[..., OFF_CKV:OFF_KR], ckv_gain) @ w_ukv).reshape(b, l, D_HEADS, D_NOPE + D_V)
    kr = z[..., OFF_KR:][:, :, None, :]
    if rope_c is not None:
        kc = apply_rope(kc, *rope_c)
        kr = apply_rope(kr, *rope_d)
    kd = jnp.concatenate([kv[..., :D_NOPE], jnp.broadcast_to(kr, (b, l, D_HEADS, D_ROPE))], axis=-1)
    vd = kv[..., D_NOPE:]
    return kc, vc, kd, vd


def cd_attend(qc, qd, kc, vc, kd, vd, w_out):
    oc = block_attention(qc, kc, vc, HEAD_DIM ** -0.5)
    od = block_attention(qd, kd, vd, (D_NOPE + D_ROPE) ** -0.5)
    return jnp.concatenate([oc, od], axis=-1) @ w_out


def swiglu(h, w_gate, w_up, w_down):
    return (jax.nn.silu(h @ w_gate) * (h @ w_up)) @ w_down


def moe_swiglu(h, router, w_gate, w_up, w_down):
    b, l, d = h.shape
    hf = h.reshape(-1, d)
    logits = (hf @ router).astype(jnp.float32)
    top_v, top_i = lax.top_k(logits, TOP_K)
    top_w = jax.nn.softmax(top_v, axis=-1)
    gates = jnp.sum(jax.nn.one_hot(top_i, N_EXPERTS, dtype=jnp.float32) * top_w[..., None], axis=1).astype(h.dtype)
    y = jnp.zeros_like(hf)
    for e in range(N_EXPERTS):
        y = y + gates[:, e:e + 1] * swiglu(hf, w_gate[e], w_up[e], w_down[e])
    return y.reshape(b, l, d)


def setup_inputs(seed: int = 0) -> dict:
    key = jax.random.key(seed)
    ks = iter(jax.random.split(key, 32))
    n_even = (DEPTH + 1) // 2
    n_odd = DEPTH // 2
    D = D_MODEL

    def nrm(shape, scale):
        return scale * jax.random.normal(next(ks), shape, jnp.float32)

    def gain(shape):
        return 1.0 + 0.1 * jax.random.normal(next(ks), shape, jnp.float32)

    return {
        "x": nrm((BATCH, SEQ, D), 1.0),
        "c": nrm((BATCH, D), 1.0),
        "ctx": nrm((BATCH, CTX_LEN, D), 1.0),
        "c_ctx": nrm((D,), 1.0),
        "ada_w": nrm((DEPTH, D, N_MOD * D), D ** -0.5),
        "ada_b": nrm((DEPTH, N_MOD * D), 0.02),
        "ab_w_in": nrm((n_even, D, AB_IN), D ** -0.5),
        "a_v_gain": gain((n_even, A_WIDTH)),
        "a_w_s": nrm((n_even, A_GROUPS, CHUNK, CHUNK), CHUNK ** -0.5),
        "a_b_s": gain((n_even, A_GROUPS, CHUNK)),
        "b_w_pool": nrm((n_even, len(POOL_WINDOWS), B_GROUP, B_GROUP), B_GROUP ** -0.5),
        "b_scale": gain((n_even, B_WIDTH)),
        "ab_w_out": nrm((n_even, AB_OUT, D), AB_OUT ** -0.5),
        "ffn_w_gate": nrm((n_even, D, D_FF), D ** -0.5),
        "ffn_w_up": nrm((n_even, D, D_FF), D ** -0.5),
        "ffn_w_down": nrm((n_even, D_FF, D), D_FF ** -0.5),
        "cd_w_in": nrm((n_odd, D, CD_IN), D ** -0.5),
        "c_q_gain": gain((n_odd, HEAD_DIM)),
        "c_k_gain": gain((n_odd, HEAD_DIM)),
        "d_cq_gain": gain((n_odd, Q_RANK)),
        "d_ckv_gain": gain((n_odd, KV_RANK)),
        "d_w_uq": nrm((n_odd, Q_RANK, D_HEADS * (D_NOPE + D_ROPE)), Q_RANK ** -0.5),
        "d_w_ukv": nrm((n_odd, KV_RANK, D_HEADS * (D_NOPE + D_V)), KV_RANK ** -0.5),
        "cd_w_out": nrm((n_odd, CD_OUT, D), CD_OUT ** -0.5),
        "moe_router": nrm((n_odd, D, N_EXPERTS), D ** -0.5),
        "moe_w_gate": nrm((n_odd, N_EXPERTS, D, D_FF_EXPERT), D ** -0.5),
        "moe_w_up": nrm((n_odd, N_EXPERTS, D, D_FF_EXPERT), D ** -0.5),
        "moe_w_down": nrm((n_odd, N_EXPERTS, D_FF_EXPERT, D), D_FF_EXPERT ** -0.5),
        "final_gain": gain((D,)),
    }


def reference(x, c, ctx, c_ctx, ada_w, ada_b, ab_w_in, a_v_gain, a_w_s, a_b_s, b_w_pool, b_scale, ab_w_out,
              ffn_w_gate, ffn_w_up, ffn_w_down, cd_w_in, c_q_gain, c_k_gain, d_cq_gain, d_ckv_gain, d_w_uq,
              d_w_ukv, cd_w_out, moe_router, moe_w_gate, moe_w_up, moe_w_down, final_gain):
    seq = x.shape[1]
    rope_c = axial_rope(seq, HEAD_DIM)
    rope_d = axial_rope(seq, D_ROPE)
    t = ctx
    ctx_len = ctx.shape[1]

    def cat(a, b):
        return jnp.concatenate([a, b], axis=1)

    for layer in range(DEPTH):
        last = layer == DEPTH - 1
        odd = layer % 2 == 1
        i = layer // 2
        sh1, sc1, g1, sh2, sc2, g2 = adaln(c, ada_w[layer], ada_b[layer])
        if odd or not last:
            tsh1, tsc1, tg1, tsh2, tsc2, tg2 = adaln(c_ctx[None, :], ada_w[layer], ada_b[layer])
            ht = modulate(t, tsh1, tsc1)
        hx = modulate(x, sh1, sc1)

        if not odd:
            ab = (ab_w_in[i], a_v_gain[i], a_w_s[i], a_b_s[i], b_w_pool[i], b_scale[i], ab_w_out[i])
            mx = ab_mixer(hx, *ab)
            if not last:
                mt = ab_mixer(ht, *ab)
        else:
            zx = hx @ cd_w_in[i]
            zt = ht @ cd_w_in[i]
            qcx, qdx = cd_queries(zx, c_q_gain[i], d_cq_gain[i], d_w_uq[i], rope_c, rope_d)
            kcx, vcx, kdx, vdx = cd_keys(zx, c_k_gain[i], d_ckv_gain[i], d_w_ukv[i], rope_c, rope_d)
            kct, vct, kdt, vdt = cd_keys(zt, c_k_gain[i], d_ckv_gain[i], d_w_ukv[i], None, None)
            mx = cd_attend(qcx, qdx, cat(kct, kcx), cat(vct, vcx), cat(kdt, kdx), cat(vdt, vdx), cd_w_out[i])
            if not last:
                qct, qdt = cd_queries(zt, c_q_gain[i], d_cq_gain[i], d_w_uq[i], None, None)
                mt = cd_attend(qct, qdt, kct, vct, kdt, vdt, cd_w_out[i])
        x = x + g1 * mx
        if not last:
            t = t + tg1 * mt

        hx2 = modulate(x, sh2, sc2)
        h2 = hx2 if last else cat(modulate(t, tsh2, tsc2), hx2)
        if odd:
            f = moe_swiglu(h2, moe_router[i], moe_w_gate[i], moe_w_up[i], moe_w_down[i])
        else:
            f = swiglu(h2, ffn_w_gate[i], ffn_w_up[i], ffn_w_down[i])
        if last:
            x = x + g2 * f
        else:
            t = t + tg2 * f[:, :ctx_len]
            x = x + g2 * f[:, ctx_len:]

    return rmsnorm(x, final_gain)
```

```cpp
#include <hip/hip_runtime.h>
#include <cstdio>
#include <cstdint>

namespace pg8 {
#define PG8_LAS __attribute__((address_space(3)))
typedef unsigned short bf16_t;
typedef short bf16x8 __attribute__((ext_vector_type(8)));
typedef float f32x4 __attribute__((ext_vector_type(4)));
typedef unsigned u32x4 __attribute__((ext_vector_type(4)));
constexpr int BM = 256, BK = 64, HALF = 128, HTB = HALF * BK * 2  , STAGE_BYTES = 8 * HTB, NXCD = 8, WGM = 8;

__host__ __device__ __forceinline__ int lds_byte(int r, int c) { const int st = (r >> 4) * 2 + (c >> 5), rr = r & 15, cc = c & 31, ob = rr * 64 + cc * 2; return st * 1024 + (ob ^ (((ob >> 9) & 1) << 5)); }
__host__ __device__ __forceinline__ void stage_rc(int b, int& R, int& C) { const int st = b / 1024, sb = b % 1024, swz = sb ^ (((sb >> 9) & 1) << 5); R = (st >> 1) * 16 + swz / 64; C = (st & 1) * 32 + (swz % 64) / 2; }
__host__ __device__ __forceinline__ int perm32(int rho) { const int n = rho >> 4, i = rho & 15; return 8 * (i >> 2) + 4 * n + (i & 3); }

struct Unit { int pm, pn, e; };
struct Gemm { const bf16_t* A; const bf16_t* Bt; int M, N, K; size_t bes; };

struct StaticOrder {
    int nM, nN, nwg, G, c, lat;
    __host__ __device__ void init(int M, int N, int G_, int c_, int lat_ = 0) { nM = M / BM; nN = N / BM; nwg = nM * nN; G = G_; c = c_; lat = lat_; }
    __host__ __device__ bool next(int i, Unit& u) const {
        const long L = (long)i * G + c; if (L >= nwg) return false;
        int wgid = (int)L; { const int q = nwg / NXCD, r = nwg % NXCD, xcd = wgid % NXCD, off = wgid / NXCD; wgid = (xcd < r ? xcd * (q + 1) : r * (q + 1) + (xcd - r) * q) + off; }
        const int nig = WGM * nN, gid = wgid / nig, fm = gid * WGM, gsz = (nM - fm) < WGM ? (nM - fm) : WGM;
        u.pm = fm + ((wgid % nig) % gsz); u.pn = (wgid % nig) / gsz; u.e = 0; if (lat) u.pm = u.pm + (u.pm >> 5) + 1; return true;
    }
    __device__ __forceinline__ void a_ready(const Unit&) const {}
    __device__ __forceinline__ void done(const Unit&) const {}
};

__device__ __forceinline__ unsigned cvt_pk_bf16(float lo, float hi) { unsigned r; asm volatile("v_cvt_pk_bf16_f32 %0, %1, %2" : "=v"(r) : "v"(lo), "v"(hi)); return r; }
typedef float f32x2 __attribute__((ext_vector_type(2)));
__device__ __forceinline__ f32x2 gelu_pk(f32x2 v) {
    const f32x2 av = __builtin_elementwise_abs(v), d = av * 0.2316418882f + 1.0f;
    f32x2 t; t.x = __builtin_amdgcn_rcpf(d.x); t.y = __builtin_amdgcn_rcpf(d.y);
    f32x2 q = t * 0.5307027145f + (-0.7265760135f); q = q * t + 0.7107068705f; q = q * t + (-0.142248368f); q = q * t + 0.127414796f; q = q * t;
    const f32x2 s = (v * v) * (-0.72134752044f);
    f32x2 e; e.x = __builtin_amdgcn_exp2f(s.x); e.y = __builtin_amdgcn_exp2f(s.y);
    const f32x2 m = v * (q * e), r = v - m;
    f32x2 o; o.x = v.x < 0.f ? m.x : r.x; o.y = v.y < 0.f ? m.y : r.y; return o;
}

template <int ACT  > struct EpiBf16 {
    static constexpr bool PERM = true, AFTER_DRAIN = false; static_assert(ACT == 0 || ACT == 1, "EpiBf16: ACT is 0 (none) or 1 (gelu_pk)");
    bf16_t* O; int ldc; const float* bias; int split_cols; size_t split_stride; float scale0;
    __device__ __forceinline__ void operator()(const f32x4 (&acc)[2][2][4][2], const Unit& u, int wr, int wc, int fr, int fq) const {
        const int row0 = u.pm * BM + wr * 64 + fr; int colt = u.pn * BM; bf16_t* base = O;
        float sc = 1.f; if (split_cols) { const int t = colt / split_cols; base += (size_t)t * split_stride; colt -= t * split_cols; if (t == 0) sc = scale0; }
        const int col0 = colt + wc * 32 + 8 * fq, bcol0 = u.pn * BM + wc * 32 + 8 * fq;
        f32x4 bv[2][2];
#pragma unroll
        for (int bj = 0; bj < 2; ++bj)
#pragma unroll
            for (int n = 0; n < 2; ++n) bv[bj][n] = bias ? *(const f32x4*)(bias + bcol0 + bj * HALF + 4 * n) : (f32x4){0.f, 0.f, 0.f, 0.f};
#pragma unroll
        for (int ai = 0; ai < 2; ++ai)
#pragma unroll
            for (int m = 0; m < 4; ++m) { bf16_t* rowp = base + (size_t)(row0 + ai * HALF + m * 16) * ldc + col0;
#pragma unroll
                for (int bj = 0; bj < 2; ++bj) { f32x4 v0 = acc[ai][bj][m][0] + bv[bj][0], v1 = acc[ai][bj][m][1] + bv[bj][1];
                    if (ACT == 1) { f32x2 a = gelu_pk((f32x2){v0[0], v0[1]}), b = gelu_pk((f32x2){v0[2], v0[3]}), c = gelu_pk((f32x2){v1[0], v1[1]}), d = gelu_pk((f32x2){v1[2], v1[3]});
                        v0 = (f32x4){a.x, a.y, b.x, b.y}; v1 = (f32x4){c.x, c.y, d.x, d.y}; }
                    v0 = v0 * sc; v1 = v1 * sc; u32x4 w; w.x = cvt_pk_bf16(v0[0], v0[1]); w.y = cvt_pk_bf16(v0[2], v0[3]); w.z = cvt_pk_bf16(v1[0], v1[1]); w.w = cvt_pk_bf16(v1[2], v1[3]);
                    *(u32x4*)(rowp + bj * HALF) = w; } }
    }
};

constexpr int PAN_B = 33;
__device__ __forceinline__ int modrow_of_panel(int pm) { const int b = pm / PAN_B; return (pm - b * PAN_B == 0) ? 4 : b; }
__device__ __forceinline__ unsigned pk4_fp8(float a, float b, float c, float d) { int w = 0; w = __builtin_amdgcn_cvt_pk_fp8_f32(a, b, w, false); w = __builtin_amdgcn_cvt_pk_fp8_f32(c, d, w, true); return (unsigned)w; }
__device__ __forceinline__ float silu_f(float g) { return g * __builtin_amdgcn_rcpf(1.0f + __builtin_amdgcn_exp2f(-1.4426950408889634f * g)); }

template <bool GELU> struct EpiZ {
    static constexpr bool PERM = true, AFTER_DRAIN = false;
    bf16_t* O; int ldc; int gelu_tiles; float oscale;
    __device__ __forceinline__ void operator()(const f32x4 (&acc)[2][2][4][2], const Unit& u, int wr, int wc, int fr, int fq) const {
        const int row0 = u.pm * BM + wr * 64 + fr, col0 = u.pn * BM + wc * 32 + 8 * fq;
        const bool g = GELU && (u.pn < gelu_tiles);
#pragma unroll
        for (int ai = 0; ai < 2; ++ai)
#pragma unroll
            for (int m = 0; m < 4; ++m) { bf16_t* rowp = O + (size_t)(row0 + ai * HALF + m * 16) * ldc + col0;
#pragma unroll
                for (int bj = 0; bj < 2; ++bj) { f32x4 v0 = acc[ai][bj][m][0], v1 = acc[ai][bj][m][1];
                    if (GELU) { if (g) { f32x2 a = gelu_pk((f32x2){v0[0], v0[1]}), b = gelu_pk((f32x2){v0[2], v0[3]}), c = gelu_pk((f32x2){v1[0], v1[1]}), d = gelu_pk((f32x2){v1[2], v1[3]});
                        v0 = (f32x4){a.x, a.y, b.x, b.y}; v1 = (f32x4){c.x, c.y, d.x, d.y}; } }
                    v0 = v0 * oscale; v1 = v1 * oscale;
                    u32x4 w; w.x = cvt_pk_bf16(v0[0], v0[1]); w.y = cvt_pk_bf16(v0[2], v0[3]); w.z = cvt_pk_bf16(v1[0], v1[1]); w.w = cvt_pk_bf16(v1[2], v1[3]);
                    *(u32x4*)(rowp + bj * HALF) = w; } }
    }
};
struct EpiResid {
    static constexpr bool PERM = false, AFTER_DRAIN = false;
    bf16_t* X; const float* gate; float gscale;
    __device__ __forceinline__ void operator()(const f32x4 (&acc)[2][2][4][2], const Unit& u, int wr, int wc, int fr, int fq) const {
        const float* gp = gate + (size_t)modrow_of_panel(u.pm) * 6144;
        const int col0 = u.pn * BM + wc * 32 + 4 * fq;
        f32x4 gv[2][2];
#pragma unroll
        for (int bj = 0; bj < 2; ++bj)
#pragma unroll
            for (int n = 0; n < 2; ++n) gv[bj][n] = *(const f32x4*)(gp + col0 + bj * HALF + n * 16) * gscale;
        typedef unsigned u32x2v __attribute__((ext_vector_type(2)));
#pragma unroll
        for (int ai = 0; ai < 2; ++ai)
#pragma unroll
            for (int m = 0; m < 4; ++m) { bf16_t* p = X + (size_t)(u.pm * BM + ai * HALF + wr * 64 + m * 16 + fr) * 1024 + col0;
                u32x2v r[2][2];
#pragma unroll
                for (int bj = 0; bj < 2; ++bj)
#pragma unroll
                    for (int n = 0; n < 2; ++n) r[bj][n] = *(const u32x2v*)(p + bj * HALF + n * 16);
#pragma unroll
                for (int bj = 0; bj < 2; ++bj)
#pragma unroll
                    for (int n = 0; n < 2; ++n) { const u32x2v rr = r[bj][n];
                        f32x4 x = (f32x4){__uint_as_float(rr.x << 16), __uint_as_float(rr.x & 0xffff0000u), __uint_as_float(rr.y << 16), __uint_as_float(rr.y & 0xffff0000u)}; x = x + gv[bj][n] * acc[ai][bj][m][n];
                        u32x2v w; w.x = cvt_pk_bf16(x[0], x[1]); w.y = cvt_pk_bf16(x[2], x[3]); *(u32x2v*)(p + bj * HALF + n * 16) = w; }
                if (m & 1) asm volatile("" ::: "memory"); }
    }
};
template <bool OUT8> struct EpiSwiglu {
    static constexpr bool PERM = true, AFTER_DRAIN = false;
    bf16_t* O; int ldc; float iscale;
    __device__ __forceinline__ void operator()(const f32x4 (&acc)[2][2][4][2], const Unit& u, int wr, int wc, int fr, int fq) const {
        const int row0 = u.pm * BM + wr * 64 + fr, col0 = u.pn * HALF + wc * 32 + 8 * fq;
#pragma unroll
        for (int ai = 0; ai < 2; ++ai)
#pragma unroll
            for (int m = 0; m < 4; ++m) {
                const f32x4 g0 = acc[ai][0][m][0] * iscale, g1 = acc[ai][0][m][1] * iscale, u0 = acc[ai][1][m][0] * iscale, u1 = acc[ai][1][m][1] * iscale;
                float h[8];
#pragma unroll
                for (int j = 0; j < 4; ++j) { h[j] = silu_f(g0[j]) * u0[j]; h[4 + j] = silu_f(g1[j]) * u1[j]; }
                if (OUT8) { typedef unsigned u32x2v __attribute__((ext_vector_type(2))); unsigned char* rowp = (unsigned char*)O + (size_t)(row0 + ai * HALF + m * 16) * ldc + col0;
                    u32x2v w; w.x = pk4_fp8(h[0], h[1], h[2], h[3]); w.y = pk4_fp8(h[4], h[5], h[6], h[7]); *(u32x2v*)rowp = w; }
                else { bf16_t* rowp = O + (size_t)(row0 + ai * HALF + m * 16) * ldc + col0;
                    u32x4 w; w.x = cvt_pk_bf16(h[0], h[1]); w.y = cvt_pk_bf16(h[2], h[3]); w.z = cvt_pk_bf16(h[4], h[5]); w.w = cvt_pk_bf16(h[6], h[7]); *(u32x4*)rowp = w; } }
    }
};
constexpr float QD_SCALE = 0.10206207261596575f * 1.4426950408889634f;
struct EpiQD {
    static constexpr bool PERM = false, AFTER_DRAIN = false;
    unsigned char* O; const float* rope;
    __device__ __forceinline__ void operator()(const f32x4 (&acc)[2][2][4][2], const Unit& u, int wr, int wc, int fr, int fq) const {
        const int pb = u.pm / PAN_B, pj = u.pm - pb * PAN_B; const bool latent = pj != 0;
        f32x4 csv[2][4], snv[2][4];
#pragma unroll
        for (int ai = 0; ai < 2; ++ai)
#pragma unroll
            for (int m = 0; m < 4; ++m) { const int rin = ai * HALF + wr * 64 + m * 16 + fr; const int s = latent ? (pj - 1) * 256 + rin : 0;
                csv[ai][m] = *(const f32x4*)(rope + (size_t)s * 32 + 4 * fq); snv[ai][m] = *(const f32x4*)(rope + (size_t)s * 32 + 16 + 4 * fq); }
#pragma unroll
        for (int ai = 0; ai < 2; ++ai)
#pragma unroll
            for (int m = 0; m < 4; ++m) { const int rin = ai * HALF + wr * 64 + m * 16 + fr;
                const f32x4 cs = csv[ai][m], sn = snv[ai][m];
                unsigned char* rowp = O + (size_t)(u.pm * BM + rin) * 1024;
#pragma unroll
                for (int bj = 0; bj < 2; ++bj) { const int cb = 8 * u.pn + 4 * bj + wc; f32x4 x1 = acc[ai][bj][m][0], x2 = acc[ai][bj][m][1];
                    if (latent && (cb % 3 == 2)) { const f32x4 o1 = x1 * cs - x2 * sn, o2 = x1 * sn + x2 * cs; x1 = o1; x2 = o2; }
                    x1 = x1 * QD_SCALE; x2 = x2 * QD_SCALE;
                    const int c1 = u.pn * BM + bj * HALF + wc * 32 + 4 * fq, c2 = c1 + 16, h1 = c1 / 96, h2 = c2 / 96;
                    *(unsigned*)(rowp + h1 * 128 + (c1 - h1 * 96)) = pk4_fp8(x1[0], x1[1], x1[2], x1[3]); *(unsigned*)(rowp + h2 * 128 + (c2 - h2 * 96)) = pk4_fp8(x2[0], x2[1], x2[2], x2[3]); } }
    }
};
struct EpiKVD {
    static constexpr bool PERM = true, AFTER_DRAIN = false;
    unsigned char* KD; bf16_t* VD;
    __device__ __forceinline__ void operator()(const f32x4 (&acc)[2][2][4][2], const Unit& u, int wr, int wc, int fr, int fq) const {
        const int row0 = u.pm * BM + wr * 64 + fr;
#pragma unroll
        for (int ai = 0; ai < 2; ++ai)
#pragma unroll
            for (int m = 0; m < 4; ++m) { const size_t row = (size_t)(row0 + ai * HALF + m * 16);
#pragma unroll
                for (int bj = 0; bj < 2; ++bj) { const int head = 2 * u.pn + bj; const f32x4 v0 = acc[ai][bj][m][0], v1 = acc[ai][bj][m][1];
                    if (wc < 2) { typedef unsigned u32x2v __attribute__((ext_vector_type(2))); u32x2v w8; w8.x = pk4_fp8(v0[0], v0[1], v0[2], v0[3]); w8.y = pk4_fp8(v1[0], v1[1], v1[2], v1[3]);
                        *(u32x2v*)(KD + row * 1024 + 128 * head + 32 * wc + 8 * fq) = w8; }
                    else { u32x4 w; w.x = cvt_pk_bf16(v0[0], v0[1]); w.y = cvt_pk_bf16(v0[2], v0[3]); w.z = cvt_pk_bf16(v1[0], v1[1]); w.w = cvt_pk_bf16(v1[2], v1[3]);
                        *(u32x4*)(VD + row * 512 + 64 * head + 32 * (wc - 2) + 8 * fq) = w; } } }
    }
};
struct MoeOrder {
    int nM, nN, nwg, G, c; unsigned t0, t1, t2, t3, t4;
    __device__ void init(int npanels, int N, int G_, int c_, const unsigned* pexp, int lane) { nM = npanels; nN = N / BM; nwg = nM * nN; G = G_; c = c_;
        t0 = __hip_atomic_load(pexp + lane, __ATOMIC_RELAXED, __HIP_MEMORY_SCOPE_AGENT); t1 = __hip_atomic_load(pexp + 64 + lane, __ATOMIC_RELAXED, __HIP_MEMORY_SCOPE_AGENT);
        t2 = __hip_atomic_load(pexp + 128 + lane, __ATOMIC_RELAXED, __HIP_MEMORY_SCOPE_AGENT); t3 = __hip_atomic_load(pexp + 192 + lane, __ATOMIC_RELAXED, __HIP_MEMORY_SCOPE_AGENT);
        t4 = __hip_atomic_load(pexp + 256 + lane, __ATOMIC_RELAXED, __HIP_MEMORY_SCOPE_AGENT); }
    __device__ bool next(int i, Unit& u) const {
        const long L = (long)i * G + c; if (L >= nwg) return false;
        int wgid = (int)L; { const int q = nwg / NXCD, r = nwg % NXCD, xcd = wgid % NXCD, off = wgid / NXCD; wgid = (xcd < r ? xcd * (q + 1) : r * (q + 1) + (xcd - r) * q) + off; }
        const int nig = WGM * nN, gid = wgid / nig, fm = gid * WGM, gsz = (nM - fm) < WGM ? (nM - fm) : WGM;
        u.pm = fm + ((wgid % nig) % gsz); u.pn = (wgid % nig) / gsz;
        const int k = u.pm >> 6; const unsigned tv = (k == 0) ? t0 : (k == 1) ? t1 : (k == 2) ? t2 : (k == 3) ? t3 : t4;
        u.e = __builtin_amdgcn_readlane((int)tv, u.pm & 63); return true;
    }
    __device__ __forceinline__ void a_ready(const Unit&) const {}
    __device__ __forceinline__ void done(const Unit&) const {}
};

template <class Epi, class Sched, bool ALIGN_EPI = false, bool SP2 = false, int F8 = 0>
__device__ __forceinline__ void gemm_phase(PG8_LAS unsigned char* lds, const Gemm g, const Sched& S, const Epi& E, int tid_in) {
    typedef int fr4_ __attribute__((ext_vector_type(4))); typedef int fr8_ __attribute__((ext_vector_type(8)));
    int tid_ = tid_in; asm volatile("" : "+v"(tid_));
    const int tid = tid_, wid = __builtin_amdgcn_readfirstlane(tid >> 6), lane = tid & 63, wr = wid >> 2, wc = wid & 3, fr = lane & 15, fq = lane >> 4;
    const int K = g.K, nt = K / BK;
    unsigned voffA[2], voffB[2];
#pragma unroll
    for (int i = 0; i < 2; ++i) { int R, C; stage_rc(tid * 16 + i * 8192, R, C); const int Rb = Epi::PERM ? ((R & ~31) + perm32(R & 31)) : R;
        voffA[i] = (unsigned)(R * K + C) * 2u; voffB[i] = (unsigned)(Rb * K + C) * 2u; }
    const size_t kstep = (size_t)(BK * 2);
    const size_t hstep = (size_t)HALF * K * 2;
    const size_t tstep = 2 * hstep;
    const unsigned ldsw = (unsigned)wid * 1024u;
    const int aoff = lds_byte(wr * 64 + fr, fq * 8), boff = lds_byte(wc * 32 + fr, fq * 8);
#define PG8_SA(b, h) (((b) * 2 + (h)) * HTB)
#define PG8_SB(b, h) ((4 + (b) * 2 + (h)) * HTB)
#define PG8_STAGE(bufoff, gbase, voff) do { _Pragma("unroll") for (int _i = 0; _i < 2; ++_i) \
        __builtin_amdgcn_global_load_lds((const unsigned*)((const char*)(gbase) + (voff)[_i]), (PG8_LAS unsigned*)(lds + (bufoff) + ldsw + _i * 8192), 16, 0, 0); } while (0)
#define PG8_LDA(dst, b, h) do { _Pragma("unroll") for (int m = 0; m < 4; ++m) { const fr4_ lo_ = *(const PG8_LAS fr4_*)(lds + PG8_SA(b, h) + aoff + m * 2048), hi_ = *(const PG8_LAS fr4_*)(lds + PG8_SA(b, h) + aoff + m * 2048 + 1024); \
        dst[m] = __builtin_shufflevector(lo_, hi_, 0, 1, 2, 3, 4, 5, 6, 7); } } while (0)
#define PG8_LDB(dst, b, h) do { _Pragma("unroll") for (int n = 0; n < 2; ++n) { const fr4_ lo_ = *(const PG8_LAS fr4_*)(lds + PG8_SB(b, h) + boff + n * 2048), hi_ = *(const PG8_LAS fr4_*)(lds + PG8_SB(b, h) + boff + n * 2048 + 1024); \
        dst[n] = __builtin_shufflevector(lo_, hi_, 0, 1, 2, 3, 4, 5, 6, 7); } } while (0)
#define PG8_MMA1(ACC, b4_, a4_) do { \
            if constexpr (F8 == 1) { typedef long l2_ __attribute__((ext_vector_type(2))); const l2_ b_ = __builtin_bit_cast(l2_, b4_), a_ = __builtin_bit_cast(l2_, a4_); \
                ACC = __builtin_amdgcn_mfma_f32_16x16x32_fp8_fp8(b_[0], a_[0], ACC, 0, 0, 0); ACC = __builtin_amdgcn_mfma_f32_16x16x32_fp8_fp8(b_[1], a_[1], ACC, 0, 0, 0); } \
            else ACC = __builtin_amdgcn_mfma_f32_16x16x32_bf16(__builtin_bit_cast(bf16x8, b4_), __builtin_bit_cast(bf16x8, a4_), ACC, 0, 0, 0); } while (0)
#define PG8_MMA(ai, bj, At, Bt) do { __builtin_amdgcn_s_setprio(1); \
      _Pragma("unroll") for (int m = 0; m < 4; ++m) _Pragma("unroll") for (int n = 0; n < 2; ++n) { \
        if constexpr (F8 == 2) asm volatile("v_mfma_scale_f32_16x16x128_f8f6f4 %0, %1, %2, %0, %3, %3 op_sel_hi:[0,0,0]" : "+v"(acc[ai][bj][m][n]) : "v"(Bt[n]), "v"(At[m]), "v"(mxscale_));     \
        else { const fr4_ b0_ = __builtin_shufflevector(Bt[n], Bt[n], 0, 1, 2, 3), a0_ = __builtin_shufflevector(At[m], At[m], 0, 1, 2, 3); PG8_MMA1(acc[ai][bj][m][n], b0_, a0_); \
               const fr4_ b1_ = __builtin_shufflevector(Bt[n], Bt[n], 4, 5, 6, 7), a1_ = __builtin_shufflevector(At[m], At[m], 4, 5, 6, 7); PG8_MMA1(acc[ai][bj][m][n], b1_, a1_); } } \
      __builtin_amdgcn_s_setprio(0); } while (0)
#define PG8_WAIT_V(n) asm volatile("s_waitcnt vmcnt(" #n ")" ::: "memory")
#define PG8_WAIT_L(n) asm volatile("s_waitcnt lgkmcnt(" #n ")" ::: "memory")
#define PG8_BAR __builtin_amdgcn_s_barrier()
#define PG8_SCHED __builtin_amdgcn_sched_barrier(0)
    int mxscale_ = 0x7F7F7F7F; asm volatile("" : "+v"(mxscale_));
    Unit cur, nxt; int ui = 0;
    if (!S.next(0, cur)) return;
    f32x4 acc[2][2][4][2];
#pragma unroll
    for (int a = 0; a < 2; ++a)
#pragma unroll
        for (int b = 0; b < 2; ++b)
#pragma unroll
            for (int m = 0; m < 4; ++m)
#pragma unroll
                for (int n = 0; n < 2; ++n) acc[a][b][m][n] = (f32x4){0.f, 0.f, 0.f, 0.f};
    fr8_ At[4], B0[2], B1[2];
    const char* cA = (const char*)g.A + (size_t)cur.pm * tstep; const char* cB = (const char*)g.Bt + (size_t)cur.e * g.bes + (size_t)cur.pn * tstep;
    S.a_ready(cur);
    if constexpr (SP2) {
        PG8_STAGE(PG8_SB(0, 0), cB, voffB); PG8_STAGE(PG8_SB(0, 1), cB + hstep, voffB); PG8_STAGE(PG8_SA(0, 0), cA, voffA); PG8_STAGE(PG8_SA(0, 1), cA + hstep, voffA);
        if (wr == 1) PG8_BAR;
        PG8_WAIT_V(2); PG8_BAR;
        PG8_STAGE(PG8_SB(1, 0), cB + kstep, voffB); PG8_STAGE(PG8_SA(1, 0), cA + kstep, voffA); PG8_STAGE(PG8_SB(1, 1), cB + hstep + kstep, voffB);
        PG8_WAIT_V(6); PG8_BAR;
    } else {
        PG8_STAGE(PG8_SB(0, 0), cB, voffB); PG8_STAGE(PG8_SA(0, 0), cA, voffA); PG8_STAGE(PG8_SB(0, 1), cB + hstep, voffB); PG8_STAGE(PG8_SA(0, 1), cA + hstep, voffA);
        if (wr == 1) PG8_BAR;
        PG8_WAIT_V(4); PG8_BAR;
        PG8_STAGE(PG8_SB(1, 0), cB + kstep, voffB); PG8_STAGE(PG8_SA(1, 0), cA + kstep, voffA); PG8_STAGE(PG8_SB(1, 1), cB + hstep + kstep, voffB);
        PG8_WAIT_V(6); PG8_BAR;
    }
    for (;;) {
        const bool has_next = S.next(ui + 1, nxt);
        const char* nA = has_next ? (const char*)g.A + (size_t)nxt.pm * tstep : cA; const char* nB = has_next ? (const char*)g.Bt + (size_t)nxt.e * g.bes + (size_t)nxt.pn * tstep : cB;
#pragma unroll 1
        for (int t = 0; t < nt; t += 2) {
            const bool last = (t == nt - 2);
            const char* a1 = cA + (size_t)(t + 1) * kstep;
            const char* a2 = last ? nA : cA + (size_t)(t + 2) * kstep; const char* b2 = last ? nB : cB + (size_t)(t + 2) * kstep;
            const char* a3 = a2 + kstep; const char* b3 = b2 + kstep;
            if (last && has_next) S.a_ready(nxt);
            if constexpr (SP2) {
            PG8_LDB(B0, 0, 0); PG8_LDB(B1, 0, 1); PG8_SCHED; PG8_LDA(At, 0, 0); PG8_STAGE(PG8_SA(1, 1), a1 + hstep, voffA);
            PG8_WAIT_V(8); PG8_WAIT_L(0); PG8_BAR; PG8_MMA(0, 0, At, B0); PG8_MMA(0, 1, At, B1); PG8_BAR; PG8_SCHED;
            PG8_LDA(At, 0, 1); PG8_STAGE(PG8_SB(0, 0), b2, voffB); PG8_STAGE(PG8_SB(0, 1), b2 + hstep, voffB); PG8_STAGE(PG8_SA(0, 0), a2, voffA);
            PG8_WAIT_V(8); PG8_WAIT_L(0); PG8_BAR; PG8_MMA(1, 0, At, B0); PG8_MMA(1, 1, At, B1); PG8_BAR; PG8_SCHED;
            PG8_LDB(B0, 1, 0); PG8_LDB(B1, 1, 1); PG8_SCHED; PG8_LDA(At, 1, 0); PG8_STAGE(PG8_SA(0, 1), a2 + hstep, voffA);
            PG8_WAIT_V(8); PG8_WAIT_L(0); PG8_BAR; PG8_MMA(0, 0, At, B0); PG8_MMA(0, 1, At, B1); PG8_BAR; PG8_SCHED;
            PG8_LDA(At, 1, 1); PG8_STAGE(PG8_SB(1, 0), b3, voffB); PG8_STAGE(PG8_SB(1, 1), b3 + hstep, voffB); PG8_STAGE(PG8_SA(1, 0), a3, voffA);
            PG8_WAIT_V(8); PG8_WAIT_L(0); PG8_BAR; PG8_MMA(1, 0, At, B0); PG8_MMA(1, 1, At, B1); PG8_BAR; PG8_SCHED;
            } else {
            PG8_LDB(B0, 0, 0); PG8_SCHED; PG8_LDA(At, 0, 0); PG8_STAGE(PG8_SA(1, 1), a1 + hstep, voffA);
            PG8_WAIT_L(8); PG8_BAR; PG8_WAIT_L(0); PG8_MMA(0, 0, At, B0); PG8_BAR; PG8_SCHED;
            PG8_LDB(B1, 0, 1); PG8_STAGE(PG8_SB(0, 0), b2, voffB);
            PG8_BAR; PG8_WAIT_L(0); PG8_MMA(0, 1, At, B1); PG8_BAR;
            PG8_LDA(At, 0, 1); PG8_STAGE(PG8_SA(0, 0), a2, voffA);
            PG8_BAR; PG8_WAIT_L(0); PG8_MMA(1, 0, At, B0); PG8_BAR; PG8_SCHED;
            PG8_STAGE(PG8_SB(0, 1), b2 + hstep, voffB);
            PG8_WAIT_V(6); PG8_BAR; PG8_MMA(1, 1, At, B1); PG8_BAR;
            PG8_LDB(B0, 1, 0); PG8_SCHED; PG8_LDA(At, 1, 0); PG8_STAGE(PG8_SA(0, 1), a2 + hstep, voffA);
            PG8_WAIT_L(8); PG8_BAR; PG8_WAIT_L(0); PG8_MMA(0, 0, At, B0); PG8_BAR; PG8_SCHED;
            PG8_LDB(B1, 1, 1); PG8_STAGE(PG8_SB(1, 0), b3, voffB);
            PG8_BAR; PG8_WAIT_L(0); PG8_MMA(0, 1, At, B1); PG8_BAR;
            PG8_LDA(At, 1, 1); PG8_STAGE(PG8_SA(1, 0), a3, voffA);
            PG8_BAR; PG8_WAIT_L(0); PG8_MMA(1, 0, At, B0); PG8_BAR; PG8_SCHED;
            PG8_STAGE(PG8_SB(1, 1), b3 + hstep, voffB);
            PG8_WAIT_V(6); PG8_BAR; PG8_MMA(1, 1, At, B1); PG8_BAR;
            }
        }
        if constexpr (F8 == 2) asm volatile("s_nop 15\n\ts_nop 15" ::: "memory");
        if constexpr (ALIGN_EPI) { if (wr == 0) PG8_BAR; }
        if constexpr (!Epi::AFTER_DRAIN) { E(acc, cur, wr, wc, fr, fq); S.done(cur); }
        if (!has_next) break;
#pragma unroll
        for (int a = 0; a < 2; ++a)
#pragma unroll
            for (int b = 0; b < 2; ++b)
#pragma unroll
                for (int m = 0; m < 4; ++m)
#pragma unroll
                    for (int n = 0; n < 2; ++n) acc[a][b][m][n] = (f32x4){0.f, 0.f, 0.f, 0.f};
        cur = nxt; cA = nA; cB = nB; ++ui;
        if constexpr (ALIGN_EPI) { if (wr == 1) PG8_BAR; }
    }
    PG8_WAIT_V(0);
    if constexpr (!ALIGN_EPI) { if (wr == 0) PG8_BAR; }
    PG8_BAR;
    if constexpr (Epi::AFTER_DRAIN) { E.fused(acc, cur, wr, wc, fr, fq, lds, wid, lane); S.done(cur); }
#undef PG8_SA
#undef PG8_SB
#undef PG8_STAGE
#undef PG8_LDA
#undef PG8_LDB
#undef PG8_MMA
#undef PG8_MMA1
#undef PG8_WAIT_V
#undef PG8_WAIT_L
#undef PG8_BAR
#undef PG8_SCHED
}
}

#define GAS __attribute__((address_space(1)))
#define LAS __attribute__((address_space(3)))
#define RLX_AGENT __ATOMIC_RELAXED, __HIP_MEMORY_SCOPE_AGENT
#define XB_TMO      128
#define XB_XCNT(j)  (256  + 64 * (j))
#define XB_XSUB(j)  (1280 + 64 * (j))
#define XB_XGEN(j)  (2304 + 64 * (j))
#define XB_TOP      3328
#define XB_TOPGEN   3392
#define XCD_BAR_WORDS 3456
#define XB_SPIN_CAP (1u << 18)

__device__ __forceinline__ unsigned xb_ld(unsigned* p)              { return __hip_atomic_load(p, __ATOMIC_RELAXED, __HIP_MEMORY_SCOPE_AGENT); }
__device__ __forceinline__ unsigned xb_add(unsigned* p, unsigned v) { return __hip_atomic_fetch_add(p, v, __ATOMIC_RELAXED, __HIP_MEMORY_SCOPE_AGENT); }
__device__ __forceinline__ unsigned xb_xcc_id() { return (unsigned)__builtin_amdgcn_s_getreg((3 << 11) | 20) & 0xFu; }
#define XB_SPIN(cond, bar) do { unsigned _sp = 0; while (cond) { __builtin_amdgcn_s_sleep(1); \
    if ((++_sp & 255u) == 0u) { if (xb_ld(&(bar)[XB_TMO])) break; if (_sp > XB_SPIN_CAP) { atomicAdd(&(bar)[XB_TMO], 1u); break; } } } } while (0)

struct XcdBarrier {
    unsigned* bar; unsigned x;
    volatile LAS unsigned* st;
};

__device__ __forceinline__ XcdBarrier xcd_barrier_post(unsigned* bar, volatile LAS unsigned* st) {
    XcdBarrier b; b.bar = bar; b.x = xb_xcc_id(); b.st = st;
    if (threadIdx.x == 0) (void)xb_add(&bar[XB_XCNT(b.x)], 1u);
    return b;
}
__device__ __forceinline__ void xcd_barrier_complete(unsigned* bar, unsigned x, unsigned& nloc, unsigned& nx) {
    const unsigned G = gridDim.x * gridDim.y * gridDim.z;
    unsigned sum, cnt, mine, sp = 0u;
    for (;;) {
        sum = 0u; cnt = 0u; mine = 0u;
#pragma unroll
        for (unsigned j = 0; j < 16; ++j) { const unsigned c = xb_ld(&bar[XB_XCNT(j)]); sum += c; cnt += (c > 0u) ? 1u : 0u; mine = (j == x) ? c : mine; }
        if (sum == G) break;
        __builtin_amdgcn_s_sleep(1);
        if ((++sp & 255u) == 0u) { if (xb_ld(&bar[XB_TMO])) break; if (sp > XB_SPIN_CAP) { atomicAdd(&bar[XB_TMO], 1u); break; } }
    }
    nloc = mine > 0u ? mine : 1u; nx = cnt > 0u ? cnt : 1u;
}

__device__ __forceinline__ void xcd_barrier(const XcdBarrier& b) {
    asm volatile("s_waitcnt vmcnt(0)" ::: "memory");
    __syncthreads();
    if (threadIdx.x == 0) {
        unsigned* bar = b.bar;
        __builtin_amdgcn_s_waitcnt(0);
        unsigned nloc = b.st[0], nx = b.st[1];
        if (nloc == 0u) { xcd_barrier_complete(bar, b.x, nloc, nx); b.st[0] = nloc; b.st[1] = nx; }
        const unsigned old = xb_add(&bar[XB_XSUB(b.x)], 1u);
        const unsigned gen = old / nloc;
        if (old + 1u == (gen + 1u) * nloc) {
            __builtin_amdgcn_fence(__ATOMIC_RELEASE, "agent");
            asm volatile("s_waitcnt vmcnt(0)" ::: "memory");
            const unsigned og = xb_add(&bar[XB_TOP], 1u);
            const unsigned tg = og / nx;
            if (og + 1u == (tg + 1u) * nx) xb_add(&bar[XB_TOPGEN], 1u);
            else XB_SPIN(xb_ld(&bar[XB_TOPGEN]) == tg, bar);
            __builtin_amdgcn_fence(__ATOMIC_ACQUIRE, "agent");
            xb_add(&bar[XB_XGEN(b.x)], 1u);
            asm volatile("s_waitcnt vmcnt(0)" ::: "memory");
        } else {
            XB_SPIN(xb_ld(&bar[XB_XGEN(b.x)]) == gen, bar);
            __builtin_amdgcn_fence(__ATOMIC_ACQUIRE, "agent");
            asm volatile("s_waitcnt vmcnt(0)" ::: "memory");
        }
    }
    __syncthreads();
}


namespace att {
using bf16x8 = __attribute__((ext_vector_type(8))) short;
using s16x4  = __attribute__((ext_vector_type(4))) short;
using f32x16 = __attribute__((ext_vector_type(16))) float;
using u32x4  = __attribute__((ext_vector_type(4))) unsigned;
typedef unsigned short bf16_t;
constexpr int NW = 8, QBLK = 32, KVBLK = 64, DV = 64;
constexpr float THR = 8.f;
#define ATT_SBAR() __builtin_amdgcn_sched_barrier(0)
__device__ __forceinline__ int crow(int r, int hi) { return (r & 3) + 8 * (r >> 2) + 4 * hi; }
__device__ __forceinline__ unsigned cvtpk(float lo, float hi) { unsigned r; asm volatile("v_cvt_pk_bf16_f32 %0, %1, %2" : "=v"(r) : "v"(lo), "v"(hi)); return r; }
template <int DK> __device__ __forceinline__ int kswz(int row, int chunk) {
    if (DK == 64) return row * 128 + ((chunk ^ ((row >> 1) & 7)) << 4);
    else          return row * 192 + ((chunk ^ ((row >> 2) & 3)) << 4);
}
__device__ __forceinline__ int v_st(int k, int c) { const int kk = (k & ~0xC) | ((k & 4) << 1) | ((k & 8) >> 1); return ((kk >> 3) * 2 + (c >> 5)) * 512 + ((kk & 7) * 32 + (c & 31)) * 2; }
__device__ __forceinline__ int v_rd_base(int lane) { return ((lane & 3) << 3) | (((lane >> 2) & 3) << 6) | (((lane >> 4) & 1) << 5) | (((lane >> 5) & 1) << 8); }
constexpr int v_rd_off(int d0, int ks, int half) { return d0 * 512 + ks * 2048 + half * 1024; }
template <int OFF> __device__ __forceinline__ s16x4 tr_read(int vb) { s16x4 r; asm volatile("ds_read_b64_tr_b16 %0, %1 offset:%2" : "=&v"(r) : "v"(vb), "i"(OFF) : "memory"); return r; }
template <int D0> __device__ __forceinline__ void pv_one(f32x16& od, int vb, bf16x8 pa0, bf16x8 pa1, bf16x8 pa2, bf16x8 pa3) {
    const s16x4 l0 = tr_read<v_rd_off(D0, 0, 0)>(vb), h0 = tr_read<v_rd_off(D0, 0, 1)>(vb), l1 = tr_read<v_rd_off(D0, 1, 0)>(vb), h1 = tr_read<v_rd_off(D0, 1, 1)>(vb);
    const s16x4 l2 = tr_read<v_rd_off(D0, 2, 0)>(vb), h2 = tr_read<v_rd_off(D0, 2, 1)>(vb), l3 = tr_read<v_rd_off(D0, 3, 0)>(vb), h3 = tr_read<v_rd_off(D0, 3, 1)>(vb);
    asm volatile("s_waitcnt lgkmcnt(0)" ::: "memory"); ATT_SBAR();
#define ATT_PK(L, H) (bf16x8){L[0], L[1], L[2], L[3], H[0], H[1], H[2], H[3]}
    od = __builtin_amdgcn_mfma_f32_32x32x16_bf16(pa0, ATT_PK(l0, h0), od, 0, 0, 0);
    od = __builtin_amdgcn_mfma_f32_32x32x16_bf16(pa1, ATT_PK(l1, h1), od, 0, 0, 0);
    od = __builtin_amdgcn_mfma_f32_32x32x16_bf16(pa2, ATT_PK(l2, h2), od, 0, 0, 0);
    od = __builtin_amdgcn_mfma_f32_32x32x16_bf16(pa3, ATT_PK(l3, h3), od, 0, 0, 0);
#undef ATT_PK
}
__device__ __forceinline__ void pv_d0(f32x16* o, int vb, bf16x8 pa0, bf16x8 pa1, bf16x8 pa2, bf16x8 pa3) { pv_one<0>(o[0], vb, pa0, pa1, pa2, pa3); pv_one<1>(o[1], vb, pa0, pa1, pa2, pa3); }
#define ATT_MX3(a, b, c) __builtin_fmaxf(__builtin_fmaxf((a), (b)), (c))
__device__ __forceinline__ void partialSM(f32x16& p0, f32x16& p1, float& mhat, f32x16& negm, float& alpha, bool first) {
    float a = ATT_MX3(p0[0], p0[1], p1[0]), b = ATT_MX3(p0[2], p0[3], p1[1]); a = ATT_MX3(a, p1[2], p1[3]);
#pragma unroll
    for (int r = 4; r < 16; r += 4) { a = ATT_MX3(a, p0[r], p0[r + 1]); b = ATT_MX3(b, p0[r + 2], p0[r + 3]); a = ATT_MX3(a, p1[r], p1[r + 1]); b = ATT_MX3(b, p1[r + 2], p1[r + 3]); }
    float pmax = fmaxf(a, b);
    { auto rr = __builtin_amdgcn_permlane32_swap(__float_as_uint(pmax), __float_as_uint(pmax), false, false); pmax = fmaxf(__uint_as_float(rr[0]), __uint_as_float(rr[1])); }
    alpha = 1.f;
    if (__builtin_expect(first || __any(pmax > THR), 0)) { const float dl = first ? pmax : fmaxf(pmax, 0.f); mhat += dl;
#pragma unroll
        for (int r = 0; r < 16; ++r) { p0[r] -= dl; p1[r] -= dl; }
#pragma unroll
        for (int r = 0; r < 16; ++r) negm[r] = -mhat;
        alpha = first ? 1.f : __builtin_amdgcn_exp2f(-dl); }
#pragma unroll
    for (int r = 0; r < 16; ++r) p0[r] = __builtin_amdgcn_exp2f(p0[r]);
}
__device__ __forceinline__ void finishSM(f32x16& p0, f32x16& p1, bf16x8& pa0, bf16x8& pa1, bf16x8& pa2, bf16x8& pa3) {
#pragma unroll
    for (int r = 0; r < 16; ++r) p1[r] = __builtin_amdgcn_exp2f(p1[r]);
#define ATT_PK4(P, BASE, OUT) do { unsigned a0 = cvtpk(P[BASE + 0], P[BASE + 1]), a1 = cvtpk(P[BASE + 2], P[BASE + 3]);   \
    unsigned b0 = cvtpk(P[BASE + 4], P[BASE + 5]), b1 = cvtpk(P[BASE + 6], P[BASE + 7]);                              \
    auto r0 = __builtin_amdgcn_permlane32_swap(a0, b0, false, false); auto r1 = __builtin_amdgcn_permlane32_swap(a1, b1, false, false); \
    u32x4 w = {r0[0], r1[0], r0[1], r1[1]}; OUT = *reinterpret_cast<bf16x8*>(&w); } while (0)
    ATT_PK4(p0, 0, pa0); ATT_PK4(p0, 8, pa1); ATT_PK4(p1, 0, pa2); ATT_PK4(p1, 8, pa3);
#undef ATT_PK4
}
__device__ __forceinline__ void lsum(f32x16& lacc, bf16x8 pa0, bf16x8 pa1, bf16x8 pa2, bf16x8 pa3) {
    const bf16x8 ones = {0x3F80, 0x3F80, 0x3F80, 0x3F80, 0x3F80, 0x3F80, 0x3F80, 0x3F80};
    lacc = __builtin_amdgcn_mfma_f32_32x32x16_bf16(pa0, ones, lacc, 0, 0, 0); lacc = __builtin_amdgcn_mfma_f32_32x32x16_bf16(pa1, ones, lacc, 0, 0, 0);
    lacc = __builtin_amdgcn_mfma_f32_32x32x16_bf16(pa2, ones, lacc, 0, 0, 0); lacc = __builtin_amdgcn_mfma_f32_32x32x16_bf16(pa3, ones, lacc, 0, 0, 0);
}
template <int DK> __device__ __forceinline__ void qkt(f32x16& p0, f32x16& p1, const char* Ks, const bf16x8* qr, const f32x16& negm, int r32, int hi) {
#pragma unroll
    for (int d0 = 0; d0 < DK / 16; ++d0) {
        const bf16x8 b0 = *reinterpret_cast<const bf16x8*>(Ks + kswz<DK>(r32, 2 * d0 + hi));
        const bf16x8 b1 = *reinterpret_cast<const bf16x8*>(Ks + kswz<DK>(32 + r32, 2 * d0 + hi));
        if (d0 == 0) { p0 = __builtin_amdgcn_mfma_f32_32x32x16_bf16(b0, qr[0], negm, 0, 0, 0); p1 = __builtin_amdgcn_mfma_f32_32x32x16_bf16(b1, qr[0], negm, 0, 0, 0); }
        else { p0 = __builtin_amdgcn_mfma_f32_32x32x16_bf16(b0, qr[d0], p0, 0, 0, 0); p1 = __builtin_amdgcn_mfma_f32_32x32x16_bf16(b1, qr[d0], p1, 0, 0, 0); } }
}
template <int DK> struct Lds { static constexpr int SHM_V = KVBLK * DV * 2, SHM_K = KVBLK * DK * 2, BYTES = 2 * SHM_V + 2 * SHM_K + NW * 64 * 4; };

template <int DK, int LDQ, int LDK, int LDV, int LDO>
__device__ __forceinline__ void attn_unit(const bf16_t* __restrict__ Qb, const bf16_t* __restrict__ Kh, const bf16_t* __restrict__ Vh, bf16_t* __restrict__ Ob, int nkeys, char* lds, int tid_in) {
    constexpr int SHM_V = Lds<DK>::SHM_V, SHM_K = Lds<DK>::SHM_K, NQD = DK / 16, KCH = DK / 8;
    int tid_ = tid_in; asm volatile("" : "+v"(tid_));
    const int tid = tid_, wid = tid >> 6, lane = tid & 63, r32 = lane & 31, hi = lane >> 5;
    char* V_lds = lds; char* K_lds = lds + 2 * SHM_V;
    float* al_l = (float*)(lds + 2 * SHM_V + 2 * SHM_K) + wid * 64;
    __syncthreads();
    float mhat = 0.f; f32x16 o[2] = {}; f32x16 lacc = {}; f32x16 negm = {}; bf16x8 qr[NQD];
    typedef const __attribute__((address_space(1))) bf16x8* gptr8;
    const bf16_t* Qw = Qb + (long)(wid * QBLK + r32) * LDQ + hi * 8;
#pragma unroll
    for (int d0 = 0; d0 < NQD; ++d0) qr[d0] = *(gptr8)(Qw + d0 * 16);
    const int vr = tid >> 3, vc = (tid & 7) * 8, vst = v_st(vr, vc);
    const int kp0 = tid, kr0 = kp0 / KCH, kc0 = kp0 % KCH, kst0 = kswz<DK>(kr0, kc0);
    const bool k2 = (DK == 96) && (tid < 256);
    const int kp1 = k2 ? tid + 512 : tid, kr1 = kp1 / KCH, kc1 = kp1 % KCH, kst1 = kswz<DK>(kr1, kc1);
    const int vb0 = (int)(uintptr_t)V_lds + v_rd_base(lane);
    struct { bf16x8 vs, ks0, ks1; } sr_[2];
#define ATT_SLOAD(i, k0) do { sr_[i].vs = *(gptr8)(&Vh[(long)((k0) + vr) * LDV + vc]); \
    sr_[i].ks0 = *(gptr8)(&Kh[(long)((k0) + kr0) * LDK + kc0 * 8]); \
    if (DK == 96) sr_[i].ks1 = *(gptr8)(&Kh[(long)((k0) + kr1) * LDK + kc1 * 8]); } while (0)
#define ATT_SWRITE(b, i) do { *(bf16x8*)(V_lds + (b) * SHM_V + vst) = sr_[i].vs; *(bf16x8*)(K_lds + (b) * SHM_K + kst0) = sr_[i].ks0; \
    if (DK == 96) { if (k2) *(bf16x8*)(K_lds + (b) * SHM_K + kst1) = sr_[i].ks1; } } while (0)
#define ATT_SWAIT() do { if (DK == 96) asm volatile("s_waitcnt vmcnt(3)" ::: "memory"); else asm volatile("s_waitcnt vmcnt(2)" ::: "memory"); } while (0)
#define ATT_RESC(a) do { if (__any((a) < 1.f)) { if (hi == 0) al_l[r32] = (a); asm volatile("s_waitcnt lgkmcnt(0)" ::: "memory"); \
    _Pragma("unroll") for (int r = 0; r < 16; ++r) { const float f_ = al_l[crow(r, hi)]; o[0][r] *= f_; o[1][r] *= f_; lacc[r] *= f_; } } } while (0)
    f32x16 pA0, pA1, pB0, pB1; float alA, alB; bf16x8 pa0, pa1, pa2, pa3; const int NT = nkeys / KVBLK;
    constexpr int SE = 0, SO = 1;
    ATT_SLOAD(SE, 0); asm volatile("s_waitcnt vmcnt(0)" ::: "memory"); ATT_SWRITE(0, SE); __syncthreads();
    qkt<DK>(pA0, pA1, K_lds, qr, negm, r32, hi); partialSM(pA0, pA1, mhat, negm, alA, true);
    ATT_SLOAD(SO, KVBLK); if (2 < NT) ATT_SLOAD(SE, 2 * KVBLK);
    if (2 < NT) ATT_SWAIT(); else asm volatile("s_waitcnt vmcnt(0)" ::: "memory");
    ATT_SWRITE(1, SO); __syncthreads();
    for (int j = 1; j + 1 < NT; j += 2) {
        ATT_SBAR(); qkt<DK>(pB0, pB1, K_lds + SHM_K, qr, negm, r32, hi);
        finishSM(pA0, pA1, pa0, pa1, pa2, pa3); ATT_SBAR();
        ATT_SLOAD(SO, (j + 2) * KVBLK); ATT_SBAR();
        pv_d0(o, vb0, pa0, pa1, pa2, pa3); lsum(lacc, pa0, pa1, pa2, pa3); partialSM(pB0, pB1, mhat, negm, alB, false);
        __syncthreads(); ATT_SWAIT(); ATT_SWRITE(0, SE);
        ATT_RESC(alB); __syncthreads();
        ATT_SBAR(); qkt<DK>(pA0, pA1, K_lds, qr, negm, r32, hi);
        finishSM(pB0, pB1, pa0, pa1, pa2, pa3); ATT_SBAR();
        if (j + 3 < NT) ATT_SLOAD(SE, (j + 3) * KVBLK); ATT_SBAR();
        pv_d0(o, vb0 + SHM_V, pa0, pa1, pa2, pa3); lsum(lacc, pa0, pa1, pa2, pa3); partialSM(pA0, pA1, mhat, negm, alA, false);
        __syncthreads(); if (j + 3 < NT) ATT_SWAIT(); else asm volatile("s_waitcnt vmcnt(0)" ::: "memory");
        ATT_SWRITE(1, SO);
        ATT_RESC(alA); __syncthreads();
    }
    ATT_SBAR(); qkt<DK>(pB0, pB1, K_lds + SHM_K, qr, negm, r32, hi);
    finishSM(pA0, pA1, pa0, pa1, pa2, pa3); ATT_SBAR();
    pv_d0(o, vb0, pa0, pa1, pa2, pa3); lsum(lacc, pa0, pa1, pa2, pa3); partialSM(pB0, pB1, mhat, negm, alB, false);
    __syncthreads(); ATT_RESC(alB);
    finishSM(pB0, pB1, pa0, pa1, pa2, pa3); ATT_SBAR();
    pv_d0(o, vb0 + SHM_V, pa0, pa1, pa2, pa3); lsum(lacc, pa0, pa1, pa2, pa3);
    __attribute__((address_space(1))) bf16_t* Ow = (__attribute__((address_space(1))) bf16_t*)(Ob + (long)(wid * QBLK) * LDO);
#pragma unroll
    for (int r = 0; r < 16; ++r) { const int orow = crow(r, hi); const float rl = __builtin_amdgcn_rcpf(lacc[r]);
#pragma unroll
        for (int d0 = 0; d0 < 2; ++d0) { const unsigned w = cvtpk(o[d0][r] * rl, 0.f); Ow[(long)orow * LDO + d0 * 32 + r32] = (bf16_t)(w & 0xffffu); } }
#undef ATT_SLOAD
#undef ATT_SWRITE
#undef ATT_SWAIT
#undef ATT_RESC
}

typedef __attribute__((address_space(3))) const char* lcp;
typedef short v4i16_t __attribute__((ext_vector_type(4)));
__device__ __forceinline__ unsigned cvtpk_b(float lo, float hi) { typedef float f2 __attribute__((ext_vector_type(2))); typedef __bf16 b2 __attribute__((ext_vector_type(2)));
    f2 v = {lo, hi}; b2 b = __builtin_convertvector(v, b2); return __builtin_bit_cast(unsigned, b); }
__device__ __forceinline__ int v3_st(int k, int c) { return (c >> 5) * 4096 + k * 64 + (c & 31) * 2; }
__device__ __forceinline__ int v3_rd_base(int lane) { return (4 * (lane >> 5) + ((lane & 15) >> 2)) * 64 + ((lane >> 4) & 1) * 32 + (lane & 3) * 8; }
constexpr int v3_rd_off(int d0, int ks) { return d0 * 4096 + ks * 1024; }
__device__ __forceinline__ bf16x8 vfrag3(lcp p) {
    const s16x4 l = __builtin_bit_cast(s16x4, __builtin_amdgcn_ds_read_tr16_b64_v4i16((__attribute__((address_space(3))) v4i16_t*)p));
    const s16x4 h = __builtin_bit_cast(s16x4, __builtin_amdgcn_ds_read_tr16_b64_v4i16((__attribute__((address_space(3))) v4i16_t*)(p + 512)));
    return (bf16x8){l[0], l[1], l[2], l[3], h[0], h[1], h[2], h[3]}; }
__device__ __forceinline__ bf16x8 vfrag(lcp p) {
    const s16x4 l = __builtin_bit_cast(s16x4, __builtin_amdgcn_ds_read_tr16_b64_v4i16((__attribute__((address_space(3))) v4i16_t*)p));
    const s16x4 h = __builtin_bit_cast(s16x4, __builtin_amdgcn_ds_read_tr16_b64_v4i16((__attribute__((address_space(3))) v4i16_t*)(p + 1024)));
    return (bf16x8){l[0], l[1], l[2], l[3], h[0], h[1], h[2], h[3]}; }
template <int DK> struct Lds3 { static constexpr int NSL = 6, SHM_V = KVBLK * DV * 2, SHM_K = KVBLK * DK * 2, OFF_K = NSL * SHM_V, OFF_AL = OFF_K + NSL * SHM_K, BYTES = OFF_AL + NW * 64 * 4; };
template <int DK, int LDQ, int LDK, int LDV, int LDO>
__device__ __forceinline__ void attn_unit3(const bf16_t* __restrict__ Qb, const bf16_t* __restrict__ Kh, const bf16_t* __restrict__ Vh, bf16_t* __restrict__ Ob, int nkeys, __attribute__((address_space(3))) char* lds, int tid_in) {
    constexpr int SHM_V = Lds3<DK>::SHM_V, SHM_K = Lds3<DK>::SHM_K, NQD = DK / 16, KCH = DK / 8;
    int tid_ = tid_in; asm volatile("" : "+v"(tid_));
    const int tid = tid_, wid = tid >> 6, lane = tid & 63, r32 = lane & 31, hi = lane >> 5;
    typedef __attribute__((address_space(3))) char* lp; typedef __attribute__((address_space(3))) bf16x8* lp8;
    const lp V_lds = lds; const lp K_lds = lds + Lds3<DK>::OFF_K;
    __attribute__((address_space(3))) float* al_l = (__attribute__((address_space(3))) float*)(lds + Lds3<DK>::OFF_AL) + wid * 64;
    typedef const __attribute__((address_space(1))) bf16x8* gptr8;
    float mhat = 0.f; f32x16 o0 = {}, o1 = {}, lacc = {}, negm = {}; bf16x8 qr[NQD];
    const bf16_t* Qw = Qb + (long)(wid * QBLK + r32) * LDQ + hi * 8;
#pragma unroll
    for (int d0 = 0; d0 < NQD; ++d0) qr[d0] = *(gptr8)(Qw + d0 * 16);
    const int vr = tid >> 3, vc = (tid & 7) * 8, vst = v3_st(vr, vc);
    const int kp0 = tid, kr0 = kp0 / KCH, kc0 = kp0 % KCH, kst0 = kswz<DK>(kr0, kc0);
    const bool k2 = (DK == 96) && (tid < 256);
    const int kp1 = k2 ? tid + 512 : tid, kr1 = kp1 / KCH, kc1 = kp1 % KCH, kst1 = kswz<DK>(kr1, kc1);
    const int vrd = v3_rd_base(lane);
    const int kq0 = kswz<DK>(r32, hi), kq1 = kswz<DK>(32 + r32, hi);
    bf16x8 sv[2], sk0[2], sk1[2];
#define A3_SLOAD(i, k0) do { sv[i] = *(gptr8)(&Vh[(long)((k0) + vr) * LDV + vc]); sk0[i] = *(gptr8)(&Kh[(long)((k0) + kr0) * LDK + kc0 * 8]); \
    if (DK == 96) sk1[i] = *(gptr8)(&Kh[(long)((k0) + kr1) * LDK + kc1 * 8]); } while (0)
#define A3_SWRITE(i, so) do { *(lp8)(V_lds + (so) * SHM_V + vst) = sv[i]; *(lp8)(K_lds + (so) * SHM_K + kst0) = sk0[i]; if (DK == 96) { if (k2) *(lp8)(K_lds + (so) * SHM_K + kst1) = sk1[i]; } } while (0)
#define A3_QKT(P0, P1, so) do { const lp kb_ = K_lds + (so) * SHM_K; \
    _Pragma("unroll") for (int d0 = 0; d0 < NQD; ++d0) { const bf16x8 b0_ = *(lp8)(kb_ + kswz<DK>(r32, 2 * d0 + hi)), b1_ = *(lp8)(kb_ + kswz<DK>(32 + r32, 2 * d0 + hi)); \
        if (d0 == 0) { P0 = __builtin_amdgcn_mfma_f32_32x32x16_bf16(b0_, qr[0], negm, 0, 0, 0); P1 = __builtin_amdgcn_mfma_f32_32x32x16_bf16(b1_, qr[0], negm, 0, 0, 0); } \
        else { P0 = __builtin_amdgcn_mfma_f32_32x32x16_bf16(b0_, qr[d0], P0, 0, 0, 0); P1 = __builtin_amdgcn_mfma_f32_32x32x16_bf16(b1_, qr[d0], P1, 0, 0, 0); } } } while (0)
#define A3_PK4(P, BASE, OUT) do { const u32x4 w_ = {cvtpk_b(P[BASE + 0], P[BASE + 1]), cvtpk_b(P[BASE + 2], P[BASE + 3]), cvtpk_b(P[BASE + 4], P[BASE + 5]), cvtpk_b(P[BASE + 6], P[BASE + 7])}; OUT = __builtin_bit_cast(bf16x8, w_); } while (0)
#define A3_ROWMAX(P0, P1, OUT) do { float a_ = ATT_MX3(P0[0], P0[1], P1[0]), b_ = ATT_MX3(P0[2], P0[3], P1[1]); a_ = ATT_MX3(a_, P1[2], P1[3]); \
    _Pragma("unroll") for (int r = 4; r < 16; r += 4) { a_ = ATT_MX3(a_, P0[r], P0[r + 1]); b_ = ATT_MX3(b_, P0[r + 2], P0[r + 3]); a_ = ATT_MX3(a_, P1[r], P1[r + 1]); b_ = ATT_MX3(b_, P1[r + 2], P1[r + 3]); } \
    float m_ = fmaxf(a_, b_); const auto rr_ = __builtin_amdgcn_permlane32_swap(__float_as_uint(m_), __float_as_uint(m_), false, false); OUT = fmaxf(__uint_as_float(rr_[0]), __uint_as_float(rr_[1])); } while (0)
#define A3_DECIDE(P0, P1, PMAX, FIRST, ALPHA) do { ALPHA = 1.f; if (__builtin_expect((FIRST) || __any(PMAX > THR), 0)) { const float dl_ = (FIRST) ? PMAX : fmaxf(PMAX, 0.f); mhat += dl_; const float nm_ = -mhat; \
    _Pragma("unroll") for (int r = 0; r < 16; ++r) { asm volatile("v_sub_f32_e32 %0, %0, %1" : "+v"(P0[r]) : "v"(dl_)); asm volatile("v_sub_f32_e32 %0, %0, %1" : "+v"(P1[r]) : "v"(dl_)); } \
    _Pragma("unroll") for (int r = 0; r < 16; ++r) asm volatile("v_mov_b32_e32 %0, %1" : "+v"(negm[r]) : "v"(nm_)); \
    ALPHA = (FIRST) ? 1.f : __builtin_amdgcn_exp2f(-dl_); } } while (0)
#define A3_EXP(P) do { _Pragma("unroll") for (int r = 0; r < 16; ++r) P[r] = __builtin_amdgcn_exp2f(P[r]); } while (0)
#define A3_RESC(a) do { if (__any((a) < 1.f)) { if (hi == 0) al_l[r32] = (a); \
    _Pragma("unroll") for (int r = 0; r < 16; ++r) { const float f_ = al_l[crow(r, hi)]; o0[r] *= f_; o1[r] *= f_; lacc[r] *= f_; } } } while (0)
    bf16x8 ones = {0x3F80, 0x3F80, 0x3F80, 0x3F80, 0x3F80, 0x3F80, 0x3F80, 0x3F80}; asm volatile("" : "+v"(ones));
#define A3_SB() __builtin_amdgcn_sched_barrier(0)
#define A3_KPF(d0, so) do { if (PREF && (d0) < NQD) { const lp kb_ = K_lds + (so) * SHM_K; kf_[2 * (d0)] = *(lp8)(kb_ + kswz<DK>(r32, 2 * (d0) + hi)); kf_[2 * (d0) + 1] = *(lp8)(kb_ + kswz<DK>(32 + r32, 2 * (d0) + hi)); } } while (0)
#define slot6(t) ((r0_ + ((t) - (s))) >= 6 ? (r0_ + ((t) - (s))) - 6 : (r0_ + ((t) - (s))))
#define A3_EX4(P, B) do { P[B] = __builtin_amdgcn_exp2f(P[B]); P[B + 1] = __builtin_amdgcn_exp2f(P[B + 1]); P[B + 2] = __builtin_amdgcn_exp2f(P[B + 2]); P[B + 3] = __builtin_amdgcn_exp2f(P[B + 3]); asm volatile("" : "+v"(P)); } while (0)
#define A3_MX4(P0, P1, B) do { mxa_ = ATT_MX3(mxa_, P0[B], P0[B + 1]); mxb_ = ATT_MX3(mxb_, P0[B + 2], P0[B + 3]); mxa_ = ATT_MX3(mxa_, P1[B], P1[B + 1]); mxb_ = ATT_MX3(mxb_, P1[B + 2], P1[B + 3]); } while (0)
#define A3_GAP1(g, P0, P1) do { \
    if (NQD == 4) { if ((g) == 0) A3_PK4(P0, 0, pa0); else if ((g) == 1) A3_PK4(P0, 8, pa1); else if ((g) == 2) A3_EX4(P1, 0); else if ((g) == 3) A3_EX4(P1, 4); else if ((g) == 4) A3_EX4(P1, 8); else if ((g) == 5) A3_EX4(P1, 12); \
                    else if ((g) == 6) A3_PK4(P1, 0, pa2); else A3_PK4(P1, 8, pa3); } \
    else { if ((g) == 0) A3_PK4(P0, 0, pa0); else if ((g) == 2) A3_PK4(P0, 8, pa1); else if ((g) == 3) A3_EX4(P1, 0); else if ((g) == 4) A3_EX4(P1, 4); else if ((g) == 5) A3_EX4(P1, 8); else if ((g) == 6) A3_EX4(P1, 12); \
           else if ((g) == 8) A3_PK4(P1, 0, pa2); else if ((g) == 10) A3_PK4(P1, 8, pa3); } } while (0)
#define A3_STEP(EVEN, s, P0, P1, N0, N1, sv_, sk_, skn_) do { float pmax_, alpha_; bf16x8 pa0, pa1, pa2, pa3; bf16x8 vf_[4]; \
    if (EVEN) { __syncthreads();        \
        if ((s) + 4 < NT) { A3_SWRITE(0, slot6((s) + 4)); A3_SWRITE(1, slot6((s) + 5)); } \
        if ((s) + 6 < NT) { A3_SLOAD(0, ((s) + 6) * KVBLK); A3_SLOAD(1, ((s) + 7) * KVBLK); } } \
    if (!PREF) { const lp kb_ = K_lds + (sk_) * SHM_K; \
      _Pragma("unroll") for (int d0 = 0; d0 < NQD; ++d0) { kf_[2 * d0] = *(lp8)(kb_ + kswz<DK>(r32, 2 * d0 + hi)); kf_[2 * d0 + 1] = *(lp8)(kb_ + kswz<DK>(32 + r32, 2 * d0 + hi)); } } \
    A3_SB(); \
    const lcp vp_ = (lcp)(V_lds + (sv_) * SHM_V + vrd); \
      \
    _Pragma("unroll") for (int d0 = 0; d0 < NQD; ++d0) { \
        if (d0 == 0) N0 = __builtin_amdgcn_mfma_f32_32x32x16_bf16(kf_[0], qr[0], negm, 0, 0, 0); else N0 = __builtin_amdgcn_mfma_f32_32x32x16_bf16(kf_[2 * d0], qr[d0], N0, 0, 0, 0); \
        A3_GAP1(2 * d0, P0, P1); A3_SB(); \
        if (d0 == 0) N1 = __builtin_amdgcn_mfma_f32_32x32x16_bf16(kf_[1], qr[0], negm, 0, 0, 0); else N1 = __builtin_amdgcn_mfma_f32_32x32x16_bf16(kf_[2 * d0 + 1], qr[d0], N1, 0, 0, 0); \
        if (d0 == NQD - 1) { vf_[0] = vfrag3(vp_ + v3_rd_off(0, 0)); vf_[1] = vfrag3(vp_ + v3_rd_off(0, 1)); vf_[2] = vfrag3(vp_ + v3_rd_off(0, 2)); vf_[3] = vfrag3(vp_ + v3_rd_off(0, 3)); } \
        A3_GAP1(2 * d0 + 1, P0, P1); A3_SB(); } \
      \
    { float mxa_ = ATT_MX3(N0[0], N0[1], N1[0]), mxb_ = ATT_MX3(N0[2], N0[3], N1[1]); \
      o0 = __builtin_amdgcn_mfma_f32_32x32x16_bf16(pa0, vf_[0], o0, 0, 0, 0); mxa_ = ATT_MX3(mxa_, N1[2], N1[3]); A3_MX4(N0, N1, 4); A3_SB(); \
      o0 = __builtin_amdgcn_mfma_f32_32x32x16_bf16(pa1, vf_[1], o0, 0, 0, 0); A3_MX4(N0, N1, 8); A3_SB(); \
      o0 = __builtin_amdgcn_mfma_f32_32x32x16_bf16(pa2, vf_[2], o0, 0, 0, 0); A3_MX4(N0, N1, 12); A3_SB(); \
      o0 = __builtin_amdgcn_mfma_f32_32x32x16_bf16(pa3, vf_[3], o0, 0, 0, 0); \
      vf_[0] = vfrag3(vp_ + v3_rd_off(1, 0)); vf_[1] = vfrag3(vp_ + v3_rd_off(1, 1)); vf_[2] = vfrag3(vp_ + v3_rd_off(1, 2)); vf_[3] = vfrag3(vp_ + v3_rd_off(1, 3)); \
      { float m_ = fmaxf(mxa_, mxb_); const auto rr_ = __builtin_amdgcn_permlane32_swap(__float_as_uint(m_), __float_as_uint(m_), false, false); pmax_ = fmaxf(__uint_as_float(rr_[0]), __uint_as_float(rr_[1])); } \
      A3_SB(); } \
    A3_DECIDE(N0, N1, pmax_, false, alpha_); \
    A3_SB(); \
      \
    lacc = __builtin_amdgcn_mfma_f32_32x32x16_bf16(pa0, ones, lacc, 0, 0, 0); A3_KPF(0, skn_); N0[0] = __builtin_amdgcn_exp2f(N0[0]); N0[1] = __builtin_amdgcn_exp2f(N0[1]); asm volatile("" : "+v"(N0)); A3_SB(); \
    lacc = __builtin_amdgcn_mfma_f32_32x32x16_bf16(pa1, ones, lacc, 0, 0, 0); A3_KPF(1, skn_); N0[2] = __builtin_amdgcn_exp2f(N0[2]); N0[3] = __builtin_amdgcn_exp2f(N0[3]); asm volatile("" : "+v"(N0)); A3_SB(); \
    lacc = __builtin_amdgcn_mfma_f32_32x32x16_bf16(pa2, ones, lacc, 0, 0, 0); A3_KPF(2, skn_); N0[4] = __builtin_amdgcn_exp2f(N0[4]); N0[5] = __builtin_amdgcn_exp2f(N0[5]); asm volatile("" : "+v"(N0)); A3_SB(); \
    lacc = __builtin_amdgcn_mfma_f32_32x32x16_bf16(pa3, ones, lacc, 0, 0, 0); A3_KPF(3, skn_); N0[6] = __builtin_amdgcn_exp2f(N0[6]); N0[7] = __builtin_amdgcn_exp2f(N0[7]); asm volatile("" : "+v"(N0)); A3_SB(); \
    o1 = __builtin_amdgcn_mfma_f32_32x32x16_bf16(pa0, vf_[0], o1, 0, 0, 0); N0[8] = __builtin_amdgcn_exp2f(N0[8]); N0[9] = __builtin_amdgcn_exp2f(N0[9]); asm volatile("" : "+v"(N0)); A3_SB(); \
    o1 = __builtin_amdgcn_mfma_f32_32x32x16_bf16(pa1, vf_[1], o1, 0, 0, 0); N0[10] = __builtin_amdgcn_exp2f(N0[10]); N0[11] = __builtin_amdgcn_exp2f(N0[11]); asm volatile("" : "+v"(N0)); A3_SB(); \
    o1 = __builtin_amdgcn_mfma_f32_32x32x16_bf16(pa2, vf_[2], o1, 0, 0, 0); N0[12] = __builtin_amdgcn_exp2f(N0[12]); N0[13] = __builtin_amdgcn_exp2f(N0[13]); asm volatile("" : "+v"(N0)); A3_SB(); \
    o1 = __builtin_amdgcn_mfma_f32_32x32x16_bf16(pa3, vf_[3], o1, 0, 0, 0); N0[14] = __builtin_amdgcn_exp2f(N0[14]); N0[15] = __builtin_amdgcn_exp2f(N0[15]); asm volatile("" : "+v"(N0)); A3_SB(); \
    if ((s) + 1 < NT) A3_RESC(alpha_); } while (0)
    const int NT = nkeys / KVBLK;
    constexpr bool PREF = true;
    bf16x8 kf_[2 * NQD];
    f32x16 pA0, pA1, pB0, pB1;
    __syncthreads();
    A3_SLOAD(0, 0); A3_SLOAD(1, KVBLK); A3_SWRITE(0, 0); A3_SWRITE(1, 1); A3_SLOAD(0, 2 * KVBLK); A3_SLOAD(1, 3 * KVBLK); A3_SWRITE(0, 2); A3_SWRITE(1, 3);
    if (4 < NT) { A3_SLOAD(0, 4 * KVBLK); A3_SLOAD(1, 5 * KVBLK); }
    __syncthreads();
    { float pmax_, alpha_; A3_QKT(pA0, pA1, 0); A3_ROWMAX(pA0, pA1, pmax_); A3_DECIDE(pA0, pA1, pmax_, true, alpha_); A3_EXP(pA0); (void)alpha_; }
    if (PREF) {
#pragma unroll
        for (int d0 = 0; d0 < NQD; ++d0) A3_KPF(d0, 1); }
    int r0_ = 0;
    for (int s = 0; s < NT; s += 2) {
        A3_STEP(true, s, pA0, pA1, pB0, pB1, r0_, r0_ + 1, (r0_ == 4 ? 0 : r0_ + 2));
        A3_STEP(false, s + 1, pB0, pB1, pA0, pA1, r0_ + 1, (r0_ == 4 ? 0 : r0_ + 2), (r0_ >= 3 ? r0_ - 3 : r0_ + 3));
        r0_ = (r0_ == 4) ? 0 : r0_ + 2;
    }
    __attribute__((address_space(1))) bf16_t* Ow = (__attribute__((address_space(1))) bf16_t*)(Ob + (long)(wid * QBLK) * LDO);
#pragma unroll
    for (int r = 0; r < 16; ++r) { const int orow = crow(r, hi); const float rl = __builtin_amdgcn_rcpf(lacc[r]);
        Ow[(long)orow * LDO + r32] = (bf16_t)(cvtpk_b(o0[r] * rl, 0.f) & 0xffffu); Ow[(long)orow * LDO + 32 + r32] = (bf16_t)(cvtpk_b(o1[r] * rl, 0.f) & 0xffffu); }
#undef A3_SLOAD
#undef A3_SWRITE
#undef A3_QKT
#undef A3_PK4
#undef A3_ROWMAX
#undef A3_DECIDE
#undef A3_EXP
#undef A3_RESC
#undef A3_STEP
#undef A3_SB
#undef A3_KPF
#undef slot6
#undef A3_EX4
#undef A3_MX4
#undef A3_GAP1
}
__device__ __forceinline__ unsigned pk4f8(float a, float b, float c, float d) { int w = 0; w = __builtin_amdgcn_cvt_pk_fp8_f32(a, b, w, false); w = __builtin_amdgcn_cvt_pk_fp8_f32(c, d, w, true); return (unsigned)w; }
template <int DK> struct Lds4 { static constexpr int NSL = 6, SHM_V = KVBLK * DV  , SHM_K = KVBLK * DK * 2, OFF_K = NSL * SHM_V, OFF_AL = OFF_K + NSL * SHM_K, BYTES = OFF_AL + NW * 64 * 4; };
template <int DK, int LDQ, int LDK, int LDO, bool QK8>
__device__ __forceinline__ void attn_unit4(const bf16_t* __restrict__ Qb, const bf16_t* __restrict__ Kh, const unsigned char* __restrict__ VT, bf16_t* __restrict__ Ob, int nkeys, __attribute__((address_space(3))) char* lds, int tid_in) {
    static_assert(QK8, "the tile step is written for e4m3 Q/K");
    constexpr int KRB = (DK == 64) ? 64 : 128, KPC = KRB / 16;
    constexpr int SHM_V = Lds4<DK>::SHM_V, SHM_K = Lds4<DK>::SHM_K, NQD = DK / 16, KCH = DK / 8;
    int tid_ = tid_in; asm volatile("" : "+v"(tid_));
    const int tid = tid_, wid = tid >> 6, lane = tid & 63, r32 = lane & 31, hi = lane >> 5;
    typedef __attribute__((address_space(3))) char* lp; typedef __attribute__((address_space(3))) bf16x8* lp8;
    const lp V_lds = lds; const lp K_lds = lds + Lds4<DK>::OFF_K;
    typedef const __attribute__((address_space(1))) bf16x8* gptr8;
    float mhat = 0.f; f32x16 o0 = {}, o1 = {}, negm = {}; typedef float f4v_ __attribute__((ext_vector_type(4))); f4v_ lacc = {}; bf16x8 qr[NQD];
    typedef int i8v __attribute__((ext_vector_type(8))); typedef int i4v __attribute__((ext_vector_type(4)));
    constexpr bool LSUMV = (DK == 96) && !QK8;
    float lsum_ = 0.f;
    i8v q8 = {};
    i8v q8b = {};
    if (QK8) { const unsigned char* Q8 = (const unsigned char*)Qb + (long)(wid * QBLK + r32) * LDQ + hi * 32; const i4v a_ = *(const __attribute__((address_space(1))) i4v*)Q8, b_ = *(const __attribute__((address_space(1))) i4v*)(Q8 + 16);
        q8 = __builtin_shufflevector(a_, b_, 0, 1, 2, 3, 4, 5, 6, 7);
        if (DK == 96) { const i4v c_ = *(const __attribute__((address_space(1))) i4v*)(Q8 + 64), d_ = *(const __attribute__((address_space(1))) i4v*)(Q8 + 80); q8b = __builtin_shufflevector(c_, d_, 0, 1, 2, 3, 4, 5, 6, 7); } }
    else { const bf16_t* Qw = Qb + (long)(wid * QBLK + r32) * LDQ + hi * 8;
#pragma unroll
        for (int d0 = 0; d0 < NQD; ++d0) qr[d0] = *(gptr8)(Qw + d0 * 16); }
    const int vpc = (tid & 255) * 16;
    const int kp0 = QK8 ? (DK == 64 ? (tid & 255) : tid) : tid, kr0 = QK8 ? kp0 / KPC : kp0 / KCH, kc0 = QK8 ? kp0 % KPC : kp0 % KCH;
    const int kst0 = QK8 ? kr0 * KRB + ((kc0 ^ (DK == 64 ? ((kr0 >> 2) & 3) : ((kr0 >> 1) & 7))) << 4) : kswz<DK>(kr0, kc0);
    const bool k2 = (DK == 96) && !QK8 && (tid < 256);
    const unsigned vpcu_ = (unsigned)vpc, koff_ = (unsigned)(kr0 * LDK + kc0 * 16);
    const __amdgpu_buffer_rsrc_t rsV_ = __builtin_amdgcn_make_buffer_rsrc((void*)VT, 0, 0x7fffffff, 0x27000), rsK_ = __builtin_amdgcn_make_buffer_rsrc((void*)Kh, 0, 0x7fffffff, 0x27000);
    const int kp1 = k2 ? tid + 512 : tid, kr1 = kp1 / KCH, kc1 = kp1 % KCH, kst1 = kswz<DK>(kr1, kc1);
    const int vrow = lane & 31, vsw = (vrow >> 2) & 3;
    const int vrd = vrow * 64 + (((2 * hi) ^ vsw) << 4), vrd2 = vrow * 64 + (((2 * hi + 1) ^ vsw) << 4);
    const int ksz_ = (DK == 64) ? ((r32 >> 2) & 3) : ((r32 >> 1) & 7);
    const int kq0 = r32 * KRB + (((2 * hi) ^ ksz_) << 4), kq1 = r32 * KRB + (((2 * hi + 1) ^ ksz_) << 4);
    const int kq2 = r32 * KRB + (((4 + 2 * hi) ^ ksz_) << 4), kq3 = r32 * KRB + (((5 + 2 * hi) ^ ksz_) << 4);
    i8v kq_[4];
    bf16x8 sv[2], sk0[2], sk1[2];
#define A3_SLOAD(i, k0) do {   \
    sv[i] = __builtin_bit_cast(bf16x8, __builtin_amdgcn_raw_buffer_load_b128(rsV_, vpcu_, (int)(((k0) / KVBLK) * 4096), 0)); \
    if (QK8) sk0[i] = __builtin_bit_cast(bf16x8, __builtin_amdgcn_raw_buffer_load_b128(rsK_, koff_, (int)((k0) * LDK), 0)); else sk0[i] = *(gptr8)(&Kh[(long)((k0) + kr0) * LDK + kc0 * 8]); \
    if (DK == 96 && !QK8) sk1[i] = *(gptr8)(&Kh[(long)((k0) + kr1) * LDK + kc1 * 8]); } while (0)
#define A3_SWRITE(i, so) do { if (tid < 256) *(lp8)(V_lds + (so) * SHM_V + vpc) = sv[i]; if (!QK8 || DK == 96 || tid < 256) *(lp8)(K_lds + (so) * SHM_K + kst0) = sk0[i]; if (DK == 96 && !QK8) { if (k2) *(lp8)(K_lds + (so) * SHM_K + kst1) = sk1[i]; } } while (0)
#define A3_MXQ(OUT, A8) asm volatile("s_nop 0\n\tv_mfma_scale_f32_32x32x64_f8f6f4 %0, %1, %2, %3, %4, %4 op_sel_hi:[0,0,0]" : "=&v"(OUT) : "v"(A8), "v"(q8), "v"(negm), "v"(mxs_))
#define A3_KLD8(so) do { const lp kb_ = K_lds + (so) * SHM_K; const i4v a_ = *(__attribute__((address_space(3))) i4v*)(kb_ + kq0), b_ = *(__attribute__((address_space(3))) i4v*)(kb_ + kq1), c_ = *(__attribute__((address_space(3))) i4v*)(kb_ + 32 * KRB + kq0), d_ = *(__attribute__((address_space(3))) i4v*)(kb_ + 32 * KRB + kq1); \
    kq_[0] = __builtin_shufflevector(a_, b_, 0, 1, 2, 3, 4, 5, 6, 7); kq_[1] = __builtin_shufflevector(c_, d_, 0, 1, 2, 3, 4, 5, 6, 7); \
    if (DK == 96) { const i4v e_ = *(__attribute__((address_space(3))) i4v*)(kb_ + kq2), f_ = *(__attribute__((address_space(3))) i4v*)(kb_ + kq3), g_ = *(__attribute__((address_space(3))) i4v*)(kb_ + 32 * KRB + kq2), h_ = *(__attribute__((address_space(3))) i4v*)(kb_ + 32 * KRB + kq3); \
        kq_[2] = __builtin_shufflevector(e_, f_, 0, 1, 2, 3, 4, 5, 6, 7); kq_[3] = __builtin_shufflevector(g_, h_, 0, 1, 2, 3, 4, 5, 6, 7); } } while (0)
#define A3_MXQ2(ACC, A8) asm volatile("s_nop 0\n\tv_mfma_scale_f32_32x32x64_f8f6f4 %0, %1, %2, %0, %3, %3 op_sel_hi:[0,0,0]" : "+v"(ACC) : "v"(A8), "v"(q8b), "v"(mxs_))
#define A3_QKT(P0, P1, so) do { if (QK8) { A3_KLD8(so); A3_MXQ(P0, kq_[0]); A3_MXQ(P1, kq_[1]); if (DK == 96) { asm volatile("s_nop 15\n\ts_nop 15" : "+v"(P0), "+v"(P1)); A3_MXQ2(P0, kq_[2]); A3_MXQ2(P1, kq_[3]); }     asm volatile("s_nop 15\n\ts_nop 15" : "+v"(P0), "+v"(P1)); } else { const lp kb_ = K_lds + (so) * SHM_K; \
    _Pragma("unroll") for (int d0 = 0; d0 < NQD; ++d0) { const bf16x8 b0_ = *(lp8)(kb_ + kswz<DK>(r32, 2 * d0 + hi)), b1_ = *(lp8)(kb_ + kswz<DK>(32 + r32, 2 * d0 + hi)); \
        if (d0 == 0) { P0 = __builtin_amdgcn_mfma_f32_32x32x16_bf16(b0_, qr[0], negm, 0, 0, 0); P1 = __builtin_amdgcn_mfma_f32_32x32x16_bf16(b1_, qr[0], negm, 0, 0, 0); } \
        else { P0 = __builtin_amdgcn_mfma_f32_32x32x16_bf16(b0_, qr[d0], P0, 0, 0, 0); P1 = __builtin_amdgcn_mfma_f32_32x32x16_bf16(b1_, qr[d0], P1, 0, 0, 0); } } } } while (0)
#define A3_PK4(P, BASE, IDX) do { p8_[IDX] = __builtin_amdgcn_cvt_pk_fp8_f32(P[BASE + 0], P[BASE + 1], p8_[IDX], false); p8_[IDX] = __builtin_amdgcn_cvt_pk_fp8_f32(P[BASE + 2], P[BASE + 3], p8_[IDX], true); \
    p8_[IDX + 1] = __builtin_amdgcn_cvt_pk_fp8_f32(P[BASE + 4], P[BASE + 5], p8_[IDX + 1], false); p8_[IDX + 1] = __builtin_amdgcn_cvt_pk_fp8_f32(P[BASE + 6], P[BASE + 7], p8_[IDX + 1], true); } while (0)
#define A3_ROWMAX(P0, P1, OUT) do { float a_ = ATT_MX3(P0[0], P0[1], P1[0]), b_ = ATT_MX3(P0[2], P0[3], P1[1]); a_ = ATT_MX3(a_, P1[2], P1[3]); \
    _Pragma("unroll") for (int r = 4; r < 16; r += 4) { a_ = ATT_MX3(a_, P0[r], P0[r + 1]); b_ = ATT_MX3(b_, P0[r + 2], P0[r + 3]); a_ = ATT_MX3(a_, P1[r], P1[r + 1]); b_ = ATT_MX3(b_, P1[r + 2], P1[r + 3]); } \
    float m_ = fmaxf(a_, b_); const auto rr_ = __builtin_amdgcn_permlane32_swap(__float_as_uint(m_), __float_as_uint(m_), false, false); OUT = fmaxf(__uint_as_float(rr_[0]), __uint_as_float(rr_[1])); } while (0)
#define A3_DECIDE(P0, P1, PMAX, FIRST, ALPHA) do { ALPHA = 1.f; if (__builtin_expect((FIRST) || __any(PMAX > THR), 0)) { const float dl_ = (FIRST) ? PMAX : fmaxf(PMAX, 0.f); mhat += dl_; const float nm_ = -mhat; \
    _Pragma("unroll") for (int r = 0; r < 16; ++r) { asm volatile("v_sub_f32_e32 %0, %0, %1" : "+v"(P0[r]) : "v"(dl_)); asm volatile("v_sub_f32_e32 %0, %0, %1" : "+v"(P1[r]) : "v"(dl_)); } \
    _Pragma("unroll") for (int r = 0; r < 16; ++r) asm volatile("v_mov_b32_e32 %0, %1" : "+v"(negm[r]) : "v"(nm_)); \
    ALPHA = (FIRST) ? 1.f : __builtin_amdgcn_exp2f(-dl_); } } while (0)
#define A3_DECIDE2(P0, P1, MH, ALPHA, RARE, BETWEEN) do { ALPHA = 1.f; RARE = __ballot(MH > THR) != 0ull; BETWEEN; if (__builtin_expect(RARE, 0)) {       \
    const auto rr_ = __builtin_amdgcn_permlane32_swap(__float_as_uint(MH), __float_as_uint(MH), false, false); const float pm_ = fmaxf(__uint_as_float(rr_[0]), __uint_as_float(rr_[1])); \
    const float dl_ = fmaxf(pm_, 0.f); mhat += dl_; const float nm_ = -mhat; \
    _Pragma("unroll") for (int r = 0; r < 16; ++r) { asm volatile("v_sub_f32_e32 %0, %0, %1" : "+v"(P0[r]) : "v"(dl_)); asm volatile("v_sub_f32_e32 %0, %0, %1" : "+v"(P1[r]) : "v"(dl_)); } \
    _Pragma("unroll") for (int r = 0; r < 16; ++r) asm volatile("v_mov_b32_e32 %0, %1" : "+v"(negm[r]) : "v"(nm_)); \
    ALPHA = __builtin_amdgcn_exp2f(-dl_); } } while (0)
#define A3_EXP(P) do { _Pragma("unroll") for (int r = 0; r < 16; ++r) P[r] = __builtin_amdgcn_exp2f(P[r]); } while (0)
#define A3_RESC2(a) do { { const float f_ = (a); asm volatile("s_nop 15\n\ts_nop 15" : "+v"(o0), "+v"(o1)); if (!LSUMV) asm volatile("" : "+v"(lacc)); \
    lsum_ *= f_; _Pragma("unroll") for (int r = 0; r < 16; ++r) { o0[r] *= f_; o1[r] *= f_; } if (!LSUMV) lacc *= f_; } } while (0)
#define A3_RESC(a) do { if (__any((a) < 1.f)) { const float f_ = (a); asm volatile("s_nop 15\n\ts_nop 15" : "+v"(o0), "+v"(o1)); if (!LSUMV) asm volatile("" : "+v"(lacc)); \
    lsum_ *= f_; _Pragma("unroll") for (int r = 0; r < 16; ++r) { o0[r] *= f_; o1[r] *= f_; } if (!LSUMV) lacc *= f_; } } while (0)
    const int onev_ = ((((lane >> 4) ^ lane) & 1) == 0) ? 0x38383838 : 0;
    i8v ones = {onev_, onev_, onev_, onev_, onev_, onev_, onev_, onev_}; asm volatile("" : "+v"(ones));
    int mxs_ = 0x7F7F7F7F; asm volatile("" : "+v"(mxs_));
#define A3_MXL(ACC, A8, B8) asm volatile("s_nop 0\n\tv_mfma_scale_f32_16x16x128_f8f6f4 %0, %1, %2, %0, %3, %3 op_sel_hi:[0,0,0]" : "+v"(ACC) : "v"(A8), "v"(B8), "v"(mxs_))
#define A3_MX0(ACC, A8, B8) asm volatile("v_mfma_scale_f32_32x32x64_f8f6f4 %0, %1, %2, %0, %3, %3 op_sel_hi:[0,0,0]" : "+v"(ACC) : "v"(A8), "v"(B8), "v"(mxs_))
#define A3_MX(ACC, A8, B8) asm volatile("s_nop 1\n\tv_mfma_scale_f32_32x32x64_f8f6f4 %0, %1, %2, %0, %3, %3 op_sel_hi:[0,0,0]" : "+v"(ACC) : "v"(A8), "v"(B8), "v"(mxs_))
#define A3_SB() __builtin_amdgcn_sched_barrier(0)
#define A3_KPF(d0, so) do { if (QK8) { if (PREF && (d0) == 0) A3_KLD8(so); } else if (PREF && (d0) < NQD) { const lp kb_ = K_lds + (so) * SHM_K; kf_[2 * (d0)] = *(lp8)(kb_ + kswz<DK>(r32, 2 * (d0) + hi)); kf_[2 * (d0) + 1] = *(lp8)(kb_ + kswz<DK>(32 + r32, 2 * (d0) + hi)); } } while (0)
#define slot6(t) ((r0_ + ((t) - (s))) >= 6 ? (r0_ + ((t) - (s))) - 6 : (r0_ + ((t) - (s))))
#define A3_EX8(P, B) do { _Pragma("unroll") for (int r_ = 0; r_ < 8; ++r_) P[(B) + r_] = __builtin_amdgcn_exp2f(P[(B) + r_]); asm volatile("" : "+v"(P)); } while (0)
#define A3_EX4(P, B) do { P[B] = __builtin_amdgcn_exp2f(P[B]); P[B + 1] = __builtin_amdgcn_exp2f(P[B + 1]); P[B + 2] = __builtin_amdgcn_exp2f(P[B + 2]); P[B + 3] = __builtin_amdgcn_exp2f(P[B + 3]); asm volatile("" : "+v"(P)); } while (0)
#define A3_MX4(P0, P1, B) do { mxa_ = ATT_MX3(mxa_, P0[B], P0[B + 1]); mxb_ = ATT_MX3(mxb_, P0[B + 2], P0[B + 3]); mxa_ = ATT_MX3(mxa_, P1[B], P1[B + 1]); mxb_ = ATT_MX3(mxb_, P1[B + 2], P1[B + 3]); } while (0)
#define A3_GAP1(g, P0, P1) do { \
    if (NQD == 4 || !LSUMV) { if ((g) == 0) A3_PK4(P0, 0, 0); else if ((g) == 1) A3_PK4(P0, 8, 2); else if ((g) == 2) A3_EX4(P1, 0); else if ((g) == 3) A3_EX4(P1, 4); else if ((g) == 4) A3_EX4(P1, 8); else if ((g) == 5) A3_EX4(P1, 12); \
                    else if ((g) == 6) A3_PK4(P1, 0, 4); else if ((g) == 7) A3_PK4(P1, 8, 6); } \
    else { if ((g) == 1) { if (LSUMV) { float s_ = (P0[0] + P0[1]) + (P0[2] + P0[3]); _Pragma("unroll") for (int r = 4; r < 16; r += 4) s_ += (P0[r] + P0[r + 1]) + (P0[r + 2] + P0[r + 3]); lsum_ += s_; } } \
           else if ((g) == 7) { if (LSUMV) lsum_ += ((P1[0] + P1[1]) + (P1[2] + P1[3])) + ((P1[4] + P1[5]) + (P1[6] + P1[7])); } else if ((g) == 9) { if (LSUMV) lsum_ += ((P1[8] + P1[9]) + (P1[10] + P1[11])) + ((P1[12] + P1[13]) + (P1[14] + P1[15])); } \
           else if ((g) == 0) A3_PK4(P0, 0, 0); else if ((g) == 2) A3_PK4(P0, 8, 2); else if ((g) == 3) A3_EX4(P1, 0); else if ((g) == 4) A3_EX4(P1, 4); else if ((g) == 5) A3_EX4(P1, 8); else if ((g) == 6) A3_EX4(P1, 12); \
           else if ((g) == 8) A3_PK4(P1, 0, 4); else if ((g) == 10) A3_PK4(P1, 8, 6); } } while (0)
#define A3_VTLD() do { const i4v a_ = *(__attribute__((address_space(3))) i4v*)(vp_ + vrd), b_ = *(__attribute__((address_space(3))) i4v*)(vp_ + vrd2), c_ = *(__attribute__((address_space(3))) i4v*)(vp_ + 2048 + vrd), d_ = *(__attribute__((address_space(3))) i4v*)(vp_ + 2048 + vrd2); \
    vt0_ = __builtin_shufflevector(a_, b_, 0, 1, 2, 3, 4, 5, 6, 7); vt1_ = __builtin_shufflevector(c_, d_, 0, 1, 2, 3, 4, 5, 6, 7); } while (0)
#define A3_EX2(P, B) do { P[B] = __builtin_amdgcn_exp2f(P[B]); P[(B) + 1] = __builtin_amdgcn_exp2f(P[(B) + 1]); asm volatile("" : "+v"(P)); A3_SB(); } while (0)
#define A3_STEP(EVEN, s, P0, P1, N0, N1, sv_, sk_, skn_) do { float pmax_, alpha_; i8v vt0_, vt1_; \
    if (EVEN) { __syncthreads();        \
        if ((s) + 4 < NT) { A3_SWRITE(0, slot6((s) + 4)); A3_SWRITE(1, slot6((s) + 5)); } \
        if ((s) + 6 < NT) { A3_SLOAD(0, ((s) + 6) * KVBLK); A3_SLOAD(1, ((s) + 7) * KVBLK); } } \
    if (!PREF) A3_KLD8(sk_); \
    A3_SB(); \
    const lp vp_ = V_lds + (sv_) * SHM_V; \
      \
    A3_VTLD(); A3_MXQ(N0, kq_[0]); A3_SB(); A3_PK4(P0, 0, 0); A3_EX4(P1, 0); A3_SB(); \
    if (DK == 96) { A3_MXQ(N1, kq_[1]); A3_SB(); } \
    A3_PK4(P0, 8, 2); A3_EX4(P1, 4); A3_SB(); \
    if (DK == 96) { A3_MXQ2(N0, kq_[2]); A3_SB(); } else { A3_MXQ(N1, kq_[1]); A3_SB(); } \
    A3_EX4(P1, 8); A3_PK4(P1, 0, 4); A3_SB(); \
    if (DK == 96) { A3_MXQ2(N1, kq_[3]); A3_SB(); } \
    A3_EX4(P1, 12); A3_PK4(P1, 8, 6); A3_SB(); \
      \
    A3_MX(o0, vt0_, p8_); A3_SB(); \
    { float m0_, m1_, m2_, m3_;       \
      asm("v_max3_f32 %0, %4, %5, %6\n\tv_max3_f32 %1, %7, %8, %9\n\tv_max3_f32 %2, %10, %11, %12\n\tv_max3_f32 %3, %13, %14, %15\n\tv_max3_f32 %0, %0, %16, %17\n\tv_max3_f32 %1, %1, %18, %19" \
          : "=&v"(m0_), "=&v"(m1_), "=&v"(m2_), "=&v"(m3_) : "v"(N0[0]), "v"(N0[1]), "v"(N0[2]), "v"(N0[3]), "v"(N0[4]), "v"(N0[5]), "v"(N0[6]), "v"(N0[7]), "v"(N0[8]), "v"(N0[9]), "v"(N0[10]), "v"(N0[11]), "v"(N0[12]), "v"(N0[13]), "v"(N0[14]), "v"(N0[15])); \
      asm("v_max3_f32 %2, %2, %4, %5\n\tv_max3_f32 %3, %3, %6, %7\n\tv_max3_f32 %0, %0, %8, %9\n\tv_max3_f32 %1, %1, %10, %11\n\tv_max3_f32 %2, %2, %12, %13\n\tv_max3_f32 %3, %3, %14, %15\n\tv_max3_f32 %0, %0, %16, %17\n\tv_max3_f32 %1, %1, %18, %19\n\tv_max3_f32 %0, %0, %2, %3\n\tv_max_f32_e32 %0, %0, %1" \
          : "+v"(m0_), "+v"(m1_), "+v"(m2_), "+v"(m3_) : "v"(N1[0]), "v"(N1[1]), "v"(N1[2]), "v"(N1[3]), "v"(N1[4]), "v"(N1[5]), "v"(N1[6]), "v"(N1[7]), "v"(N1[8]), "v"(N1[9]), "v"(N1[10]), "v"(N1[11]), "v"(N1[12]), "v"(N1[13]), "v"(N1[14]), "v"(N1[15])); \
      pmax_ = m0_; \
      A3_SB(); \
      A3_MX0(o1, vt1_, p8_); A3_SB(); } \
    bool rare_; A3_DECIDE2(N0, N1, pmax_, alpha_, rare_, A3_KPF(0, skn_)); \
    A3_SB(); \
      \
    A3_EX8(N0, 0); A3_SB(); \
    if (!LSUMV) { A3_MXL(lacc, ones, p8_); A3_SB(); } \
    A3_EX8(N0, 8); A3_SB(); \
    if (rare_ && (s) + 1 < NT) A3_RESC2(alpha_); } while (0)
    const int NT = nkeys / KVBLK;
    constexpr bool PREF = true;
    bf16x8 kf_[2 * NQD];
    f32x16 pA0, pA1, pB0, pB1; i8v p8_ = {};
    __syncthreads();
    A3_SLOAD(0, 0); A3_SLOAD(1, KVBLK); A3_SWRITE(0, 0); A3_SWRITE(1, 1); A3_SLOAD(0, 2 * KVBLK); A3_SLOAD(1, 3 * KVBLK); A3_SWRITE(0, 2); A3_SWRITE(1, 3);
    if (4 < NT) { A3_SLOAD(0, 4 * KVBLK); A3_SLOAD(1, 5 * KVBLK); }
    __syncthreads();
    { float pmax_, alpha_; A3_QKT(pA0, pA1, 0); A3_ROWMAX(pA0, pA1, pmax_); A3_DECIDE(pA0, pA1, pmax_, true, alpha_); A3_EXP(pA0); (void)alpha_; }
    if (PREF) {
#pragma unroll
        for (int d0 = 0; d0 < NQD; ++d0) A3_KPF(d0, 1); }
    int r0_ = 0;
    for (int s = 0; s < NT; s += 2) {
        A3_STEP(true, s, pA0, pA1, pB0, pB1, r0_, r0_ + 1, (r0_ == 4 ? 0 : r0_ + 2));
        A3_STEP(false, s + 1, pB0, pB1, pA0, pA1, r0_ + 1, (r0_ == 4 ? 0 : r0_ + 2), (r0_ >= 3 ? r0_ - 3 : r0_ + 3));
        r0_ = (r0_ == 4) ? 0 : r0_ + 2;
    }
    asm volatile("s_nop 15\n\ts_nop 15" : "+v"(o0), "+v"(o1)); if (!LSUMV) asm volatile("" : "+v"(lacc));
    { float lt_ = (r32 & 16) ? lacc[1] : lacc[0];
        if (LSUMV) { const auto rr_ = __builtin_amdgcn_permlane32_swap(__float_as_uint(lsum_), __float_as_uint(lsum_), false, false); lt_ = __uint_as_float(rr_[0]) + __uint_as_float(rr_[1]); }
        const float rl = __builtin_amdgcn_rcpf(lt_);
        __attribute__((address_space(1))) bf16_t* Ow = (__attribute__((address_space(1))) bf16_t*)(Ob + (long)(wid * QBLK + r32) * LDO);
        typedef unsigned u4v_ __attribute__((ext_vector_type(4)));
#pragma unroll
        for (int blk = 0; blk < 2; ++blk)
#pragma unroll
            for (int j = 0; j < 2; ++j) { const int ga = 8 * j, gb = 8 * j + 4;
                const unsigned ax = blk ? cvtpk_b(o1[ga] * rl, o1[ga + 1] * rl) : cvtpk_b(o0[ga] * rl, o0[ga + 1] * rl), ay = blk ? cvtpk_b(o1[ga + 2] * rl, o1[ga + 3] * rl) : cvtpk_b(o0[ga + 2] * rl, o0[ga + 3] * rl);
                const unsigned bx = blk ? cvtpk_b(o1[gb] * rl, o1[gb + 1] * rl) : cvtpk_b(o0[gb] * rl, o0[gb + 1] * rl), by = blk ? cvtpk_b(o1[gb + 2] * rl, o1[gb + 3] * rl) : cvtpk_b(o0[gb + 2] * rl, o0[gb + 3] * rl);
                const auto rx = __builtin_amdgcn_permlane32_swap(ax, bx, false, false), ry = __builtin_amdgcn_permlane32_swap(ay, by, false, false);
                const u4v_ w = {rx[0], ry[0], rx[1], ry[1]};
                *(__attribute__((address_space(1))) u4v_*)(Ow + 32 * blk + 16 * j + 8 * hi) = w; } }
#undef A3_MX
#undef A3_MX0
#undef A3_MXL
#undef A3_MXQ
#undef A3_MXQ2
#undef A3_KLD8
#undef A3_SLOAD
#undef A3_SWRITE
#undef A3_QKT
#undef A3_PK4
#undef A3_ROWMAX
#undef A3_DECIDE
#undef A3_EXP
#undef A3_RESC
#undef A3_RESC2
#undef A3_STEP
#undef A3_SB
#undef A3_KPF
#undef slot6
#undef A3_EX4
#undef A3_EX8
#undef A3_MX4
#undef A3_GAP1
#undef A3_VTLD
#undef A3_DECIDE2
#undef A3_EX2
}
#undef ATT_SBAR
}

constexpr int NWAVES = 8;
constexpr int BATCH = 4, SEQ = 8192, CTXL = 256, D = 1024, ROWS_B = CTXL + SEQ, M = BATCH * ROWS_B, NPAN = M / 256;
constexpr int MLAT = BATCH * SEQ;
constexpr int AB_IN = 1536, CD_IN = 1440, CD_INP = 1536, DFF = 2816, NEXP = 8;
constexpr int MOE_ROWS = 2 * M + NEXP * 256;
constexpr float EPS = 1e-6f;
static_assert(M == 33792 && NPAN == 132 && NPAN == BATCH * pg8::PAN_B, "row layout");

#ifndef HDP_FP8
#define HDP_FP8 14
#endif
constexpr int FP8G2 = (HDP_FP8 & 8) != 0;
constexpr bool FP8F = (HDP_FP8 & 1) != 0, FP8M = (HDP_FP8 & 2) != 0, FP8D = FP8F || (HDP_FP8 & 4) != 0;
#ifndef HDP_MX
#define HDP_MX 2
#endif
constexpr int MXM = HDP_MX;
#ifndef HDP_MOE_SP2
#define HDP_MOE_SP2 0
#endif
constexpr bool MOE_SP2 = HDP_MOE_SP2 != 0;
#ifndef HDP_MOE_ALIGN
#define HDP_MOE_ALIGN 1
#endif
constexpr bool MOE_ALIGN = HDP_MOE_ALIGN != 0;
constexpr float WSC = 64.0f, WSC_INV = 1.0f / 64.0f;
constexpr size_t MiB = 1u << 20;
constexpr size_t WS_CTL = 0, CTL_ZERO_BYTES = 1 * MiB;
constexpr size_t WS_MOD = 1 * MiB;
constexpr size_t WS_TOPK = 2 * MiB;
constexpr size_t WS_TOKSLOT = 3 * MiB;
constexpr size_t WS_CNT = 3 * MiB + 512 * 1024;
constexpr size_t WS_PEXP = 3 * MiB + 768 * 1024;
constexpr size_t WS_ROPE = 4 * MiB;
constexpr size_t WS_WSMALL = 5 * MiB;
constexpr size_t EV_WIN = 0, EV_WS = 3 * MiB, EV_WPOOL = EV_WS + 128 * 1024, EV_WOUT = EV_WPOOL + 128 * 1024, EV_WGU = EV_WOUT + 2 * MiB, EV_WDN = EV_WGU + 11 * MiB, EV_STRIDE = EV_WDN + 5632 * 1024;
constexpr size_t WS_WODD = WS_WSMALL + 2 * EV_STRIDE;
constexpr size_t OD_WCD = 0, OD_WUQ = 3 * MiB, OD_WUKV = OD_WUQ + 576 * 1024, OD_WCDO = OD_WUKV + 512 * 1024, OD_STRIDE = OD_WCDO + 2 * MiB;
constexpr size_t WS_WMOE = (WS_WODD + 2 * OD_STRIDE + MiB - 1) / MiB * MiB;
constexpr size_t MOE_WGU = (size_t)5632 * 1024 * 2, MOE_WDN = (size_t)1024 * 2816 * 2, MOE_WDN_OFF = NEXP * MOE_WGU;
constexpr size_t MOE_WGU8 = (size_t)5632 * 1024, MOE_WDN8 = (size_t)1024 * 2816, MOE_WDN_OFF8 = NEXP * MOE_WGU8;
constexpr size_t WS_XS = WS_WMOE + NEXP * (MOE_WGU + MOE_WDN);
constexpr size_t WS_BIG = WS_XS + (size_t)M * D * 2;
constexpr size_t B_Z = 0;
constexpr size_t B_Y = B_Z + (size_t)M * 1536 * 2;
constexpr size_t B_HB = B_Y + (size_t)M * 1024 * 2;
constexpr size_t B_QC = B_Y + (size_t)M * 1024 * 2;
constexpr size_t B_KC = B_QC + (size_t)M * 512 * 2;
constexpr size_t B_CQN = B_KC + (size_t)M * 128 * 2;
constexpr size_t B_CKVN = B_CQN + (size_t)M * 384 * 2;
constexpr size_t B_QD = B_CKVN + (size_t)M * 256 * 2;
constexpr size_t B_KD = B_QD + (size_t)M * 768 * 2;
constexpr size_t B_VD = B_KD + (size_t)M * 768 * 2;
constexpr size_t B_VT8 = B_VD + (size_t)M * 512 * 2;
constexpr size_t B_QC8 = B_VT8 + (size_t)BATCH * 10 * (ROWS_B / 64) * 4096;
constexpr size_t B_KC8 = B_QC8 + (size_t)M * 512;
constexpr size_t B_ATT_END = B_KC8 + (size_t)M * 128;
constexpr size_t B_HS = 0;
constexpr size_t B_HM = B_HS + (size_t)MOE_ROWS * 1024 * 2;
constexpr size_t B_END = B_HM + (size_t)MOE_ROWS * 2816 * 2;
constexpr size_t B_H = B_END - (size_t)M * 1024 * 2;
static_assert(B_HB + (size_t)M * 2816 * 2 <= B_H && B_ATT_END <= B_H, "H must stay clear of the even-layer / attention buffers");
constexpr size_t WS_END = WS_BIG + B_END;

constexpr int RING_OFF = 0, RING_BYTES = 131072;
constexpr int LDSCTL_OFF = RING_BYTES, MISC_OFF = LDSCTL_OFF + 320;
constexpr int LDS_BYTES = 147456;
static_assert(att::Lds3<96>::BYTES <= RING_BYTES && att::Lds4<96>::BYTES <= RING_BYTES && pg8::STAGE_BYTES <= RING_BYTES, "LDS");

typedef unsigned short bf16;
typedef unsigned v4u __attribute__((ext_vector_type(4)));
typedef unsigned v2u __attribute__((ext_vector_type(2)));
typedef float f32x4 __attribute__((ext_vector_type(4)));
typedef short bf16x8 __attribute__((ext_vector_type(8)));
#define LDS_WAIT() asm volatile("s_waitcnt lgkmcnt(0)" ::: "memory")
#define VM_WAIT() asm volatile("s_waitcnt vmcnt(0)" ::: "memory")
__device__ __forceinline__ unsigned pk2(float lo, float hi) { unsigned r; asm volatile("v_cvt_pk_bf16_f32 %0, %1, %2" : "=v"(r) : "v"(lo), "v"(hi)); return r; }
__device__ __forceinline__ float bf_lo(unsigned w) { return __uint_as_float(w << 16); }
__device__ __forceinline__ float bf_hi(unsigned w) { return __uint_as_float(w & 0xffff0000u); }
__device__ __forceinline__ float bf1(unsigned short h) { return __uint_as_float(((unsigned)h) << 16); }
__device__ __forceinline__ float wave_sum(float v) {
#pragma unroll
    for (int o = 1; o < 64; o <<= 1) v += __shfl_xor(v, o);
    return v;
}
typedef unsigned short xs_t;
__device__ __forceinline__ v2u xs_ld(const xs_t* XS, size_t row, int lane, int q) { return *((const v2u*)(XS + row * D) + lane + 64 * q); }
__device__ __forceinline__ f32x4 xs_cvt(v2u r) { return (f32x4){bf_lo(r.x), bf_hi(r.x), bf_lo(r.y), bf_hi(r.y)}; }
__device__ __forceinline__ void xs_st(xs_t* XS, size_t row, int lane, int q, f32x4 v) { v2u o; o.x = pk2(v[0], v[1]); o.y = pk2(v[2], v[3]); *((v2u*)(XS + row * D) + lane + 64 * q) = o; }

struct Args { const float* in[29]; float* out; unsigned char* ws; int ph_lo, ph_hi; };
enum { I_X = 0, I_C, I_CTX, I_CCTX, I_ADAW, I_ADAB, I_ABWIN, I_AVGAIN, I_AWS, I_ABS, I_BWPOOL, I_BSCALE, I_ABWOUT, I_FFNG, I_FFNU, I_FFND, I_CDWIN, I_CQGAIN, I_CKGAIN, I_DCQGAIN,
       I_DCKVGAIN, I_DWUQ, I_DWUKV, I_CDWOUT, I_ROUTER, I_MOEG, I_MOEU, I_MOED, I_FGAIN };
struct Ctx {
    LAS unsigned char* lds; unsigned char* ldsg;
    int tid, lane, wave, vcu, G, bx;
    GAS unsigned char* ws;
};
__device__ __forceinline__ int modrow_of_row(int row) { const int b = row / ROWS_B; return (row - b * ROWS_B < CTXL) ? 4 : b; }

__device__ __forceinline__ void tr_item(const float* W, int K, int N, bf16* WT, int il, int off, LAS float* scr, int item, int lane) {
    const int nblk = N / 32, kb = item / nblk, nb = item - kb * nblk, k0 = 64 * kb, n0 = 32 * nb;
    float wv[32];
#pragma unroll
    for (int i = 0; i < 32; ++i) wv[i] = W[(size_t)(k0 + 2 * i + (lane >> 5)) * N + n0 + (lane & 31)];
#pragma unroll
    for (int i = 0; i < 32; ++i) scr[(2 * i + (lane >> 5)) * 33 + (lane & 31)] = wv[i];
    LDS_WAIT(); asm volatile("" ::: "memory");
    const int c = lane & 7;
#pragma unroll
    for (int j = 0; j < 4; ++j) { const int n = (lane >> 3) + 8 * j; const LAS float* s = scr + (8 * c) * 33 + n;
        v4u o; o.x = pk2(s[0 * 33], s[1 * 33]); o.y = pk2(s[2 * 33], s[3 * 33]); o.z = pk2(s[4 * 33], s[5 * 33]); o.w = pk2(s[6 * 33], s[7 * 33]);
        const int nn = n0 + n; const int drow = il ? ((nn >> 7) * 256 + (nn & 127) + off) : (nn + off);
        *(v4u*)(WT + (size_t)drow * K + k0 + 8 * c) = o; }
    LDS_WAIT(); asm volatile("" ::: "memory");
}
__device__ __forceinline__ void tr_item8(const float* W, int K, int N, unsigned char* WT, int il, int off, LAS float* scr, int item, int lane) {
    const int nblk = N / 32, kb = item / nblk, nb = item - kb * nblk, k0 = 64 * kb, n0 = 32 * nb;
    float wv[32];
#pragma unroll
    for (int i = 0; i < 32; ++i) wv[i] = W[(size_t)(k0 + 2 * i + (lane >> 5)) * N + n0 + (lane & 31)];
#pragma unroll
    for (int i = 0; i < 32; ++i) scr[(2 * i + (lane >> 5)) * 33 + (lane & 31)] = wv[i];
    LDS_WAIT(); asm volatile("" ::: "memory");
    const int n = lane >> 1, hf = lane & 1; const LAS float* s = scr + (32 * hf) * 33 + n;
    v4u o0, o1;
    o0.x = pg8::pk4_fp8(s[0 * 33] * WSC, s[1 * 33] * WSC, s[2 * 33] * WSC, s[3 * 33] * WSC);     o0.y = pg8::pk4_fp8(s[4 * 33] * WSC, s[5 * 33] * WSC, s[6 * 33] * WSC, s[7 * 33] * WSC);
    o0.z = pg8::pk4_fp8(s[8 * 33] * WSC, s[9 * 33] * WSC, s[10 * 33] * WSC, s[11 * 33] * WSC);   o0.w = pg8::pk4_fp8(s[12 * 33] * WSC, s[13 * 33] * WSC, s[14 * 33] * WSC, s[15 * 33] * WSC);
    o1.x = pg8::pk4_fp8(s[16 * 33] * WSC, s[17 * 33] * WSC, s[18 * 33] * WSC, s[19 * 33] * WSC); o1.y = pg8::pk4_fp8(s[20 * 33] * WSC, s[21 * 33] * WSC, s[22 * 33] * WSC, s[23 * 33] * WSC);
    o1.z = pg8::pk4_fp8(s[24 * 33] * WSC, s[25 * 33] * WSC, s[26 * 33] * WSC, s[27 * 33] * WSC); o1.w = pg8::pk4_fp8(s[28 * 33] * WSC, s[29 * 33] * WSC, s[30 * 33] * WSC, s[31 * 33] * WSC);
    const int nn = n0 + n; const int drow = il ? ((nn >> 7) * 256 + (nn & 127) + off) : (nn + off);
    unsigned char* dst = WT + (size_t)drow * K + k0 + 32 * hf;
    *(v4u*)dst = o0; *(v4u*)(dst + 16) = o1;
    LDS_WAIT(); asm volatile("" ::: "memory");
}
struct MatDesc { const float* W; bf16* WT; int K, N, il, off, f8; };
__device__ __forceinline__ MatDesc small_desc(const Args& a, unsigned char* ws, int m) {
    const int i = m / 13, k = m - i * 13; MatDesc d; d.il = 0; d.off = 0; d.f8 = (((FP8F || (FP8G2 && i == 1)) && (k == 6 || k == 7)) || (FP8D && k == 8)) ? 1 : 0;
    unsigned char* ev = ws + WS_WSMALL + (size_t)i * EV_STRIDE; unsigned char* od = ws + WS_WODD + (size_t)i * OD_STRIDE;
    if (k == 0)       { d.W = a.in[I_ABWIN] + (size_t)i * 1024 * 1536; d.K = 1024; d.N = 1536; d.WT = (bf16*)(ev + EV_WIN); }
    else if (k <= 4)  { d.W = a.in[I_BWPOOL] + (size_t)(i * 4 + k - 1) * 128 * 128; d.K = 128; d.N = 128; d.WT = (bf16*)(ev + EV_WPOOL) + (size_t)(k - 1) * 128 * 128; }
    else if (k == 5)  { d.W = a.in[I_ABWOUT] + (size_t)i * 1024 * 1024; d.K = 1024; d.N = 1024; d.WT = (bf16*)(ev + EV_WOUT); }
    else if (k == 6)  { d.W = a.in[I_FFNG] + (size_t)i * 1024 * DFF; d.K = 1024; d.N = DFF; d.WT = (bf16*)(ev + EV_WGU); d.il = 1; }
    else if (k == 7)  { d.W = a.in[I_FFNU] + (size_t)i * 1024 * DFF; d.K = 1024; d.N = DFF; d.WT = (bf16*)(ev + EV_WGU); d.il = 1; d.off = 128; }
    else if (k == 8)  { d.W = a.in[I_FFND] + (size_t)i * DFF * 1024; d.K = DFF; d.N = 1024; d.WT = (bf16*)(ev + EV_WDN); }
    else if (k == 9)  { d.W = a.in[I_CDWIN] + (size_t)i * 1024 * CD_IN; d.K = 1024; d.N = CD_IN; d.WT = (bf16*)(od + OD_WCD); }
    else if (k == 10) { d.W = a.in[I_DWUQ] + (size_t)i * 384 * 768; d.K = 384; d.N = 768; d.WT = (bf16*)(od + OD_WUQ); }
    else if (k == 11) { d.W = a.in[I_DWUKV] + (size_t)i * 256 * 1024; d.K = 256; d.N = 1024; d.WT = (bf16*)(od + OD_WUKV); }
    else              { d.W = a.in[I_CDWOUT] + (size_t)i * 1024 * 1024; d.K = 1024; d.N = 1024; d.WT = (bf16*)(od + OD_WCDO); }
    return d;
}
__device__ __forceinline__ MatDesc moe_desc(const Args& a, unsigned char* ws, int li, int m) {
    const int e = m / 3, k = m - e * 3; MatDesc d; d.il = 0; d.off = 0; d.f8 = FP8M ? 1 : 0;
    const size_t wgu = FP8M ? MOE_WGU8 : MOE_WGU, wdn = FP8M ? MOE_WDN8 : MOE_WDN, wdo = FP8M ? MOE_WDN_OFF8 : MOE_WDN_OFF;
    if (k == 0)      { d.W = a.in[I_MOEG] + (size_t)(li * NEXP + e) * 1024 * DFF; d.K = 1024; d.N = DFF; d.WT = (bf16*)(ws + WS_WMOE + (size_t)e * wgu); d.il = 1; }
    else if (k == 1) { d.W = a.in[I_MOEU] + (size_t)(li * NEXP + e) * 1024 * DFF; d.K = 1024; d.N = DFF; d.WT = (bf16*)(ws + WS_WMOE + (size_t)e * wgu); d.il = 1; d.off = 128; }
    else             { d.W = a.in[I_MOED] + (size_t)(li * NEXP + e) * DFF * 1024; d.K = DFF; d.N = 1024; d.WT = (bf16*)(ws + WS_WMOE + wdo + (size_t)e * wdn); }
    return d;
}
__device__ __forceinline__ void convert_small(const Ctx& F, const Args& a) {
    LAS float* scr = (LAS float*)(F.lds + RING_OFF + F.wave * 16384);
    const int gw = F.vcu * NWAVES + F.wave, NGW = F.G * NWAVES;
    int it = gw, base = 0;
    for (int m = 0; m < 26; ++m) { const MatDesc d = small_desc(a, (unsigned char*)F.ws, m); const int items = (d.K / 64) * (d.N / 32);
        for (; it < base + items; it += NGW) { if (d.f8) tr_item8(d.W, d.K, d.N, (unsigned char*)d.WT, d.il, d.off, scr, it - base, F.lane); else tr_item(d.W, d.K, d.N, d.WT, d.il, d.off, scr, it - base, F.lane); }
        base += items; }
    const int gt = F.vcu * (NWAVES * 64) + F.tid, NGT = F.G * NWAVES * 64;
    for (int i = gt; i < 2 * 96 * 1024 / 8; i += NGT) { const int l = i / (96 * 128), r = i - l * (96 * 128);
        *(v4u*)(F.ws + WS_WODD + (size_t)l * OD_STRIDE + OD_WCD + (size_t)CD_IN * 1024 * 2 + (size_t)r * 16) = (v4u){0u, 0u, 0u, 0u}; }
    for (int i = gt; i < 2 * 4 * 128 * 128 / 8; i += NGT) { const int l = i / (4 * 128 * 128 / 8), r = i - l * (4 * 128 * 128 / 8);
        const f32x4 x0 = *(const f32x4*)(a.in[I_AWS] + (size_t)i * 8), x1 = *(const f32x4*)(a.in[I_AWS] + (size_t)i * 8 + 4);
        v4u o; o.x = pk2(x0[0], x0[1]); o.y = pk2(x0[2], x0[3]); o.z = pk2(x1[0], x1[1]); o.w = pk2(x1[2], x1[3]);
        *(v4u*)(F.ws + WS_WSMALL + (size_t)l * EV_STRIDE + EV_WS + (size_t)r * 16) = o; }
}
__device__ __forceinline__ void rope_table(const Ctx& F) {
    const int gt = F.vcu * (NWAVES * 64) + F.tid, NGT = F.G * NWAVES * 64; float* T = (float*)(F.ws + WS_ROPE);
    for (int i = gt; i < SEQ * 32; i += NGT) { const int s = i >> 5, k = i & 31, t = k & 15;
        const float ang = (float)((t < 8) ? (s >> 6) : (s & 63)) * __builtin_amdgcn_exp2f(-(float)(t & 7) * (13.287712379549449f / 8.0f));
        T[i] = (k < 16) ? __cosf(ang) : __sinf(ang); }
}
__device__ __forceinline__ void convert_moe(const Ctx& F, const Args& a, int li) {
    LAS float* scr = (LAS float*)(F.lds + RING_OFF + F.wave * 16384);
    const int gw = F.vcu * NWAVES + F.wave, NGW = F.G * NWAVES;
    int it = gw, base = 0;
    for (int m = 0; m < 24; ++m) { const MatDesc d = moe_desc(a, (unsigned char*)F.ws, li, m); const int items = (d.K / 64) * (d.N / 32);
        for (; it < base + items; it += NGW) { if (d.f8) tr_item8(d.W, d.K, d.N, (unsigned char*)d.WT, d.il, d.off, scr, it - base, F.lane); else tr_item(d.W, d.K, d.N, d.WT, d.il, d.off, scr, it - base, F.lane); }
        base += items; }
}
__device__ __forceinline__ void adaln_phase(const Ctx& F, const Args& a) {
    LAS float* sc = (LAS float*)(F.lds + 65536);
    LAS float* red = (LAS float*)(F.lds + 65536 + 20480);
    __syncthreads();
    for (int idx = F.tid; idx < 5 * 1024; idx += NWAVES * 64) { const int r = idx >> 10, k = idx & 1023; const float v = (r < 4) ? a.in[I_C][r * 1024 + k] : a.in[I_CCTX][k];
        sc[idx] = v / (1.0f + __expf(-v)); }
    __syncthreads();
    float* MOD = (float*)(F.ws + WS_MOD);
    for (int task = F.bx; task < 4 * 96; task += F.G) { const int layer = task / 96, n0 = (task - layer * 96) * 64;
        const float* W = a.in[I_ADAW] + (size_t)layer * 1024 * 6144 + n0 + F.lane;
        float a0 = 0.f, a1 = 0.f, a2 = 0.f, a3 = 0.f, a4 = 0.f;
        for (int kb = F.wave * 128; kb < F.wave * 128 + 128; kb += 32) { float wv[32];
#pragma unroll
            for (int i = 0; i < 32; ++i) wv[i] = W[(size_t)(kb + i) * 6144];
#pragma unroll
            for (int i = 0; i < 32; ++i) { const float w = wv[i]; const int k = kb + i;
                a0 += sc[k] * w; a1 += sc[1024 + k] * w; a2 += sc[2048 + k] * w; a3 += sc[3072 + k] * w; a4 += sc[4096 + k] * w; } }
        red[(F.wave * 5 + 0) * 64 + F.lane] = a0; red[(F.wave * 5 + 1) * 64 + F.lane] = a1; red[(F.wave * 5 + 2) * 64 + F.lane] = a2; red[(F.wave * 5 + 3) * 64 + F.lane] = a3; red[(F.wave * 5 + 4) * 64 + F.lane] = a4;
        __syncthreads();
        if (F.wave < 5) { float s = a.in[I_ADAB][layer * 6144 + n0 + F.lane];
#pragma unroll
            for (int w = 0; w < 8; ++w) s += red[(w * 5 + F.wave) * 64 + F.lane];
            MOD[(size_t)(layer * 5 + F.wave) * 6144 + n0 + F.lane] = s; }
        __syncthreads();
    }
}

__device__ __forceinline__ float row_rstd(const f32x4 (&v)[4]) {
    float s = 0.f;
#pragma unroll
    for (int j = 0; j < 4; ++j) s += (v[j][0] * v[j][0] + v[j][1] * v[j][1]) + (v[j][2] * v[j][2] + v[j][3] * v[j][3]);
    return 1.0f / sqrtf(wave_sum(s) * (1.0f / 1024.0f) + EPS);
}
__device__ __forceinline__ void store_mod_row(const f32x4 (&v)[4], float rstd, const float* shift, const float* scale, bf16* hrow, int lane) {
#pragma unroll
    for (int j = 0; j < 4; ++j) { const f32x4 sc = *((const f32x4*)scale + lane + 64 * j), sh = *((const f32x4*)shift + lane + 64 * j);
        const f32x4 h = v[j] * rstd * (sc + 1.0f) + sh; v2u o; o.x = pk2(h[0], h[1]); o.y = pk2(h[2], h[3]);
        *((v2u*)hrow + lane + 64 * j) = o; }
}
__device__ __forceinline__ void store_mod_row8(const f32x4 (&v)[4], float rstd, const float* shift, const float* scale, unsigned char* hrow, int lane) {
#pragma unroll
    for (int j = 0; j < 4; ++j) { const f32x4 sc = *((const f32x4*)scale + lane + 64 * j), sh = *((const f32x4*)shift + lane + 64 * j);
        const f32x4 h = v[j] * rstd * (sc + 1.0f) + sh; *((unsigned*)hrow + lane + 64 * j) = pg8::pk4_fp8(h[0], h[1], h[2], h[3]); }
}
struct ModVec { f32x4 sc[4], sh[4]; };
__device__ __forceinline__ void modvec_load(ModVec& m, const float* shift, const float* scale, int lane) {
#pragma unroll
    for (int j = 0; j < 4; ++j) { m.sc[j] = *((const f32x4*)scale + lane + 64 * j) + 1.0f; m.sh[j] = *((const f32x4*)shift + lane + 64 * j); }
}
__device__ __forceinline__ void store_mod_row_v(const f32x4 (&v)[4], float rstd, const ModVec& m, bf16* hrow, int lane) {
#pragma unroll
    for (int j = 0; j < 4; ++j) { const f32x4 h = v[j] * rstd * m.sc[j] + m.sh[j]; v2u o; o.x = pk2(h[0], h[1]); o.y = pk2(h[2], h[3]); *((v2u*)hrow + lane + 64 * j) = o; }
}
__device__ __forceinline__ void store_mod_row8_v(const f32x4 (&v)[4], float rstd, const ModVec& m, unsigned char* hrow, int lane) {
#pragma unroll
    for (int j = 0; j < 4; ++j) { const f32x4 h = v[j] * rstd * m.sc[j] + m.sh[j]; *((unsigned*)hrow + lane + 64 * j) = pg8::pk4_fp8(h[0], h[1], h[2], h[3]); }
}
__device__ __forceinline__ void nm_phase(const Ctx& F, const Args& a, bool first, const float* modl, int shift_off, int scale_off, bool out8 = false) {
    const int gw = F.vcu * NWAVES + F.wave, NGW = F.G * NWAVES;
    const int rpw = (M + NGW - 1) / NGW, rbeg = gw * rpw, rend = (rbeg + rpw < M) ? rbeg + rpw : M;
    xs_t* XS = (xs_t*)(F.ws + WS_XS); bf16* H = (bf16*)(F.ws + WS_BIG + B_H);
    ModVec mv; int cur_mr = -1;
    if (first) {
        f32x4 nx[4];
#define NM_SRC(row_) ({ const int b_ = (row_) / ROWS_B, j_ = (row_) - b_ * ROWS_B; (j_ < CTXL) ? a.in[I_CTX] + (size_t)(b_ * CTXL + j_) * D : a.in[I_X] + (size_t)(b_ * SEQ + j_ - CTXL) * D; })
        if (rbeg < rend) { const float* s0 = NM_SRC(rbeg);
#pragma unroll
            for (int q = 0; q < 4; ++q) nx[q] = *((const f32x4*)s0 + F.lane + 64 * q); }
        for (int row = rbeg; row < rend; ++row) { const int mr = modrow_of_row(row);
            if (mr != cur_mr) { modvec_load(mv, modl + (size_t)mr * 6144 + shift_off, modl + (size_t)mr * 6144 + scale_off, F.lane); cur_mr = mr; }
            f32x4 v[4];
#pragma unroll
            for (int q = 0; q < 4; ++q) v[q] = nx[q];
            if (row + 1 < rend) { const float* s1 = NM_SRC(row + 1);
#pragma unroll
                for (int q = 0; q < 4; ++q) nx[q] = *((const f32x4*)s1 + F.lane + 64 * q); }
#pragma unroll
            for (int q = 0; q < 4; ++q) xs_st(XS, row, F.lane, q, v[q]);
            const float rstd = row_rstd(v);
            store_mod_row_v(v, rstd, mv, H + (size_t)row * D, F.lane);
        }
#undef NM_SRC
    } else {
        v2u nx[4], ny[4];
        if (rbeg < rend) {
#pragma unroll
            for (int q = 0; q < 4; ++q) nx[q] = xs_ld(XS, rbeg, F.lane, q); }
        if (rbeg + 1 < rend) {
#pragma unroll
            for (int q = 0; q < 4; ++q) ny[q] = xs_ld(XS, rbeg + 1, F.lane, q); }
        for (int row = rbeg; row < rend; ++row) { const int mr = modrow_of_row(row);
            if (mr != cur_mr) { modvec_load(mv, modl + (size_t)mr * 6144 + shift_off, modl + (size_t)mr * 6144 + scale_off, F.lane); cur_mr = mr; }
            f32x4 v[4];
#pragma unroll
            for (int q = 0; q < 4; ++q) { v[q] = xs_cvt(nx[q]); nx[q] = ny[q]; }
            if (row + 2 < rend) {
#pragma unroll
                for (int q = 0; q < 4; ++q) ny[q] = xs_ld(XS, row + 2, F.lane, q); }
            const float rstd = row_rstd(v);
            if (out8) store_mod_row8_v(v, rstd, mv, (unsigned char*)H + (size_t)row * D, F.lane);
            else store_mod_row_v(v, rstd, mv, H + (size_t)row * D, F.lane);
        }
    }
}

#ifndef AB_REP3
#define AB_REP3 1
#endif
#ifndef AB_REP4
#define AB_REP4 1
#endif
#ifndef AB_REP5
#define AB_REP5 1
#endif
__device__ __forceinline__ void abmid_unit(const Ctx& F, int c, int g, const bf16* Z, bf16* Y, const bf16* Wsb, const bf16* WpT, const float* vgain, const float* bsv, const float* pscale, int& cur_g) {
    typedef float f32x4v __attribute__((ext_vector_type(4)));
    const int r0 = c * 128, tid = F.tid, lane = F.lane, wave = F.wave;
    const int b = r0 / ROWS_B, j0 = r0 - b * ROWS_B;
    const int S0 = (j0 < CTXL) ? b * ROWS_B : b * ROWS_B + CTXL, S1 = (j0 < CTXL) ? b * ROWS_B + CTXL : (b + 1) * ROWS_B;
    LAS float* rstd = (LAS float*)F.lds;
    LAS unsigned short* T = (LAS unsigned short*)(F.lds + 1024);
    LAS unsigned short* P = (LAS unsigned short*)(F.lds + 1024 + 144 * 256);
    LAS unsigned char* WSL = F.lds + 1024 + 144 * 256 + 128 * 272;
    __syncthreads();
    const int fr = lane & 15, fq = lane >> 4;
    if (g != cur_g) { cur_g = g;
#pragma unroll
        for (int i = 0; i < 4; ++i) { const int p = tid + i * (NWAVES * 64), row = p >> 4, ch = p & 15;
            *(LAS v4u*)(WSL + row * 272 + ch * 16) = *(const v4u*)(Wsb + (size_t)(g * 128 + row) * 128 + ch * 8); }
    }
    v4u xr[16], xs[5]; unsigned short gv[32]; bf16x8 afp[4]; v2u uur[8]; float biasr[8];
#pragma unroll
    for (int rr = 0; rr < 16; ++rr) xr[rr] = *(const v4u*)(Z + (size_t)(r0 + 16 * wave + rr) * AB_IN + 512 + lane * 8);
#pragma unroll
    for (int i = 0; i < 5; ++i) { const int p = tid + i * (NWAVES * 64), lr = p >> 4, ch = p & 15, R = r0 - 8 + lr; xs[i] = (v4u){0u, 0u, 0u, 0u};
        if (p < 144 * 16 && R >= S0 && R < S1) xs[i] = *(const v4u*)(Z + (size_t)R * AB_IN + 1024 + 128 * g + ch * 8); }
    const int dcol = 128 * g + 16 * wave + fr;
#pragma unroll
    for (int ks = 0; ks < 4; ++ks)
#pragma unroll
        for (int jj = 0; jj < 8; ++jj) gv[ks * 8 + jj] = Z[(size_t)(r0 + 32 * ks + 8 * fq + jj) * AB_IN + 512 + dcol];
#pragma unroll
    for (int pb = 0; pb < 8; ++pb) { uur[pb] = *(const v2u*)(Z + (size_t)(r0 + 16 * pb + fr) * AB_IN + 128 * g + 16 * wave + 4 * fq); biasr[pb] = bsv[g * 128 + 16 * pb + fr]; }
#pragma unroll
    for (int ks = 0; ks < 4; ++ks) afp[ks] = *(const bf16x8*)(WpT + (size_t)(g * 128 + 16 * wave + fr) * 128 + 32 * ks + 8 * fq);
    { float mine = 0.f;
#pragma unroll
        for (int rr = 0; rr < 16; ++rr) { const v4u x = xr[rr];
            float s = bf_lo(x.x) * bf_lo(x.x) + bf_hi(x.x) * bf_hi(x.x) + bf_lo(x.y) * bf_lo(x.y) + bf_hi(x.y) * bf_hi(x.y) + bf_lo(x.z) * bf_lo(x.z) + bf_hi(x.z) * bf_hi(x.z) + bf_lo(x.w) * bf_lo(x.w) + bf_hi(x.w) * bf_hi(x.w);
            s = wave_sum(s); if (lane == rr) mine = s; }
        if (lane < 16) rstd[16 * wave + lane] = 1.0f / sqrtf(mine * (1.0f / 512.0f) + EPS); }
#pragma unroll
    for (int i = 0; i < 5; ++i) { const int p = tid + i * (NWAVES * 64), lr = p >> 4, ch = p & 15;
        if (p < 144 * 16) *(LAS v4u*)((LAS unsigned char*)T + lr * 256 + ch * 16) = xs[i]; }
    __syncthreads();
    for (int rep3_ = 0; rep3_ < AB_REP3; ++rep3_)
    { const int i = tid & 127, rq = tid >> 7, w = 2 << g, half = w >> 1, l0 = 32 * rq;
        float s = 0.f;
        for (int t = 0; t < w; ++t) s += bf1(T[(l0 + 8 - half + t) * 128 + i]);
#pragma unroll 8
        for (int l = l0; l < l0 + 32; ++l) { const int R = r0 + l; int lo = R - half, hi = R - half + w; lo = lo < S0 ? S0 : lo; hi = hi > S1 ? S1 : hi;
            const float mean = s * __builtin_amdgcn_rcpf((float)(hi - lo)); const float pv = mean - bf1(T[(l + 8) * 128 + i]);
            P[l * 136 + i] = (unsigned short)(pk2(pv, 0.f) & 0xffffu);
            s += bf1(T[(l + 8 - half + w) * 128 + i]) - bf1(T[(l + 8 - half) * 128 + i]); } }
    __syncthreads();
    for (int rep4_ = 0; rep4_ < AB_REP4; ++rep4_)
    { const f32x4v psc = *(const f32x4v*)(pscale + 128 * g + 16 * wave + 4 * fq);
#pragma unroll 2
        for (int lb = 0; lb < 8; ++lb) { pg8::f32x4 acc = {0.f, 0.f, 0.f, 0.f};
#pragma unroll
            for (int ks = 0; ks < 4; ++ks) { const bf16x8 bfr = *(const LAS bf16x8*)((LAS unsigned char*)P + (16 * lb + fr) * 272 + (32 * ks + 8 * fq) * 2);
                acc = __builtin_amdgcn_mfma_f32_16x16x32_bf16(afp[ks], bfr, acc, 0, 0, 0); }
            v2u o; o.x = pk2(acc[0] * psc[0], acc[1] * psc[1]); o.y = pk2(acc[2] * psc[2], acc[3] * psc[3]);
            *(v2u*)(Y + (size_t)(r0 + 16 * lb + fr) * 1024 + 512 + 128 * g + 16 * wave + 4 * fq) = o; } }
    for (int rep5_ = 0; rep5_ < AB_REP5; ++rep5_)
    { bf16x8 af[4]; const float gn = vgain[dcol];
#pragma unroll
        for (int ks = 0; ks < 4; ++ks) { float t[8];
#pragma unroll
            for (int jj = 0; jj < 8; ++jj) { const int q = 32 * ks + 8 * fq + jj; t[jj] = bf1(gv[ks * 8 + jj]) * rstd[q] * gn; }
            v4u w; w.x = pk2(t[0], t[1]); w.y = pk2(t[2], t[3]); w.z = pk2(t[4], t[5]); w.w = pk2(t[6], t[7]); af[ks] = __builtin_bit_cast(bf16x8, w); }
#pragma unroll
        for (int pb = 0; pb < 8; ++pb) { pg8::f32x4 acc = {0.f, 0.f, 0.f, 0.f};
#pragma unroll
            for (int ks = 0; ks < 4; ++ks) { const bf16x8 bfr = *(const LAS bf16x8*)(WSL + (16 * pb + fr) * 272 + (32 * ks + 8 * fq) * 2);
                acc = __builtin_amdgcn_mfma_f32_16x16x32_bf16(af[ks], bfr, acc, 0, 0, 0); }
            const int prow = 16 * pb + fr; const float bias = biasr[pb];
            const v2u uu = uur[pb];
            v2u o; o.x = pk2(bf_lo(uu.x) * (acc[0] + bias), bf_hi(uu.x) * (acc[1] + bias)); o.y = pk2(bf_lo(uu.y) * (acc[2] + bias), bf_hi(uu.y) * (acc[3] + bias));
            *(v2u*)(Y + (size_t)(r0 + prow) * 1024 + 128 * g + 16 * wave + 4 * fq) = o; } }
}

__device__ __forceinline__ void unpack8(const v4u x, float (&f)[8]) { f[0] = bf_lo(x.x); f[1] = bf_hi(x.x); f[2] = bf_lo(x.y); f[3] = bf_hi(x.y); f[4] = bf_lo(x.z); f[5] = bf_hi(x.z); f[6] = bf_lo(x.w); f[7] = bf_hi(x.w); }
__device__ __forceinline__ v4u pack8(const float (&f)[8]) { v4u o; o.x = pk2(f[0], f[1]); o.y = pk2(f[2], f[3]); o.z = pk2(f[4], f[5]); o.w = pk2(f[6], f[7]); return o; }
__device__ __forceinline__ void head_norm_rope(float (&f)[8], int sub, const float (&gain)[8], bool rope, float grow, float gcol, float oscale) {
    float s = 0.f;
#pragma unroll
    for (int j = 0; j < 8; ++j) s += f[j] * f[j];
    s += __shfl_xor(s, 1); s += __shfl_xor(s, 2); s += __shfl_xor(s, 4);
    const float r = 1.0f / sqrtf(s * (1.0f / 64.0f) + EPS);
#pragma unroll
    for (int j = 0; j < 8; ++j) f[j] = f[j] * r * gain[j];
    float o[8];
#pragma unroll
    for (int j = 0; j < 8; ++j) o[j] = __shfl_xor(f[j], 4);
    if (rope) {
#pragma unroll
        for (int j = 0; j < 8; ++j) { const int dp = (sub & 3) * 8 + j;
            const float ang = ((dp < 16) ? grow : gcol) * __builtin_amdgcn_exp2f(-(float)(dp & 15) * (13.287712379549449f / 16.0f));
            const float cs = __cosf(ang), sn = __sinf(ang);
            f[j] = (sub < 4) ? (f[j] * cs - o[j] * sn) : (o[j] * sn + f[j] * cs); }
    }
#pragma unroll
    for (int j = 0; j < 8; ++j) f[j] *= oscale;
}
__device__ __forceinline__ void cdmid_phase(const Ctx& F, const Args& a, int li) {
    const int gw = F.vcu * NWAVES + F.wave, NGW = F.G * NWAVES, lane = F.lane;
    GAS unsigned char* big = F.ws + WS_BIG;
    const bf16* Z = (const bf16*)(big + B_Z); bf16* QC = (bf16*)(big + B_QC); bf16* KC = (bf16*)(big + B_KC); bf16* CQN = (bf16*)(big + B_CQN); bf16* CKVN = (bf16*)(big + B_CKVN); unsigned char* KD8 = (unsigned char*)(big + B_KD); unsigned char* QD8 = (unsigned char*)(big + B_QD); unsigned char* QC8 = (unsigned char*)(big + B_QC8); unsigned char* KC8 = (unsigned char*)(big + B_KC8);
    const float* qg = a.in[I_CQGAIN] + li * 64; const float* kg = a.in[I_CKGAIN] + li * 64; const float* cqg = a.in[I_DCQGAIN] + li * 384; const float* ckvg = a.in[I_DCKVGAIN] + li * 256;
    float qgv[8], kgv[8], cq1[8], cq2[8], ckv[8];
    { const int c1 = (lane >= 32) ? (lane - 32) * 8 : 0, c2 = (lane < 16) ? 256 + lane * 8 : 0, c3 = (lane >= 16 && lane < 48) ? (lane - 16) * 8 : 0;
#pragma unroll
        for (int t = 0; t < 8; ++t) { qgv[t] = qg[(lane & 7) * 8 + t]; kgv[t] = kg[(lane & 7) * 8 + t]; cq1[t] = cqg[c1 + t]; cq2[t] = cqg[c2 + t]; ckv[t] = ckvg[c3 + t]; } }
    v4u nx0 = (v4u){0u, 0u, 0u, 0u}, nx1 = nx0, nx2 = nx0;
    if (gw < M) { const bf16* zn = Z + (size_t)gw * CD_INP; nx0 = *(const v4u*)(zn + lane * 8); nx1 = *(const v4u*)(zn + (64 + lane) * 8); nx2 = *(const v4u*)(zn + (128 + lane) * 8); }
    for (int row = gw; row < M; row += NGW) { const int b = row / ROWS_B, j = row - b * ROWS_B; const bool latent = j >= CTXL; const int s = j - CTXL;
        const float grow = (float)(s >> 6), gcol = (float)(s & 63);
        const v4u x0 = nx0, x1 = nx1, x2 = nx2;
        if (row + NGW < M) { const bf16* zn = Z + (size_t)(row + NGW) * CD_INP; nx0 = *(const v4u*)(zn + lane * 8); nx1 = *(const v4u*)(zn + (64 + lane) * 8); nx2 = *(const v4u*)(zn + (128 + lane) * 8); }
        float f0[8], f1[8], f2[8]; unpack8(x0, f0); unpack8(x1, f1); unpack8(x2, f2);
        head_norm_rope(f0, lane & 7, qgv, latent, grow, gcol, 0.125f * 1.4426950408889634f);
        *(v4u*)(QC + (size_t)row * 512 + lane * 8) = pack8(f0);
        { v2u q8; q8.x = pg8::pk4_fp8(f0[0], f0[1], f0[2], f0[3]); q8.y = pg8::pk4_fp8(f0[4], f0[5], f0[6], f0[7]); *(v2u*)(QC8 + (size_t)row * 512 + lane * 8) = q8; }
        float ssq = 0.f, sskv = 0.f;
        if (lane >= 32) {
#pragma unroll
            for (int t = 0; t < 8; ++t) ssq += f1[t] * f1[t]; }
        if (lane < 16) {
#pragma unroll
            for (int t = 0; t < 8; ++t) ssq += f2[t] * f2[t]; }
        else if (lane < 48) {
#pragma unroll
            for (int t = 0; t < 8; ++t) sskv += f2[t] * f2[t]; }
        { float fk[8];
#pragma unroll
            for (int t = 0; t < 8; ++t) fk[t] = f1[t];
            head_norm_rope(fk, lane & 7, kgv, latent, grow, gcol, 1.0f);
            if (lane < 16) { *(v4u*)(KC + (size_t)row * 128 + lane * 8) = pack8(fk); v2u k8; k8.x = pg8::pk4_fp8(fk[0], fk[1], fk[2], fk[3]); k8.y = pg8::pk4_fp8(fk[4], fk[5], fk[6], fk[7]); *(v2u*)(KC8 + (size_t)row * 128 + lane * 8) = k8; } }
        ssq = wave_sum(ssq); sskv = wave_sum(sskv);
        const float rq = 1.0f / sqrtf(ssq * (1.0f / 384.0f) + EPS), rkv = 1.0f / sqrtf(sskv * (1.0f / 256.0f) + EPS);
        if (lane >= 32) { float o[8]; const int c0 = (lane - 32) * 8;
#pragma unroll
            for (int t = 0; t < 8; ++t) o[t] = f1[t] * rq * cq1[t];
            *(v4u*)(CQN + (size_t)row * 384 + c0) = pack8(o); }
        if (lane < 16) { float o[8]; const int c0 = 256 + lane * 8;
#pragma unroll
            for (int t = 0; t < 8; ++t) o[t] = f2[t] * rq * cq2[t];
            *(v4u*)(CQN + (size_t)row * 384 + c0) = pack8(o); }
        else if (lane < 48) { float o[8]; const int c0 = (lane - 16) * 8;
#pragma unroll
            for (int t = 0; t < 8; ++t) o[t] = f2[t] * rkv * ckv[t];
            *(v4u*)(CKVN + (size_t)row * 256 + c0) = pack8(o); }
        { float o[8];
#pragma unroll
            for (int t = 0; t < 8; ++t) o[t] = __shfl_xor(f2[t], 2);
            if (lane >= 48 && lane < 52) { const int sub = lane - 48;
                if (latent) {
#pragma unroll
                    for (int t = 0; t < 8; ++t) { const int dp = (sub & 1) * 8 + t; const float ang = ((dp < 8) ? grow : gcol) * __builtin_amdgcn_exp2f(-(float)(dp & 7) * (13.287712379549449f / 8.0f));
                        const float cs = __cosf(ang), sn = __sinf(ang);
                        f2[t] = (sub < 2) ? (f2[t] * cs - o[t] * sn) : (o[t] * sn + f2[t] * cs); } }
                v2u w8; w8.x = pg8::pk4_fp8(f2[0], f2[1], f2[2], f2[3]); w8.y = pg8::pk4_fp8(f2[4], f2[5], f2[6], f2[7]);
#pragma unroll
                for (int h = 0; h < 8; ++h) *(v2u*)(KD8 + (size_t)row * 1024 + 128 * h + 64 + sub * 8) = w8; }
            if (lane < 16) { const v4u z = (v4u){0u, 0u, 0u, 0u};
                *(v4u*)(KD8 + (size_t)row * 1024 + 128 * (lane >> 1) + 96 + 16 * (lane & 1)) = z; *(v4u*)(QD8 + (size_t)row * 1024 + 128 * (lane >> 1) + 96 + 16 * (lane & 1)) = z; } }
    }
}

constexpr int RPB_MAX = 1056;
__device__ __forceinline__ void route_phase(const Ctx& F, const Args& a, int li, const float* modl) {
    LAS float* R = (LAS float*)F.lds;
    LAS unsigned* cnt = (LAS unsigned*)(F.lds + 40960);
    const float* rw = a.in[I_ROUTER] + (size_t)li * 1024 * 8;
    __syncthreads();
    for (int i = F.tid; i < 1024 * 8 / 4; i += NWAVES * 64) { const int c = i >> 1, hf = i & 1; *((LAS f32x4*)(R + (c >> 2) * 36 + (c & 3) * 8 + hf * 4)) = *((const f32x4*)rw + i); }
    if (F.tid < 8) cnt[F.tid] = 0u;
    __syncthreads();
    const int rpb = (M + F.G - 1) / F.G, rbeg = F.bx * rpb, rend = (rbeg + rpb < M) ? rbeg + rpb : M;
    const xs_t* XS = (const xs_t*)(F.ws + WS_XS); v4u* TOPK = (v4u*)(F.ws + WS_TOPK);
    v2u nx[4], ny[4];
    if (rbeg + F.wave < rend) {
#pragma unroll
        for (int q = 0; q < 4; ++q) nx[q] = xs_ld(XS, rbeg + F.wave, F.lane, q); }
    if (rbeg + F.wave + NWAVES < rend) {
#pragma unroll
        for (int q = 0; q < 4; ++q) ny[q] = xs_ld(XS, rbeg + F.wave + NWAVES, F.lane, q); }
    ModVec mv; int cur_mr = -1;
    for (int row = rbeg + F.wave; row < rend; row += NWAVES) { const int mr = modrow_of_row(row);
        if (mr != cur_mr) { modvec_load(mv, modl + (size_t)mr * 6144 + 3 * 1024, modl + (size_t)mr * 6144 + 4 * 1024, F.lane); cur_mr = mr; }
        f32x4 v[4];
#pragma unroll
        for (int q = 0; q < 4; ++q) { v[q] = xs_cvt(nx[q]); nx[q] = ny[q]; }
        if (row + 2 * NWAVES < rend) {
#pragma unroll
            for (int q = 0; q < 4; ++q) ny[q] = xs_ld(XS, row + 2 * NWAVES, F.lane, q); }
        const float rstd = row_rstd(v);
        float lg[8] = {0.f, 0.f, 0.f, 0.f, 0.f, 0.f, 0.f, 0.f};
#pragma unroll
        for (int q = 0; q < 4; ++q) { const f32x4 h = v[q] * rstd * mv.sc[q] + mv.sh[q];
#pragma unroll
            for (int t = 0; t < 4; ++t) { const LAS float* rp = R + (F.lane + 64 * q) * 36 + t * 8; const f32x4 r0 = *((const LAS f32x4*)rp), r1 = *((const LAS f32x4*)(rp + 4));
                lg[0] += h[t] * r0[0]; lg[1] += h[t] * r0[1]; lg[2] += h[t] * r0[2]; lg[3] += h[t] * r0[3]; lg[4] += h[t] * r1[0]; lg[5] += h[t] * r1[1]; lg[6] += h[t] * r1[2]; lg[7] += h[t] * r1[3]; } }
        { float t4[4], t2[2], t1;
#pragma unroll
            for (int i = 0; i < 4; ++i) { const float keep = (F.lane & 1) ? lg[4 + i] : lg[i], send = (F.lane & 1) ? lg[i] : lg[4 + i]; t4[i] = keep + __shfl_xor(send, 1); }
#pragma unroll
            for (int i = 0; i < 2; ++i) { const float keep = (F.lane & 2) ? t4[2 + i] : t4[i], send = (F.lane & 2) ? t4[i] : t4[2 + i]; t2[i] = keep + __shfl_xor(send, 2); }
            { const float keep = (F.lane & 4) ? t2[1] : t2[0], send = (F.lane & 4) ? t2[0] : t2[1]; t1 = keep + __shfl_xor(send, 4); }
            t1 += __shfl_xor(t1, 8); t1 += __shfl_xor(t1, 16); t1 += __shfl_xor(t1, 32);
#pragma unroll
            for (int e = 0; e < 8; ++e) lg[e] = __int_as_float(__builtin_amdgcn_readlane(__float_as_int(t1), (e >> 2) | (((e >> 1) & 1) << 1) | ((e & 1) << 2))); }
        int i0 = 0; float v0 = lg[0];
#pragma unroll
        for (int e = 1; e < 8; ++e) if (lg[e] > v0) { v0 = lg[e]; i0 = e; }
        int i1 = -1; float v1 = -3.0e38f;
#pragma unroll
        for (int e = 0; e < 8; ++e) if (e != i0 && (i1 < 0 || lg[e] > v1)) { v1 = lg[e]; i1 = e; }
        const float w0 = 1.0f / (1.0f + __expf(v1 - v0)), w1 = 1.0f - w0;
        if (F.lane == 0) { TOPK[row] = (v4u){(unsigned)i0, (unsigned)i1, __float_as_uint(w0), __float_as_uint(w1)}; __hip_atomic_fetch_add((unsigned*)&cnt[i0], 1u, __ATOMIC_RELAXED, __HIP_MEMORY_SCOPE_WORKGROUP); __hip_atomic_fetch_add((unsigned*)&cnt[i1], 1u, __ATOMIC_RELAXED, __HIP_MEMORY_SCOPE_WORKGROUP); }
    }
    __syncthreads();
    if (F.tid < 8) __hip_atomic_store((unsigned*)(F.ws + WS_CNT) + F.bx * 8 + F.tid, cnt[F.tid], __ATOMIC_RELAXED, __HIP_MEMORY_SCOPE_AGENT);
}
__device__ __forceinline__ void slots_phase(const Ctx& F, const Args& a, const float* modl) {
    LAS unsigned* tot = (LAS unsigned*)F.lds;
    LAS unsigned* e01 = (LAS unsigned*)(F.lds + 256);
    LAS unsigned* sl0 = e01 + RPB_MAX; LAS unsigned* sl1 = sl0 + RPB_MAX;
    const int rpb = (M + F.G - 1) / F.G, rbeg = F.bx * rpb, rend = (rbeg + rpb < M) ? rbeg + rpb : M, nr = rend > rbeg ? rend - rbeg : 0;
    const unsigned* CNT = (const unsigned*)(F.ws + WS_CNT); const v4u* TOPK = (const v4u*)(F.ws + WS_TOPK); unsigned* PEXP = (unsigned*)(F.ws + WS_PEXP);
    __syncthreads();
    LAS unsigned* cl = sl1 + RPB_MAX;
    for (int i = F.tid; i < F.G * 8; i += NWAVES * 64) cl[i] = __hip_atomic_load(CNT + i, __ATOMIC_RELAXED, __HIP_MEMORY_SCOPE_AGENT);
    for (int r = F.tid; r < nr; r += NWAVES * 64) { const v4u tk = TOPK[rbeg + r]; e01[r] = tk.x | (tk.y << 8); }
    __syncthreads();
    if (F.tid < 8) { unsigned t = 0u, pre = 0u;
        for (int g = 0; g < F.G; ++g) { const unsigned cv = cl[g * 8 + F.tid]; t += cv; if (g < F.bx) pre += cv; }
        tot[F.tid] = t; tot[8 + F.tid] = pre; }
    __syncthreads();
    if (F.tid == 0) { unsigned pb = 0u;
        for (int e = 0; e < 8; ++e) { const unsigned np = (tot[e] + 255u) >> 8; tot[16 + e] = pb * 256u + tot[8 + e];
            if (F.bx == 0) for (unsigned p = 0; p < np; ++p) __hip_atomic_store(PEXP + pb + p, (unsigned)e, __ATOMIC_RELAXED, __HIP_MEMORY_SCOPE_AGENT);
            pb += np; }
        if (F.bx == 0) __hip_atomic_store(PEXP + 511, pb, __ATOMIC_RELAXED, __HIP_MEMORY_SCOPE_AGENT); }
    __syncthreads();
    if (F.tid < 8) { unsigned c = tot[16 + F.tid]; const unsigned e = (unsigned)F.tid;
        for (int r = 0; r < nr; ++r) { const unsigned w = e01[r]; if ((w & 0xffu) == e) sl0[r] = c++; else if ((w >> 8) == e) sl1[r] = c++; } }
    __syncthreads();
    const xs_t* XS = (const xs_t*)(F.ws + WS_XS); bf16* HS = (bf16*)(F.ws + WS_BIG + B_HS); v2u* TOKSLOT = (v2u*)(F.ws + WS_TOKSLOT);
    v2u nx[4], ny[4];
    if (F.wave < nr) {
#pragma unroll
        for (int q = 0; q < 4; ++q) nx[q] = xs_ld(XS, rbeg + F.wave, F.lane, q); }
    if (F.wave + NWAVES < nr) {
#pragma unroll
        for (int q = 0; q < 4; ++q) ny[q] = xs_ld(XS, rbeg + F.wave + NWAVES, F.lane, q); }
    ModVec mv; int cur_mr = -1;
    for (int r = F.wave; r < nr; r += NWAVES) { const int row = rbeg + r; const int mr = modrow_of_row(row);
        if (mr != cur_mr) { modvec_load(mv, modl + (size_t)mr * 6144 + 3 * 1024, modl + (size_t)mr * 6144 + 4 * 1024, F.lane); cur_mr = mr; }
        f32x4 v[4];
#pragma unroll
        for (int q = 0; q < 4; ++q) { v[q] = xs_cvt(nx[q]); nx[q] = ny[q]; }
        if (r + 2 * NWAVES < nr) {
#pragma unroll
            for (int q = 0; q < 4; ++q) ny[q] = xs_ld(XS, row + 2 * NWAVES, F.lane, q); }
        const float rstd = row_rstd(v); const unsigned s0 = sl0[r], s1 = sl1[r];
#pragma unroll
        for (int q = 0; q < 4; ++q) { const f32x4 h = v[q] * rstd * mv.sc[q] + mv.sh[q];
            if (FP8M) { const unsigned o8 = pg8::pk4_fp8(h[0], h[1], h[2], h[3]); *((unsigned*)((unsigned char*)HS + (size_t)s0 * D) + F.lane + 64 * q) = o8; *((unsigned*)((unsigned char*)HS + (size_t)s1 * D) + F.lane + 64 * q) = o8; }
            else { v2u o; o.x = pk2(h[0], h[1]); o.y = pk2(h[2], h[3]);
                *((v2u*)(HS + (size_t)s0 * D) + F.lane + 64 * q) = o; *((v2u*)(HS + (size_t)s1 * D) + F.lane + 64 * q) = o; } }
        if (F.lane == 0) TOKSLOT[row] = (v2u){s0, s1};
    }
}
__device__ __forceinline__ void combine_phase(const Ctx& F, const Args& a, const float* modl, bool final_layer, const float* modn, float gscale) {
    const int gw = F.vcu * NWAVES + F.wave, NGW = F.G * NWAVES;
    const int rpw = (M + NGW - 1) / NGW, rbeg = gw * rpw, rend = (rbeg + rpw < M) ? rbeg + rpw : M;
    xs_t* XS = (xs_t*)(F.ws + WS_XS); bf16* H = (bf16*)(F.ws + WS_BIG + B_H); const bf16* Y = (const bf16*)(F.ws + WS_BIG + B_HS);
    const v4u* TOPK = (const v4u*)(F.ws + WS_TOPK); const v2u* TOKSLOT = (const v2u*)(F.ws + WS_TOKSLOT);
    v2u nx[4]; v2u ny0[4], ny1[4]; v4u ntk = (v4u){0u, 0u, 0u, 0u}, ftk = ntk; v2u fts = (v2u){0u, 0u};
#define CB_DATA(row_, ts_) do { _Pragma("unroll") for (int q = 0; q < 4; ++q) { nx[q] = xs_ld(XS, (row_), F.lane, q); \
        ny0[q] = *((const v2u*)(Y + (size_t)(ts_).x * D) + F.lane + 64 * q); ny1[q] = *((const v2u*)(Y + (size_t)(ts_).y * D) + F.lane + 64 * q); } } while (0)
    if (rbeg < rend) { ntk = TOPK[rbeg]; const v2u ts0 = TOKSLOT[rbeg]; CB_DATA(rbeg, ts0); }
    if (rbeg + 1 < rend) { ftk = TOPK[rbeg + 1]; fts = TOKSLOT[rbeg + 1]; }
    ModVec mv; f32x4 gv[4], fg[4]; int cur_mr = -1;
    if (final_layer) {
#pragma unroll
        for (int q = 0; q < 4; ++q) fg[q] = *((const f32x4*)a.in[I_FGAIN] + F.lane + 64 * q); }
    for (int row = rbeg; row < rend; ++row) { const int b = row / ROWS_B, j = row - b * ROWS_B; const int mr = (j < CTXL) ? 4 : b;
        const v4u tk = ntk; f32x4 x[4]; v2u y0[4], y1[4];
#pragma unroll
        for (int q = 0; q < 4; ++q) { x[q] = xs_cvt(nx[q]); y0[q] = ny0[q]; y1[q] = ny1[q]; }
        if (row + 1 < rend) { ntk = ftk; const v2u ts1 = fts; CB_DATA(row + 1, ts1); }
        if (row + 2 < rend) { ftk = TOPK[row + 2]; fts = TOKSLOT[row + 2]; }
        if (final_layer && j < CTXL) continue;
        if (mr != cur_mr) { cur_mr = mr;
#pragma unroll
            for (int q = 0; q < 4; ++q) gv[q] = *((const f32x4*)(modl + (size_t)mr * 6144 + 5 * 1024) + F.lane + 64 * q) * gscale;
            if (!final_layer) modvec_load(mv, modn + (size_t)mr * 6144, modn + (size_t)mr * 6144 + 1024, F.lane); }
        const float w0 = __uint_as_float(tk.z), w1 = __uint_as_float(tk.w);
        f32x4 v[4];
#pragma unroll
        for (int q = 0; q < 4; ++q) {
            f32x4 y; y[0] = w0 * bf_lo(y0[q].x) + w1 * bf_lo(y1[q].x); y[1] = w0 * bf_hi(y0[q].x) + w1 * bf_hi(y1[q].x); y[2] = w0 * bf_lo(y0[q].y) + w1 * bf_lo(y1[q].y); y[3] = w0 * bf_hi(y0[q].y) + w1 * bf_hi(y1[q].y);
            v[q] = x[q] + gv[q] * y; }
        const float rstd = row_rstd(v);
        if (!final_layer) {
#pragma unroll
            for (int q = 0; q < 4; ++q) xs_st(XS, row, F.lane, q, v[q]);
            store_mod_row_v(v, rstd, mv, H + (size_t)row * D, F.lane);
        } else { float* orow = a.out + (size_t)(b * SEQ + j - CTXL) * D;
#pragma unroll
            for (int q = 0; q < 4; ++q) *((f32x4*)orow + F.lane + 64 * q) = v[q] * rstd * fg[q]; }
    }
#undef CB_DATA
}
template <bool F8, class E> __device__ __forceinline__ void ctx_gemm(const Ctx& F, const void* Av, const void* Btv, int Kb  , int N, const E& epi) {
    const int fr = F.lane & 15, fq = F.lane >> 4, ntn = N / 64, ntask = 16 * ntn, nks = Kb / 64;
    typedef const __attribute__((address_space(1))) bf16x8* gp8;
    const unsigned char* A = (const unsigned char*)Av; const unsigned char* Bt = (const unsigned char*)Btv;
    LAS pg8::f32x4* red = (LAS pg8::f32x4*)(F.lds + RING_OFF);
    for (int t = F.vcu; t < ntask; t += F.G) { const int rt = t / ntn, ct = t - rt * ntn; const int p = rt >> 2, rq = rt & 3;
        const int row0 = p * ROWS_B + rq * 64, col0 = ct * 64;
        const unsigned char* ap = A + (size_t)(row0 + fr) * Kb + 16 * fq; const unsigned char* bp = Bt + (size_t)(col0 + fr) * Kb + 16 * fq;
        pg8::f32x4 acc[4][4];
#pragma unroll
        for (int mb = 0; mb < 4; ++mb)
#pragma unroll
            for (int nb = 0; nb < 4; ++nb) acc[mb][nb] = (pg8::f32x4){0.f, 0.f, 0.f, 0.f};
#pragma unroll 2
        for (int s = F.wave; s < nks; s += NWAVES) { const int k = 64 * s; bf16x8 av[4], wv[4];
#pragma unroll
            for (int i = 0; i < 4; ++i) { av[i] = *(gp8)(ap + (size_t)(16 * i) * Kb + k); wv[i] = *(gp8)(bp + (size_t)(16 * i) * Kb + k); }
#pragma unroll
            for (int mb = 0; mb < 4; ++mb)
#pragma unroll
                for (int nb = 0; nb < 4; ++nb) {
                    if constexpr (F8) { typedef long l2_ __attribute__((ext_vector_type(2))); const l2_ b_ = __builtin_bit_cast(l2_, wv[nb]), a_ = __builtin_bit_cast(l2_, av[mb]);
                        acc[mb][nb] = __builtin_amdgcn_mfma_f32_16x16x32_fp8_fp8(b_[0], a_[0], acc[mb][nb], 0, 0, 0); acc[mb][nb] = __builtin_amdgcn_mfma_f32_16x16x32_fp8_fp8(b_[1], a_[1], acc[mb][nb], 0, 0, 0); }
                    else acc[mb][nb] = __builtin_amdgcn_mfma_f32_16x16x32_bf16(wv[nb], av[mb], acc[mb][nb], 0, 0, 0); } }
        __syncthreads();
#pragma unroll
        for (int mb = 0; mb < 4; ++mb)
#pragma unroll
            for (int nb = 0; nb < 4; ++nb) red[(F.wave * 16 + mb * 4 + nb) * 64 + F.lane] = acc[mb][nb];
        __syncthreads();
#pragma unroll
        for (int i = 0; i < 2; ++i) { const int tile = 2 * F.wave + i, mb = tile >> 2, nb = tile & 3; pg8::f32x4 v = red[tile * 64 + F.lane];
#pragma unroll
            for (int w = 1; w < 8; ++w) v = v + red[(w * 16 + tile) * 64 + F.lane];
            epi(row0 + 16 * mb + fr, col0 + 16 * nb + 4 * fq, v); }
    }
    __syncthreads();
}
template <bool F8, class E> __device__ __forceinline__ void ctx_gemm_gu(const Ctx& F, const void* Av, const void* Btv, int Kb, int NH  , const E& epi) {
    const int fr = F.lane & 15, fq = F.lane >> 4, ntn = NH / 64, ntask = 16 * ntn, nks = Kb / 64;
    typedef const __attribute__((address_space(1))) bf16x8* gp8;
    const unsigned char* A = (const unsigned char*)Av; const unsigned char* Bt = (const unsigned char*)Btv;
    LAS pg8::f32x4* red = (LAS pg8::f32x4*)(F.lds + RING_OFF);
    for (int t = F.vcu; t < ntask; t += F.G) { const int rt = t / ntn, ct = t - rt * ntn; const int p = rt >> 2, rq = rt & 3;
        const int row0 = p * ROWS_B + rq * 64, hc0 = ct * 64, brow = (hc0 >> 7) * 256 + (hc0 & 127);
        const unsigned char* ap = A + (size_t)(row0 + fr) * Kb + 16 * fq; const unsigned char* bp = Bt + (size_t)(brow + fr) * Kb + 16 * fq;
        pg8::f32x4 ag[4][4], au[4][4];
#pragma unroll
        for (int mb = 0; mb < 4; ++mb)
#pragma unroll
            for (int nb = 0; nb < 4; ++nb) { ag[mb][nb] = (pg8::f32x4){0.f, 0.f, 0.f, 0.f}; au[mb][nb] = (pg8::f32x4){0.f, 0.f, 0.f, 0.f}; }
        for (int s = F.wave; s < nks; s += NWAVES) { const int k = 64 * s; bf16x8 av[4], wg[4], wu[4];
#pragma unroll
            for (int i = 0; i < 4; ++i) { av[i] = *(gp8)(ap + (size_t)(16 * i) * Kb + k); wg[i] = *(gp8)(bp + (size_t)(16 * i) * Kb + k); wu[i] = *(gp8)(bp + (size_t)(128 + 16 * i) * Kb + k); }
#pragma unroll
            for (int mb = 0; mb < 4; ++mb)
#pragma unroll
                for (int nb = 0; nb < 4; ++nb) {
                    if constexpr (F8) { typedef long l2_ __attribute__((ext_vector_type(2))); const l2_ g_ = __builtin_bit_cast(l2_, wg[nb]), u_ = __builtin_bit_cast(l2_, wu[nb]), a_ = __builtin_bit_cast(l2_, av[mb]);
                        ag[mb][nb] = __builtin_amdgcn_mfma_f32_16x16x32_fp8_fp8(g_[0], a_[0], ag[mb][nb], 0, 0, 0); ag[mb][nb] = __builtin_amdgcn_mfma_f32_16x16x32_fp8_fp8(g_[1], a_[1], ag[mb][nb], 0, 0, 0);
                        au[mb][nb] = __builtin_amdgcn_mfma_f32_16x16x32_fp8_fp8(u_[0], a_[0], au[mb][nb], 0, 0, 0); au[mb][nb] = __builtin_amdgcn_mfma_f32_16x16x32_fp8_fp8(u_[1], a_[1], au[mb][nb], 0, 0, 0); }
                    else { ag[mb][nb] = __builtin_amdgcn_mfma_f32_16x16x32_bf16(wg[nb], av[mb], ag[mb][nb], 0, 0, 0); au[mb][nb] = __builtin_amdgcn_mfma_f32_16x16x32_bf16(wu[nb], av[mb], au[mb][nb], 0, 0, 0); } } }
        pg8::f32x4 vg[2], vu[2];
        __syncthreads();
#pragma unroll
        for (int mb = 0; mb < 4; ++mb)
#pragma unroll
            for (int nb = 0; nb < 4; ++nb) red[(F.wave * 16 + mb * 4 + nb) * 64 + F.lane] = ag[mb][nb];
        __syncthreads();
#pragma unroll
        for (int i = 0; i < 2; ++i) { const int tile = 2 * F.wave + i; pg8::f32x4 v = red[tile * 64 + F.lane];
#pragma unroll
            for (int w = 1; w < 8; ++w) v = v + red[(w * 16 + tile) * 64 + F.lane];
            vg[i] = v; }
        __syncthreads();
#pragma unroll
        for (int mb = 0; mb < 4; ++mb)
#pragma unroll
            for (int nb = 0; nb < 4; ++nb) red[(F.wave * 16 + mb * 4 + nb) * 64 + F.lane] = au[mb][nb];
        __syncthreads();
#pragma unroll
        for (int i = 0; i < 2; ++i) { const int tile = 2 * F.wave + i, mb = tile >> 2, nb = tile & 3; pg8::f32x4 v = red[tile * 64 + F.lane];
#pragma unroll
            for (int w = 1; w < 8; ++w) v = v + red[(w * 16 + tile) * 64 + F.lane];
            vu[i] = v; epi(row0 + 16 * mb + fr, hc0 + 16 * nb + 4 * fq, vg[i], vu[i]); }
    }
    __syncthreads();
}
struct CtxEpiSwiglu { void* O; int ldc; float iscale; bool out8;
    __device__ __forceinline__ void operator()(int row, int col, pg8::f32x4 g, pg8::f32x4 u) const {
        float h[4];
#pragma unroll
        for (int j = 0; j < 4; ++j) h[j] = pg8::silu_f(g[j] * iscale) * (u[j] * iscale);
        if (out8) *(unsigned*)((unsigned char*)O + (size_t)row * ldc + col) = pg8::pk4_fp8(h[0], h[1], h[2], h[3]);
        else { v2u o; o.x = pk2(h[0], h[1]); o.y = pk2(h[2], h[3]); *(v2u*)((bf16*)O + (size_t)row * ldc + col) = o; } } };
struct CtxEpiZ { bf16* O; int ldc; int gelu_cols;
    __device__ __forceinline__ void operator()(int row, int col, pg8::f32x4 v) const {
        if (col < gelu_cols) { const pg8::f32x2 a = pg8::gelu_pk((pg8::f32x2){v[0], v[1]}), b = pg8::gelu_pk((pg8::f32x2){v[2], v[3]}); v = (pg8::f32x4){a.x, a.y, b.x, b.y}; }
        v2u o; o.x = pk2(v[0], v[1]); o.y = pk2(v[2], v[3]); *(v2u*)(O + (size_t)row * ldc + col) = o; } };
struct CtxEpiResid { xs_t* X; const float* gate; float gscale;
    __device__ __forceinline__ void operator()(int row, int col, pg8::f32x4 v) const {
        xs_t* p = X + (size_t)row * D + col; const f32x4 g = *(const f32x4*)(gate + col) * gscale; f32x4 x = xs_cvt(*(const v2u*)p); x = x + g * v; v2u o; o.x = pk2(x[0], x[1]); o.y = pk2(x[2], x[3]); *(v2u*)p = o; } };
__device__ __forceinline__ void vtrans_phase(const Ctx& F) {
    GAS unsigned char* big = F.ws + WS_BIG;
    const bf16* Z = (const bf16*)(big + B_Z); const bf16* VD = (const bf16*)(big + B_VD); unsigned char* VT = (unsigned char*)(big + B_VT8);
    LAS unsigned char* T = F.lds + F.wave * 4096;
    const int gw = F.vcu * NWAVES + F.wave, NGW = F.G * NWAVES, lane = F.lane, NTL = ROWS_B / 64;
    const int k = lane, h = (k >> 2) & 1, jj = (k & 3) + 4 * ((k & 31) >> 3), pos = 32 * h + jj + 16 * (k >> 5);
    for (int it = gw; it < BATCH * 10 * NTL; it += NGW) { const int b = it / (10 * NTL), r = it - b * 10 * NTL, hd = r / NTL, tile = r - hd * NTL;
        const size_t row = (size_t)b * ROWS_B + tile * 64 + k;
        const bf16* src = (hd < 2) ? Z + row * CD_INP + 640 + hd * 64 : VD + row * 512 + (hd - 2) * 64;
        v4u x[8];
#pragma unroll
        for (int i = 0; i < 8; ++i) x[i] = *(const v4u*)(src + 8 * i);
#pragma unroll
        for (int i = 0; i < 8; ++i) { float f[8]; unpack8(x[i], f);
#pragma unroll
            for (int t = 0; t < 8; t += 2) { const int w = __builtin_amdgcn_cvt_pk_fp8_f32(f[t], f[t + 1], 0, false); const int d0 = 8 * i + t, d1 = d0 + 1;
                T[d0 * 64 + ((((pos >> 4) ^ ((d0 >> 2) & 3)) << 4) | (pos & 15))] = (unsigned char)(w & 0xff);
                T[d1 * 64 + ((((pos >> 4) ^ ((d1 >> 2) & 3)) << 4) | (pos & 15))] = (unsigned char)((w >> 8) & 0xff); } }
        LDS_WAIT(); asm volatile("" ::: "memory");
        unsigned char* dst = VT + (size_t)it * 4096;
#pragma unroll
        for (int i = 0; i < 4; ++i) *(v4u*)(dst + (i * 64 + lane) * 16) = *(const LAS v4u*)(T + (i * 64 + lane) * 16);
        LDS_WAIT(); asm volatile("" ::: "memory");
    }
}
__device__ __forceinline__ void attn_do_unit(const Ctx& F, int kind  , int b, int h, int qb  ) {
    GAS unsigned char* big = F.ws + WS_BIG;
    const size_t rowb = (size_t)b * ROWS_B, qrow = rowb + (qb < 0 ? 0 : CTXL + qb * 256); const int nkeys = qb < 0 ? CTXL : ROWS_B;
    bf16* O = (bf16*)(big + B_Y);
    if (kind == 0) { const bf16* QC = (const bf16*)(big + B_QC); const bf16* KC = (const bf16*)(big + B_KC); const bf16* Z = (const bf16*)(big + B_Z); const int kvh = h >> 2;
        att::attn_unit4<64, 512, 128, 1024, true>((const bf16*)((const unsigned char*)(big + B_QC8) + qrow * 512 + h * 64), (const bf16*)((const unsigned char*)(big + B_KC8) + rowb * 128 + kvh * 64), (const unsigned char*)(big + B_VT8) + (size_t)(b * 10 + kvh) * (ROWS_B / 64) * 4096, O + qrow * 1024 + h * 64, nkeys, (__attribute__((address_space(3))) char*)F.lds, F.tid); (void)Z; (void)QC; (void)KC;
    } else { const bf16* QD = (const bf16*)(big + B_QD); const bf16* KD = (const bf16*)(big + B_KD); const bf16* VD = (const bf16*)(big + B_VD);
        att::attn_unit4<96, 1024, 1024, 1024, true>((const bf16*)((const unsigned char*)(big + B_QD) + qrow * 1024 + h * 128), (const bf16*)((const unsigned char*)(big + B_KD) + rowb * 1024 + h * 128), (const unsigned char*)(big + B_VT8) + (size_t)(b * 10 + 2 + h) * (ROWS_B / 64) * 4096, O + qrow * 1024 + 512 + h * 64, nkeys, (__attribute__((address_space(3))) char*)F.lds, F.tid); (void)VD; (void)QD; (void)KD;
    }
}

__device__ __forceinline__ bool attn_deal(int G, int blk, int i, int ctx_shift, int& b, int& h, int& qb) {
    if (G == 256) { const int x = blk & 7, c = blk >> 3;
        if (i < 4) { const int pair = 4 * x + i; b = pair >> 3; h = pair & 7; qb = c; return true; }
        if (i == 4) { const int p = blk - ctx_shift; if (p >= 0 && p < 32) { b = p >> 3; h = p & 7; qb = -1; return true; } }
        return false; }
    const int L = i * G + blk;
    if (L < 1024) { const int pair = L >> 5; b = pair >> 3; h = pair & 7; qb = L & 31; return true; }
    if (L < 1056) { const int p = L - 1024; b = p >> 3; h = p & 7; qb = -1; return true; }
    return false;
}

#ifndef HDP_DUP
#define HDP_DUP 0u
#endif
#define NREP(k) (((HDP_DUP >> (k)) & 1u) ? 2 : 1)
#define GS(k) ((NREP(k) == 2) ? 0.5f : 1.0f)
#ifndef HDP_ONLY
#define PH_ON(k) true
#else
#define PH_ON(k) ((k) == HDP_ONLY)
#endif
constexpr int N_PHASES = 2 + 2 * 18;
__global__ void __launch_bounds__(NWAVES * 64, 2) hdp_fwd(Args args_k) {
    extern __shared__ __attribute__((aligned(16))) unsigned char lds[];
    Ctx F0;
    { Ctx& F = F0;
    F.ldsg = lds; F.lds = (LAS unsigned char*)lds;
    F.tid = threadIdx.x; F.lane = F.tid & 63; F.wave = __builtin_amdgcn_readfirstlane(F.tid >> 6);
    F.bx = blockIdx.x; F.G = gridDim.x; { const int bx = blockIdx.x; F.vcu = (F.G % 8 == 0) ? (bx % 8) * (F.G / 8) + bx / 8 : bx; }
    F.ws = (GAS unsigned char*)args_k.ws; }
    const Ctx& F = F0;
    volatile LAS unsigned* MISC = (volatile LAS unsigned*)(F.lds + MISC_OFF);
    for (int u = F.tid; u < (LDS_BYTES - LDSCTL_OFF) / 4; u += NWAVES * 64) ((LAS unsigned*)(F.lds + LDSCTL_OFF))[u] = 0u;
    __syncthreads();
    unsigned* barw = (unsigned*)(args_k.ws + WS_CTL) + 4096;
    XcdBarrier bar = xcd_barrier_post(barw, MISC + 8);
    const int lo = args_k.ph_lo, hi = args_k.ph_hi;
    int ph = 0;
#define IN() (lo <= ph && ph < hi)
#define FRESH() Ctx F = F0; F.lane = (int)__builtin_amdgcn_mbcnt_hi(~0u, __builtin_amdgcn_mbcnt_lo(~0u, 0u)); asm volatile("" : "+v"(F.lane)); F.tid = F.wave * 64 + F.lane; const Args& args = args_k; asm volatile("" : "+s"(F.ws), "+s"(F.G), "+s"(F.vcu), "+s"(F.bx)); GAS unsigned char* ws = F.ws; GAS unsigned char* big = ws + WS_BIG; xs_t* XS = (xs_t*)(ws + WS_XS); const float* MOD = (const float*)(ws + WS_MOD); bf16* H = (bf16*)(big + B_H); (void)XS; (void)MOD; (void)H; (void)big
#ifndef HDP_DBLBAR
#define HDP_DBLBAR 0
#endif
#define SEAM() do { if (lo <= ph && ph + 1 < hi) { xcd_barrier(bar); if (HDP_DBLBAR) xcd_barrier(bar); } ++ph; } while (0)

    for (int rep_ = 0; rep_ < NREP(0); ++rep_) if (PH_ON(0) && IN()) { FRESH(); convert_small(F, args); rope_table(F); adaln_phase(F, args); }
    SEAM();
    for (int rep_ = 0; rep_ < NREP(1); ++rep_) if (PH_ON(1) && IN()) { FRESH(); nm_phase(F, args, true, MOD, 0, 1024); }
    SEAM();

    for (int lp = 0; lp < 2; ++lp) {
#define LAYER_PTRS() const float* mode = MOD + (size_t)(2 * lp) * 5 * 6144; const float* modo = MOD + (size_t)(2 * lp + 1) * 5 * 6144; \
        GAS unsigned char* ev = ws + WS_WSMALL + (size_t)lp * EV_STRIDE; GAS unsigned char* od = ws + WS_WODD + (size_t)lp * OD_STRIDE; (void)mode; (void)modo; (void)ev; (void)od
        for (int rep_ = 0; rep_ < NREP(2); ++rep_) if (PH_ON(2) && IN()) { FRESH(); LAYER_PTRS(); pg8::Gemm g{H, (const bf16*)(ev + EV_WIN), MLAT, AB_IN, D, 0}; pg8::StaticOrder S; S.init(MLAT, AB_IN, F.G, F.bx, 1);
            pg8::EpiZ<true> E{(bf16*)(big + B_Z), AB_IN, 4, 1.0f};
            pg8::gemm_phase<pg8::EpiZ<true>, pg8::StaticOrder, true, true>(F.lds + RING_OFF, g, S, E, F.tid);
            ctx_gemm<false>(F, H, (const bf16*)(ev + EV_WIN), 2 * D, AB_IN, CtxEpiZ{(bf16*)(big + B_Z), AB_IN, 1024}); }
        SEAM();
        for (int rep_ = 0; rep_ < NREP(3); ++rep_) if (PH_ON(3) && IN()) { FRESH(); LAYER_PTRS(); int cur_g = -1;
            for (int u = F.vcu; u < (M / 128) * 4; u += F.G) abmid_unit(F, u >> 2, u & 3, (const bf16*)(big + B_Z), (bf16*)(big + B_Y), (const bf16*)(ev + EV_WS), (const bf16*)(ev + EV_WPOOL),
                args.in[I_AVGAIN] + lp * 512, args.in[I_ABS] + lp * 512, args.in[I_BSCALE] + lp * 512, cur_g); }
        SEAM();
        for (int rep_ = 0; rep_ < NREP(4); ++rep_) if (PH_ON(4) && IN()) { FRESH(); LAYER_PTRS(); pg8::Gemm g{(const bf16*)(big + B_Y), (const bf16*)(ev + EV_WOUT), MLAT, D, D, 0}; pg8::StaticOrder S; S.init(MLAT, D, F.G, F.bx, 1);
            pg8::EpiResid E{XS, mode + 2 * 1024, GS(4)};
            pg8::gemm_phase<pg8::EpiResid, pg8::StaticOrder, true, true>(F.lds + RING_OFF, g, S, E, F.tid);
            ctx_gemm<false>(F, (const bf16*)(big + B_Y), (const bf16*)(ev + EV_WOUT), 2 * D, D, CtxEpiResid{XS, mode + 4 * 6144 + 2 * 1024, GS(4)}); }
        SEAM();
        for (int rep_ = 0; rep_ < NREP(5); ++rep_) if (PH_ON(5) && IN()) { FRESH(); LAYER_PTRS(); nm_phase(F, args, false, mode, 3 * 1024, 4 * 1024, FP8F || (FP8G2 && lp == 1)); }
        SEAM();
        for (int rep_ = 0; rep_ < NREP(6); ++rep_) if (PH_ON(6) && IN()) { FRESH(); LAYER_PTRS(); const bool g8 = FP8F || (FP8G2 && lp == 1);
            pg8::Gemm g{H, (const bf16*)(ev + EV_WGU), M, 2 * DFF, g8 ? D / 2 : D, 0}; pg8::StaticOrder S; S.init(M, 2 * DFF, F.G, F.bx);
            pg8::EpiSwiglu<FP8D> E{(bf16*)(big + B_HB), DFF, g8 ? WSC_INV : 1.0f};
            if (FP8G2 && !FP8F) { if (lp == 1) pg8::gemm_phase<pg8::EpiSwiglu<FP8D>, pg8::StaticOrder, true, true, MXM>(F.lds + RING_OFF, g, S, E, F.tid);
                                  else pg8::gemm_phase<pg8::EpiSwiglu<FP8D>, pg8::StaticOrder, true, true, 0>(F.lds + RING_OFF, g, S, E, F.tid); }
            else pg8::gemm_phase<pg8::EpiSwiglu<FP8D>, pg8::StaticOrder, true, true, FP8F ? MXM : 0>(F.lds + RING_OFF, g, S, E, F.tid); }
        SEAM();
        for (int rep_ = 0; rep_ < NREP(7); ++rep_) if (PH_ON(7) && IN()) { FRESH(); LAYER_PTRS(); pg8::Gemm g{(const bf16*)(big + B_HB), (const bf16*)(ev + EV_WDN), MLAT, D, FP8D ? DFF / 2 : DFF, 0}; pg8::StaticOrder S; S.init(MLAT, D, F.G, F.bx, 1);
            pg8::EpiResid E{XS, mode + 5 * 1024, GS(7) * (FP8D ? WSC_INV : 1.0f)};
            pg8::gemm_phase<pg8::EpiResid, pg8::StaticOrder, true, true, FP8D ? MXM : 0>(F.lds + RING_OFF, g, S, E, F.tid);
            ctx_gemm<FP8D>(F, (const void*)(big + B_HB), (const void*)(ev + EV_WDN), FP8D ? DFF : 2 * DFF, D, CtxEpiResid{XS, mode + 4 * 6144 + 5 * 1024, GS(7) * (FP8D ? WSC_INV : 1.0f)}); }
        SEAM();
        for (int rep_ = 0; rep_ < NREP(8); ++rep_) if (PH_ON(8) && IN()) { FRESH(); LAYER_PTRS(); nm_phase(F, args, false, modo, 0, 1024); }
        SEAM();
        for (int rep_ = 0; rep_ < NREP(9); ++rep_) if (PH_ON(9) && IN()) { FRESH(); LAYER_PTRS(); pg8::Gemm g{H, (const bf16*)(od + OD_WCD), MLAT, CD_INP, D, 0}; pg8::StaticOrder S; S.init(MLAT, CD_INP, F.G, F.bx, 1);
            pg8::EpiZ<false> E{(bf16*)(big + B_Z), CD_INP, 0, 1.0f};
            pg8::gemm_phase<pg8::EpiZ<false>, pg8::StaticOrder, true, true>(F.lds + RING_OFF, g, S, E, F.tid);
            ctx_gemm<false>(F, H, (const bf16*)(od + OD_WCD), 2 * D, CD_INP, CtxEpiZ{(bf16*)(big + B_Z), CD_INP, 0}); }
        SEAM();
        for (int rep_ = 0; rep_ < NREP(10); ++rep_) if (PH_ON(10) && IN()) { FRESH(); cdmid_phase(F, args, lp); convert_moe(F, args, lp); }
        SEAM();
        for (int rep_ = 0; rep_ < NREP(11); ++rep_) if (PH_ON(11) && IN()) { FRESH(); LAYER_PTRS(); pg8::Gemm g{(const bf16*)(big + B_CQN), (const bf16*)(od + OD_WUQ), M, 768, 384, 0}; pg8::StaticOrder S; S.init(M, 768, F.G, F.bx);
              pg8::EpiQD E{(unsigned char*)(big + B_QD), (const float*)(ws + WS_ROPE)};
              pg8::gemm_phase<pg8::EpiQD, pg8::StaticOrder, true, true>(F.lds + RING_OFF, g, S, E, F.tid); }
        for (int rep_ = 0; rep_ < NREP(12); ++rep_) if (PH_ON(12) && IN()) { FRESH(); LAYER_PTRS(); pg8::Gemm g{(const bf16*)(big + B_CKVN), (const bf16*)(od + OD_WUKV), M, 1024, 256, 0}; pg8::StaticOrder S; S.init(M, 1024, F.G, F.bx);
              pg8::EpiKVD E{(unsigned char*)(big + B_KD), (bf16*)(big + B_VD)};
              pg8::gemm_phase<pg8::EpiKVD, pg8::StaticOrder, true, true>(F.lds + RING_OFF, g, S, E, F.tid); }
        SEAM();
        for (int rep_ = 0; rep_ < NREP(21); ++rep_) if (PH_ON(21) && IN()) { FRESH(); vtrans_phase(F); }
        SEAM();
        for (int rep_ = 0; rep_ < NREP(13); ++rep_) if (PH_ON(13) && IN()) { FRESH(); int b, h, qb;
            for (int i = 0; attn_deal(F.G, F.bx, i, 0, b, h, qb); ++i) attn_do_unit(F, 0, b, h, qb); }
        for (int rep_ = 0; rep_ < NREP(14); ++rep_) if (PH_ON(14) && IN()) { FRESH(); int b, h, qb;
            for (int i = 0; attn_deal(F.G, F.bx, i, 32, b, h, qb); ++i) attn_do_unit(F, 1, b, h, qb); }
        SEAM();
        for (int rep_ = 0; rep_ < NREP(15); ++rep_) if (PH_ON(15) && IN()) { FRESH(); LAYER_PTRS(); pg8::Gemm g{(const bf16*)(big + B_Y), (const bf16*)(od + OD_WCDO), MLAT, D, D, 0}; pg8::StaticOrder S; S.init(MLAT, D, F.G, F.bx, 1);
            pg8::EpiResid E{XS, modo + 2 * 1024, GS(15)};
            pg8::gemm_phase<pg8::EpiResid, pg8::StaticOrder, true, true>(F.lds + RING_OFF, g, S, E, F.tid);
            ctx_gemm<false>(F, (const bf16*)(big + B_Y), (const bf16*)(od + OD_WCDO), 2 * D, D, CtxEpiResid{XS, modo + 4 * 6144 + 2 * 1024, GS(15)}); }
        SEAM();
        for (int rep_ = 0; rep_ < NREP(16); ++rep_) if (PH_ON(16) && IN()) { FRESH(); LAYER_PTRS(); route_phase(F, args, lp, modo); }
        SEAM();
        for (int rep_ = 0; rep_ < NREP(17); ++rep_) if (PH_ON(17) && IN()) { FRESH(); LAYER_PTRS(); slots_phase(F, args, modo); }
        SEAM();
        for (int rep_ = 0; rep_ < NREP(18); ++rep_) if (PH_ON(18) && IN()) { FRESH(); const unsigned* pexp = (const unsigned*)(ws + WS_PEXP);
            const int npan = __builtin_amdgcn_readfirstlane((int)__hip_atomic_load(pexp + 511, __ATOMIC_RELAXED, __HIP_MEMORY_SCOPE_AGENT));
            pg8::Gemm g{(const bf16*)(big + B_HS), (const bf16*)(ws + WS_WMOE), npan * 256, 2 * DFF, FP8M ? D / 2 : D, FP8M ? MOE_WGU8 : MOE_WGU}; pg8::MoeOrder S; S.init(npan, 2 * DFF, F.G, F.bx, pexp, F.lane);
            pg8::EpiSwiglu<FP8M> E{(bf16*)(big + B_HM), DFF, FP8M ? WSC_INV : 1.0f};
            pg8::gemm_phase<pg8::EpiSwiglu<FP8M>, pg8::MoeOrder, MOE_ALIGN, MOE_SP2, FP8M ? MXM : 0>(F.lds + RING_OFF, g, S, E, F.tid); }
        SEAM();
        for (int rep_ = 0; rep_ < NREP(19); ++rep_) if (PH_ON(19) && IN()) { FRESH(); const unsigned* pexp = (const unsigned*)(ws + WS_PEXP);
            const int npan = __builtin_amdgcn_readfirstlane((int)__hip_atomic_load(pexp + 511, __ATOMIC_RELAXED, __HIP_MEMORY_SCOPE_AGENT));
            pg8::Gemm g{(const bf16*)(big + B_HM), (const bf16*)(ws + WS_WMOE + (FP8M ? MOE_WDN_OFF8 : MOE_WDN_OFF)), npan * 256, D, FP8M ? DFF / 2 : DFF, FP8M ? MOE_WDN8 : MOE_WDN}; pg8::MoeOrder S; S.init(npan, D, F.G, F.bx, pexp, F.lane);
            pg8::EpiZ<false> E{(bf16*)(big + B_HS), D, 0, FP8M ? WSC_INV : 1.0f};
            pg8::gemm_phase<pg8::EpiZ<false>, pg8::MoeOrder, MOE_ALIGN, MOE_SP2, FP8M ? MXM : 0>(F.lds + RING_OFF, g, S, E, F.tid); }
        SEAM();
        for (int rep_ = 0; rep_ < NREP(20); ++rep_) if (PH_ON(20) && IN()) { FRESH(); LAYER_PTRS(); combine_phase(F, args, modo, lp == 1, MOD + (size_t)(2 * lp + 2 < 4 ? 2 * lp + 2 : 0) * 5 * 6144, (NREP(20) == 2 && rep_ == 0) ? 0.0f : 1.0f); }
        SEAM();
    }
    if (hi == N_PHASES) { if (__hip_atomic_load(barw + XB_TMO, __ATOMIC_RELAXED, __HIP_MEMORY_SCOPE_AGENT) != 0u) {
        const float q = __builtin_nanf("");
        const int tid_e = F0.wave * 64 + (int)__builtin_amdgcn_mbcnt_hi(~0u, __builtin_amdgcn_mbcnt_lo(~0u, 0u));
        for (size_t i = (size_t)blockIdx.x * (NWAVES * 64) + tid_e; i < (size_t)BATCH * SEQ * D; i += (size_t)F.G * NWAVES * 64) args_k.out[i] = q; } }
#undef IN
#undef SEAM
}

#ifndef HDP_N_LAUNCHES
#define HDP_N_LAUNCHES 1
#endif
extern "C" void kernel_launch(void* const* d_in, const int* in_sizes, int n_in, void* d_out, int out_size, void* d_ws, size_t ws_size, hipStream_t stream) {
    static int grid = 0;
    if (grid == 0) {
        int dev = 0, cus = 0;
        if (n_in != 29 || out_size != BATCH * SEQ * D || hipGetDevice(&dev) != hipSuccess || hipDeviceGetAttribute(&cus, hipDeviceAttributeMultiprocessorCount, dev) != hipSuccess) { fprintf(stderr, "kernel_launch: unexpected problem shape or device query failure\n"); grid = -1; }
        else if (hipFuncSetAttribute((const void*)hdp_fwd, hipFuncAttributeMaxDynamicSharedMemorySize, LDS_BYTES) != hipSuccess) { fprintf(stderr, "kernel_launch: hipFuncSetAttribute failed\n"); grid = -1; }
        else { int per_cu = 0; (void)hipOccupancyMaxActiveBlocksPerMultiprocessor(&per_cu, (const void*)hdp_fwd, NWAVES * 64, LDS_BYTES); (void)hipGetLastError();
            grid = (per_cu >= 1 && cus >= 32) ? cus : -1; if (grid > 1024) grid = 1024; }
    }
    if (grid < 0 || ws_size < WS_END) {
        (void)hipMemsetAsync(d_out, 0xFF, (size_t)out_size * 4, stream); return; }
    (void)hipMemsetAsync((char*)d_ws + WS_CTL, 0, CTL_ZERO_BYTES, stream);
    Args a{};
    for (int i = 0; i < 29; ++i) a.in[i] = (const float*)d_in[i];
    a.out = (float*)d_out; a.ws = (unsigned char*)d_ws;
#if HDP_N_LAUNCHES == 1
    a.ph_lo = 0; a.ph_hi = N_PHASES;
    hipLaunchKernelGGL(hdp_fwd, dim3(grid), dim3(NWAVES * 64), LDS_BYTES, stream, a);
#else
    for (int p = 0; p < N_PHASES; ++p) { a.ph_lo = p; a.ph_hi = p + 1; hipLaunchKernelGGL(hdp_fwd, dim3(grid), dim3(NWAVES * 64), LDS_BYTES, stream, a); }
#endif
}
```

```cpp
#include <hip/hip_runtime.h>
#include <cstdio>
#include <cstdint>

namespace pg8 {
#define PG8_LAS __attribute__((address_space(3)))
typedef unsigned short bf16_t;
typedef short bf16x8 __attribute__((ext_vector_type(8)));
typedef float f32x4 __attribute__((ext_vector_type(4)));
typedef unsigned u32x4 __attribute__((ext_vector_type(4)));
constexpr int BM = 256, BK = 64, HALF = 128, HTB = HALF * BK * 2  , STAGE_BYTES = 8 * HTB, NXCD = 8, WGM = 8;

__host__ __device__ __forceinline__ int lds_byte(int r, int c) { const int st = (r >> 4) * 2 + (c >> 5), rr = r & 15, cc = c & 31, ob = rr * 64 + cc * 2; return st * 1024 + (ob ^ (((ob >> 9) & 1) << 5)); }
__host__ __device__ __forceinline__ void stage_rc(int b, int& R, int& C) { const int st = b / 1024, sb = b % 1024, swz = sb ^ (((sb >> 9) & 1) << 5); R = (st >> 1) * 16 + swz / 64; C = (st & 1) * 32 + (swz % 64) / 2; }
__host__ __device__ __forceinline__ int perm32(int rho) { const int n = rho >> 4, i = rho & 15; return 8 * (i >> 2) + 4 * n + (i & 3); }

struct Unit { int pm, pn, e; };
struct Gemm { const bf16_t* A; const bf16_t* Bt; int M, N, K; size_t bes; };

struct StaticOrder {
    int nM, nN, nwg, G, c, lat;
    __host__ __device__ void init(int M, int N, int G_, int c_, int lat_ = 0) { nM = M / BM; nN = N / BM; nwg = nM * nN; G = G_; c = c_; lat = lat_; }
    __host__ __device__ bool next(int i, Unit& u) const {
        const long L = (long)i * G + c; if (L >= nwg) return false;
        int wgid = (int)L; { const int q = nwg / NXCD, r = nwg % NXCD, xcd = wgid % NXCD, off = wgid / NXCD; wgid = (xcd < r ? xcd * (q + 1) : r * (q + 1) + (xcd - r) * q) + off; }
        const int nig = WGM * nN, gid = wgid / nig, fm = gid * WGM, gsz = (nM - fm) < WGM ? (nM - fm) : WGM;
        u.pm = fm + ((wgid % nig) % gsz); u.pn = (wgid % nig) / gsz; u.e = 0; if (lat) u.pm = u.pm + (u.pm >> 5) + 1; return true;
    }
    __device__ __forceinline__ void a_ready(const Unit&) const {}
    __device__ __forceinline__ void done(const Unit&) const {}
};

__device__ __forceinline__ unsigned cvt_pk_bf16(float lo, float hi) { unsigned r; asm volatile("v_cvt_pk_bf16_f32 %0, %1, %2" : "=v"(r) : "v"(lo), "v"(hi)); return r; }
typedef float f32x2 __attribute__((ext_vector_type(2)));
__device__ __forceinline__ f32x2 gelu_pk(f32x2 v) {
    const f32x2 av = __builtin_elementwise_abs(v), d = av * 0.2316418882f + 1.0f;
    f32x2 t; t.x = __builtin_amdgcn_rcpf(d.x); t.y = __builtin_amdgcn_rcpf(d.y);
    f32x2 q = t * 0.5307027145f + (-0.7265760135f); q = q * t + 0.7107068705f; q = q * t + (-0.142248368f); q = q * t + 0.127414796f; q = q * t;
    const f32x2 s = (v * v) * (-0.72134752044f);
    f32x2 e; e.x = __builtin_amdgcn_exp2f(s.x); e.y = __builtin_amdgcn_exp2f(s.y);
    const f32x2 m = v * (q * e), r = v - m;
    f32x2 o; o.x = v.x < 0.f ? m.x : r.x; o.y = v.y < 0.f ? m.y : r.y; return o;
}

template <int ACT  > struct EpiBf16 {
    static constexpr bool PERM = true, AFTER_DRAIN = false; static_assert(ACT == 0 || ACT == 1, "EpiBf16: ACT is 0 (none) or 1 (gelu_pk)");
    bf16_t* O; int ldc; const float* bias; int split_cols; size_t split_stride; float scale0;
    __device__ __forceinline__ void operator()(const f32x4 (&acc)[2][2][4][2], const Unit& u, int wr, int wc, int fr, int fq) const {
        const int row0 = u.pm * BM + wr * 64 + fr; int colt = u.pn * BM; bf16_t* base = O;
        float sc = 1.f; if (split_cols) { const int t = colt / split_cols; base += (size_t)t * split_stride; colt -= t * split_cols; if (t == 0) sc = scale0; }
        const int col0 = colt + wc * 32 + 8 * fq, bcol0 = u.pn * BM + wc * 32 + 8 * fq;
        f32x4 bv[2][2];
#pragma unroll
        for (int bj = 0; bj < 2; ++bj)
#pragma unroll
            for (int n = 0; n < 2; ++n) bv[bj][n] = bias ? *(const f32x4*)(bias + bcol0 + bj * HALF + 4 * n) : (f32x4){0.f, 0.f, 0.f, 0.f};
#pragma unroll
        for (int ai = 0; ai < 2; ++ai)
#pragma unroll
            for (int m = 0; m < 4; ++m) { bf16_t* rowp = base + (size_t)(row0 + ai * HALF + m * 16) * ldc + col0;
#pragma unroll
                for (int bj = 0; bj < 2; ++bj) { f32x4 v0 = acc[ai][bj][m][0] + bv[bj][0], v1 = acc[ai][bj][m][1] + bv[bj][1];
                    if (ACT == 1) { f32x2 a = gelu_pk((f32x2){v0[0], v0[1]}), b = gelu_pk((f32x2){v0[2], v0[3]}), c = gelu_pk((f32x2){v1[0], v1[1]}), d = gelu_pk((f32x2){v1[2], v1[3]});
                        v0 = (f32x4){a.x, a.y, b.x, b.y}; v1 = (f32x4){c.x, c.y, d.x, d.y}; }
                    v0 = v0 * sc; v1 = v1 * sc; u32x4 w; w.x = cvt_pk_bf16(v0[0], v0[1]); w.y = cvt_pk_bf16(v0[2], v0[3]); w.z = cvt_pk_bf16(v1[0], v1[1]); w.w = cvt_pk_bf16(v1[2], v1[3]);
                    *(u32x4*)(rowp + bj * HALF) = w; } }
    }
};

constexpr int PAN_B = 33;
__device__ __forceinline__ int modrow_of_panel(int pm) { const int b = pm / PAN_B; return (pm - b * PAN_B == 0) ? 4 : b; }
__device__ __forceinline__ unsigned pk4_fp8(float a, float b, float c, float d) { int w = 0; w = __builtin_amdgcn_cvt_pk_fp8_f32(a, b, w, false); w = __builtin_amdgcn_cvt_pk_fp8_f32(c, d, w, true); return (unsigned)w; }
__device__ __forceinline__ float silu_f(float g) { return g * __builtin_amdgcn_rcpf(1.0f + __builtin_amdgcn_exp2f(-1.4426950408889634f * g)); }

template <bool GELU> struct EpiZ {
    static constexpr bool PERM = true, AFTER_DRAIN = false;
    bf16_t* O; int ldc; int gelu_tiles; float oscale;
    __device__ __forceinline__ void operator()(const f32x4 (&acc)[2][2][4][2], const Unit& u, int wr, int wc, int fr, int fq) const {
        const int row0 = u.pm * BM + wr * 64 + fr, col0 = u.pn * BM + wc * 32 + 8 * fq;
        const bool g = GELU && (u.pn < gelu_tiles);
#pragma unroll
        for (int ai = 0; ai < 2; ++ai)
#pragma unroll
            for (int m = 0; m < 4; ++m) { bf16_t* rowp = O + (size_t)(row0 + ai * HALF + m * 16) * ldc + col0;
#pragma unroll
                for (int bj = 0; bj < 2; ++bj) { f32x4 v0 = acc[ai][bj][m][0], v1 = acc[ai][bj][m][1];
                    if (GELU) { if (g) { f32x2 a = gelu_pk((f32x2){v0[0], v0[1]}), b = gelu_pk((f32x2){v0[2], v0[3]}), c = gelu_pk((f32x2){v1[0], v1[1]}), d = gelu_pk((f32x2){v1[2], v1[3]});
                        v0 = (f32x4){a.x, a.y, b.x, b.y}; v1 = (f32x4){c.x, c.y, d.x, d.y}; } }
                    v0 = v0 * oscale; v1 = v1 * oscale;
                    u32x4 w; w.x = cvt_pk_bf16(v0[0], v0[1]); w.y = cvt_pk_bf16(v0[2], v0[3]); w.z = cvt_pk_bf16(v1[0], v1[1]); w.w = cvt_pk_bf16(v1[2], v1[3]);
                    *(u32x4*)(rowp + bj * HALF) = w; } }
    }
};
struct EpiResid {
    static constexpr bool PERM = false, AFTER_DRAIN = false;
    bf16_t* X; const float* gate; float gscale;
    __device__ __forceinline__ void operator()(const f32x4 (&acc)[2][2][4][2], const Unit& u, int wr, int wc, int fr, int fq) const {
        const float* gp = gate + (size_t)modrow_of_panel(u.pm) * 6144;
        const int col0 = u.pn * BM + wc * 32 + 4 * fq;
        f32x4 gv[2][2];
#pragma unroll
        for (int bj = 0; bj < 2; ++bj)
#pragma unroll
            for (int n = 0; n < 2; ++n) gv[bj][n] = *(const f32x4*)(gp + col0 + bj * HALF + n * 16) * gscale;
        typedef unsigned u32x2v __attribute__((ext_vector_type(2)));
#pragma unroll
        for (int ai = 0; ai < 2; ++ai)
#pragma unroll
            for (int m = 0; m < 4; ++m) { bf16_t* p = X + (size_t)(u.pm * BM + ai * HALF + wr * 64 + m * 16 + fr) * 1024 + col0;
                u32x2v r[2][2];
#pragma unroll
                for (int bj = 0; bj < 2; ++bj)
#pragma unroll
                    for (int n = 0; n < 2; ++n) r[bj][n] = *(const u32x2v*)(p + bj * HALF + n * 16);
#pragma unroll
                for (int bj = 0; bj < 2; ++bj)
#pragma unroll
                    for (int n = 0; n < 2; ++n) { const u32x2v rr = r[bj][n];
                        f32x4 x = (f32x4){__uint_as_float(rr.x << 16), __uint_as_float(rr.x & 0xffff0000u), __uint_as_float(rr.y << 16), __uint_as_float(rr.y & 0xffff0000u)}; x = x + gv[bj][n] * acc[ai][bj][m][n];
                        u32x2v w; w.x = cvt_pk_bf16(x[0], x[1]); w.y = cvt_pk_bf16(x[2], x[3]); *(u32x2v*)(p + bj * HALF + n * 16) = w; }
                if (m & 1) asm volatile("" ::: "memory"); }
    }
};
template <bool OUT8> struct EpiSwiglu {
    static constexpr bool PERM = true, AFTER_DRAIN = false;
    bf16_t* O; int ldc; float iscale;
    __device__ __forceinline__ void operator()(const f32x4 (&acc)[2][2][4][2], const Unit& u, int wr, int wc, int fr, int fq) const {
        const int row0 = u.pm * BM + wr * 64 + fr, col0 = u.pn * HALF + wc * 32 + 8 * fq;
#pragma unroll
        for (int ai = 0; ai < 2; ++ai)
#pragma unroll
            for (int m = 0; m < 4; ++m) {
                const f32x4 g0 = acc[ai][0][m][0] * iscale, g1 = acc[ai][0][m][1] * iscale, u0 = acc[ai][1][m][0] * iscale, u1 = acc[ai][1][m][1] * iscale;
                float h[8];
#pragma unroll
                for (int j = 0; j < 4; ++j) { h[j] = silu_f(g0[j]) * u0[j]; h[4 + j] = silu_f(g1[j]) * u1[j]; }
                if (OUT8) { typedef unsigned u32x2v __attribute__((ext_vector_type(2))); unsigned char* rowp = (unsigned char*)O + (size_t)(row0 + ai * HALF + m * 16) * ldc + col0;
                    u32x2v w; w.x = pk4_fp8(h[0], h[1], h[2], h[3]); w.y = pk4_fp8(h[4], h[5], h[6], h[7]); *(u32x2v*)rowp = w; }
                else { bf16_t* rowp = O + (size_t)(row0 + ai * HALF + m * 16) * ldc + col0;
                    u32x4 w; w.x = cvt_pk_bf16(h[0], h[1]); w.y = cvt_pk_bf16(h[2], h[3]); w.z = cvt_pk_bf16(h[4], h[5]); w.w = cvt_pk_bf16(h[6], h[7]); *(u32x4*)rowp = w; } }
    }
};
constexpr float QD_SCALE = 0.10206207261596575f * 1.4426950408889634f;
struct EpiQD {
    static constexpr bool PERM = false, AFTER_DRAIN = false;
    unsigned char* O; const float* rope;
    __device__ __forceinline__ void operator()(const f32x4 (&acc)[2][2][4][2], const Unit& u, int wr, int wc, int fr, int fq) const {
        const int pb = u.pm / PAN_B, pj = u.pm - pb * PAN_B; const bool latent = pj != 0;
        f32x4 csv[2][4], snv[2][4];
#pragma unroll
        for (int ai = 0; ai < 2; ++ai)
#pragma unroll
            for (int m = 0; m < 4; ++m) { const int rin = ai * HALF + wr * 64 + m * 16 + fr; const int s = latent ? (pj - 1) * 256 + rin : 0;
                csv[ai][m] = *(const f32x4*)(rope + (size_t)s * 32 + 4 * fq); snv[ai][m] = *(const f32x4*)(rope + (size_t)s * 32 + 16 + 4 * fq); }
#pragma unroll
        for (int ai = 0; ai < 2; ++ai)
#pragma unroll
            for (int m = 0; m < 4; ++m) { const int rin = ai * HALF + wr * 64 + m * 16 + fr;
                const f32x4 cs = csv[ai][m], sn = snv[ai][m];
                unsigned char* rowp = O + (size_t)(u.pm * BM + rin) * 1024;
#pragma unroll
                for (int bj = 0; bj < 2; ++bj) { const int cb = 8 * u.pn + 4 * bj + wc; f32x4 x1 = acc[ai][bj][m][0], x2 = acc[ai][bj][m][1];
                    if (latent && (cb % 3 == 2)) { const f32x4 o1 = x1 * cs - x2 * sn, o2 = x1 * sn + x2 * cs; x1 = o1; x2 = o2; }
                    x1 = x1 * QD_SCALE; x2 = x2 * QD_SCALE;
                    const int c1 = u.pn * BM + bj * HALF + wc * 32 + 4 * fq, c2 = c1 + 16, h1 = c1 / 96, h2 = c2 / 96;
                    *(unsigned*)(rowp + h1 * 128 + (c1 - h1 * 96)) = pk4_fp8(x1[0], x1[1], x1[2], x1[3]); *(unsigned*)(rowp + h2 * 128 + (c2 - h2 * 96)) = pk4_fp8(x2[0], x2[1], x2[2], x2[3]); } }
    }
};
struct EpiKVD {
    static constexpr bool PERM = true, AFTER_DRAIN = false;
    unsigned char* KD; bf16_t* VD;
    __device__ __forceinline__ void operator()(const f32x4 (&acc)[2][2][4][2], const Unit& u, int wr, int wc, int fr, int fq) const {
        const int row0 = u.pm * BM + wr * 64 + fr;
#pragma unroll
        for (int ai = 0; ai < 2; ++ai)
#pragma unroll
            for (int m = 0; m < 4; ++m) { const size_t row = (size_t)(row0 + ai * HALF + m * 16);
#pragma unroll
                for (int bj = 0; bj < 2; ++bj) { const int head = 2 * u.pn + bj; const f32x4 v0 = acc[ai][bj][m][0], v1 = acc[ai][bj][m][1];
                    if (wc < 2) { typedef unsigned u32x2v __attribute__((ext_vector_type(2))); u32x2v w8; w8.x = pk4_fp8(v0[0], v0[1], v0[2], v0[3]); w8.y = pk4_fp8(v1[0], v1[1], v1[2], v1[3]);
                        *(u32x2v*)(KD + row * 1024 + 128 * head + 32 * wc + 8 * fq) = w8; }
                    else { u32x4 w; w.x = cvt_pk_bf16(v0[0], v0[1]); w.y = cvt_pk_bf16(v0[2], v0[3]); w.z = cvt_pk_bf16(v1[0], v1[1]); w.w = cvt_pk_bf16(v1[2], v1[3]);
                        *(u32x4*)(VD + row * 512 + 64 * head + 32 * (wc - 2) + 8 * fq) = w; } } }
    }
};
struct MoeOrder {
    int nM, nN, nwg, G, c; unsigned t0, t1, t2, t3, t4;
    __device__ void init(int npanels, int N, int G_, int c_, const unsigned* pexp, int lane) { nM = npanels; nN = N / BM; nwg = nM * nN; G = G_; c = c_;
        t0 = __hip_atomic_load(pexp + lane, __ATOMIC_RELAXED, __HIP_MEMORY_SCOPE_AGENT); t1 = __hip_atomic_load(pexp + 64 + lane, __ATOMIC_RELAXED, __HIP_MEMORY_SCOPE_AGENT);
        t2 = __hip_atomic_load(pexp + 128 + lane, __ATOMIC_RELAXED, __HIP_MEMORY_SCOPE_AGENT); t3 = __hip_atomic_load(pexp + 192 + lane, __ATOMIC_RELAXED, __HIP_MEMORY_SCOPE_AGENT);
        t4 = __hip_atomic_load(pexp + 256 + lane, __ATOMIC_RELAXED, __HIP_MEMORY_SCOPE_AGENT); }
    __device__ bool next(int i, Unit& u) const {
        const long L = (long)i * G + c; if (L >= nwg) return false;
        int wgid = (int)L; { const int q = nwg / NXCD, r = nwg % NXCD, xcd = wgid % NXCD, off = wgid / NXCD; wgid = (xcd < r ? xcd * (q + 1) : r * (q + 1) + (xcd - r) * q) + off; }
        const int nig = WGM * nN, gid = wgid / nig, fm = gid * WGM, gsz = (nM - fm) < WGM ? (nM - fm) : WGM;
        u.pm = fm + ((wgid % nig) % gsz); u.pn = (wgid % nig) / gsz;
        const int k = u.pm >> 6; const unsigned tv = (k == 0) ? t0 : (k == 1) ? t1 : (k == 2) ? t2 : (k == 3) ? t3 : t4;
        u.e = __builtin_amdgcn_readlane((int)tv, u.pm & 63); return true;
    }
    __device__ __forceinline__ void a_ready(const Unit&) const {}
    __device__ __forceinline__ void done(const Unit&) const {}
};

template <class Epi, class Sched, bool ALIGN_EPI = false, bool SP2 = false, int F8 = 0>
__device__ __forceinline__ void gemm_phase(PG8_LAS unsigned char* lds, const Gemm g, const Sched& S, const Epi& E, int tid_in) {
    typedef int fr4_ __attribute__((ext_vector_type(4))); typedef int fr8_ __attribute__((ext_vector_type(8)));
    int tid_ = tid_in; asm volatile("" : "+v"(tid_));
    const int tid = tid_, wid = __builtin_amdgcn_readfirstlane(tid >> 6), lane = tid & 63, wr = wid >> 2, wc = wid & 3, fr = lane & 15, fq = lane >> 4;
    const int K = g.K, nt = K / BK;
    unsigned voffA[2], voffB[2];
#pragma unroll
    for (int i = 0; i < 2; ++i) { int R, C; stage_rc(tid * 16 + i * 8192, R, C); const int Rb = Epi::PERM ? ((R & ~31) + perm32(R & 31)) : R;
        voffA[i] = (unsigned)(R * K + C) * 2u; voffB[i] = (unsigned)(Rb * K + C) * 2u; }
    const size_t kstep = (size_t)(BK * 2);
    const size_t hstep = (size_t)HALF * K * 2;
    const size_t tstep = 2 * hstep;
    const unsigned ldsw = (unsigned)wid * 1024u;
    const int aoff = lds_byte(wr * 64 + fr, fq * 8), boff = lds_byte(wc * 32 + fr, fq * 8);
#define PG8_SA(b, h) (((b) * 2 + (h)) * HTB)
#define PG8_SB(b, h) ((4 + (b) * 2 + (h)) * HTB)
#define PG8_STAGE(bufoff, gbase, voff) do { _Pragma("unroll") for (int _i = 0; _i < 2; ++_i) \
        __builtin_amdgcn_global_load_lds((const unsigned*)((const char*)(gbase) + (voff)[_i]), (PG8_LAS unsigned*)(lds + (bufoff) + ldsw + _i * 8192), 16, 0, 0); } while (0)
#define PG8_LDA(dst, b, h) do { _Pragma("unroll") for (int m = 0; m < 4; ++m) { const fr4_ lo_ = *(const PG8_LAS fr4_*)(lds + PG8_SA(b, h) + aoff + m * 2048), hi_ = *(const PG8_LAS fr4_*)(lds + PG8_SA(b, h) + aoff + m * 2048 + 1024); \
        dst[m] = __builtin_shufflevector(lo_, hi_, 0, 1, 2, 3, 4, 5, 6, 7); } } while (0)
#define PG8_LDB(dst, b, h) do { _Pragma("unroll") for (int n = 0; n < 2; ++n) { const fr4_ lo_ = *(const PG8_LAS fr4_*)(lds + PG8_SB(b, h) + boff + n * 2048), hi_ = *(const PG8_LAS fr4_*)(lds + PG8_SB(b, h) + boff + n * 2048 + 1024); \
        dst[n] = __builtin_shufflevector(lo_, hi_, 0, 1, 2, 3, 4, 5, 6, 7); } } while (0)
#define PG8_MMA1(ACC, b4_, a4_) do { \
            if constexpr (F8 == 1) { typedef long l2_ __attribute__((ext_vector_type(2))); const l2_ b_ = __builtin_bit_cast(l2_, b4_), a_ = __builtin_bit_cast(l2_, a4_); \
                ACC = __builtin_amdgcn_mfma_f32_16x16x32_fp8_fp8(b_[0], a_[0], ACC, 0, 0, 0); ACC = __builtin_amdgcn_mfma_f32_16x16x32_fp8_fp8(b_[1], a_[1], ACC, 0, 0, 0); } \
            else ACC = __builtin_amdgcn_mfma_f32_16x16x32_bf16(__builtin_bit_cast(bf16x8, b4_), __builtin_bit_cast(bf16x8, a4_), ACC, 0, 0, 0); } while (0)
#define PG8_MMA(ai, bj, At, Bt) do { __builtin_amdgcn_s_setprio(1); \
      _Pragma("unroll") for (int m = 0; m < 4; ++m) _Pragma("unroll") for (int n = 0; n < 2; ++n) { \
        if constexpr (F8 == 2) asm volatile("v_mfma_scale_f32_16x16x128_f8f6f4 %0, %1, %2, %0, %3, %3 op_sel_hi:[0,0,0]" : "+v"(acc[ai][bj][m][n]) : "v"(Bt[n]), "v"(At[m]), "v"(mxscale_));     \
        else { const fr4_ b0_ = __builtin_shufflevector(Bt[n], Bt[n], 0, 1, 2, 3), a0_ = __builtin_shufflevector(At[m], At[m], 0, 1, 2, 3); PG8_MMA1(acc[ai][bj][m][n], b0_, a0_); \
               const fr4_ b1_ = __builtin_shufflevector(Bt[n], Bt[n], 4, 5, 6, 7), a1_ = __builtin_shufflevector(At[m], At[m], 4, 5, 6, 7); PG8_MMA1(acc[ai][bj][m][n], b1_, a1_); } } \
      __builtin_amdgcn_s_setprio(0); } while (0)
#define PG8_WAIT_V(n) asm volatile("s_waitcnt vmcnt(" #n ")" ::: "memory")
#define PG8_WAIT_L(n) asm volatile("s_waitcnt lgkmcnt(" #n ")" ::: "memory")
#define PG8_BAR __builtin_amdgcn_s_barrier()
#define PG8_SCHED __builtin_amdgcn_sched_barrier(0)
    int mxscale_ = 0x7F7F7F7F; asm volatile("" : "+v"(mxscale_));
    Unit cur, nxt; int ui = 0;
    if (!S.next(0, cur)) return;
    f32x4 acc[2][2][4][2];
#pragma unroll
    for (int a = 0; a < 2; ++a)
#pragma unroll
        for (int b = 0; b < 2; ++b)
#pragma unroll
            for (int m = 0; m < 4; ++m)
#pragma unroll
                for (int n = 0; n < 2; ++n) acc[a][b][m][n] = (f32x4){0.f, 0.f, 0.f, 0.f};
    fr8_ At[4], B0[2], B1[2];
    const char* cA = (const char*)g.A + (size_t)cur.pm * tstep; const char* cB = (const char*)g.Bt + (size_t)cur.e * g.bes + (size_t)cur.pn * tstep;
    S.a_ready(cur);
    if constexpr (SP2) {
        PG8_STAGE(PG8_SB(0, 0), cB, voffB); PG8_STAGE(PG8_SB(0, 1), cB + hstep, voffB); PG8_STAGE(PG8_SA(0, 0), cA, voffA); PG8_STAGE(PG8_SA(0, 1), cA + hstep, voffA);
        if (wr == 1) PG8_BAR;
        PG8_WAIT_V(2); PG8_BAR;
        PG8_STAGE(PG8_SB(1, 0), cB + kstep, voffB); PG8_STAGE(PG8_SA(1, 0), cA + kstep, voffA); PG8_STAGE(PG8_SB(1, 1), cB + hstep + kstep, voffB);
        PG8_WAIT_V(6); PG8_BAR;
    } else {
        PG8_STAGE(PG8_SB(0, 0), cB, voffB); PG8_STAGE(PG8_SA(0, 0), cA, voffA); PG8_STAGE(PG8_SB(0, 1), cB + hstep, voffB); PG8_STAGE(PG8_SA(0, 1), cA + hstep, voffA);
        if (wr == 1) PG8_BAR;
        PG8_WAIT_V(4); PG8_BAR;
        PG8_STAGE(PG8_SB(1, 0), cB + kstep, voffB); PG8_STAGE(PG8_SA(1, 0), cA + kstep, voffA); PG8_STAGE(PG8_SB(1, 1), cB + hstep + kstep, voffB);
        PG8_WAIT_V(6); PG8_BAR;
    }
    for (;;) {
        const bool has_next = S.next(ui + 1, nxt);
        const char* nA = has_next ? (const char*)g.A + (size_t)nxt.pm * tstep : cA; const char* nB = has_next ? (const char*)g.Bt + (size_t)nxt.e * g.bes + (size_t)nxt.pn * tstep : cB;
#pragma unroll 1
        for (int t = 0; t < nt; t += 2) {
            const bool last = (t == nt - 2);
            const char* a1 = cA + (size_t)(t + 1) * kstep;
            const char* a2 = last ? nA : cA + (size_t)(t + 2) * kstep; const char* b2 = last ? nB : cB + (size_t)(t + 2) * kstep;
            const char* a3 = a2 + kstep; const char* b3 = b2 + kstep;
            if (last && has_next) S.a_ready(nxt);
            if constexpr (SP2) {
            PG8_LDB(B0, 0, 0); PG8_LDB(B1, 0, 1); PG8_SCHED; PG8_LDA(At, 0, 0); PG8_STAGE(PG8_SA(1, 1), a1 + hstep, voffA);
            PG8_WAIT_V(8); PG8_WAIT_L(0); PG8_BAR; PG8_MMA(0, 0, At, B0); PG8_MMA(0, 1, At, B1); PG8_BAR; PG8_SCHED;
            PG8_LDA(At, 0, 1); PG8_STAGE(PG8_SB(0, 0), b2, voffB); PG8_STAGE(PG8_SB(0, 1), b2 + hstep, voffB); PG8_STAGE(PG8_SA(0, 0), a2, voffA);
            PG8_WAIT_V(8); PG8_WAIT_L(0); PG8_BAR; PG8_MMA(1, 0, At, B0); PG8_MMA(1, 1, At, B1); PG8_BAR; PG8_SCHED;
            PG8_LDB(B0, 1, 0); PG8_LDB(B1, 1, 1); PG8_SCHED; PG8_LDA(At, 1, 0); PG8_STAGE(PG8_SA(0, 1), a2 + hstep, voffA);
            PG8_WAIT_V(8); PG8_WAIT_L(0); PG8_BAR; PG8_MMA(0, 0, At, B0); PG8_MMA(0, 1, At, B1); PG8_BAR; PG8_SCHED;
            PG8_LDA(At, 1, 1); PG8_STAGE(PG8_SB(1, 0), b3, voffB); PG8_STAGE(PG8_SB(1, 1), b3 + hstep, voffB); PG8_STAGE(PG8_SA(1, 0), a3, voffA);
            PG8_WAIT_V(8); PG8_WAIT_L(0); PG8_BAR; PG8_MMA(1, 0, At, B0); PG8_MMA(1, 1, At, B1); PG8_BAR; PG8_SCHED;
            } else {
            PG8_LDB(B0, 0, 0); PG8_SCHED; PG8_LDA(At, 0, 0); PG8_STAGE(PG8_SA(1, 1), a1 + hstep, voffA);
            PG8_WAIT_L(8); PG8_BAR; PG8_WAIT_L(0); PG8_MMA(0, 0, At, B0); PG8_BAR; PG8_SCHED;
            PG8_LDB(B1, 0, 1); PG8_STAGE(PG8_SB(0, 0), b2, voffB);
            PG8_BAR; PG8_WAIT_L(0); PG8_MMA(0, 1, At, B1); PG8_BAR;
            PG8_LDA(At, 0, 1); PG8_STAGE(PG8_SA(0, 0), a2, voffA);
            PG8_BAR; PG8_WAIT_L(0); PG8_MMA(1, 0, At, B0); PG8_BAR; PG8_SCHED;
            PG8_STAGE(PG8_SB(0, 1), b2 + hstep, voffB);
            PG8_WAIT_V(6); PG8_BAR; PG8_MMA(1, 1, At, B1); PG8_BAR;
            PG8_LDB(B0, 1, 0); PG8_SCHED; PG8_LDA(At, 1, 0); PG8_STAGE(PG8_SA(0, 1), a2 + hstep, voffA);
            PG8_WAIT_L(8); PG8_BAR; PG8_WAIT_L(0); PG8_MMA(0, 0, At, B0); PG8_BAR; PG8_SCHED;
            PG8_LDB(B1, 1, 1); PG8_STAGE(PG8_SB(1, 0), b3, voffB);
            PG8_BAR; PG8_WAIT_L(0); PG8_MMA(0, 1, At, B1); PG8_BAR;
            PG8_LDA(At, 1, 1); PG8_STAGE(PG8_SA(1, 0), a3, voffA);
            PG8_BAR; PG8_WAIT_L(0); PG8_MMA(1, 0, At, B0); PG8_BAR; PG8_SCHED;
            PG8_STAGE(PG8_SB(1, 1), b3 + hstep, voffB);
            PG8_WAIT_V(6); PG8_BAR; PG8_MMA(1, 1, At, B1); PG8_BAR;
            }
        }
        if constexpr (F8 == 2) asm volatile("s_nop 15\n\ts_nop 15" ::: "memory");
        if constexpr (ALIGN_EPI) { if (wr == 0) PG8_BAR; }
        if constexpr (!Epi::AFTER_DRAIN) { E(acc, cur, wr, wc, fr, fq); S.done(cur); }
        if (!has_next) break;
#pragma unroll
        for (int a = 0; a < 2; ++a)
#pragma unroll
            for (int b = 0; b < 2; ++b)
#pragma unroll
                for (int m = 0; m < 4; ++m)
#pragma unroll
                    for (int n = 0; n < 2; ++n) acc[a][b][m][n] = (f32x4){0.f, 0.f, 0.f, 0.f};
        cur = nxt; cA = nA; cB = nB; ++ui;
        if constexpr (ALIGN_EPI) { if (wr == 1) PG8_BAR; }
    }
    PG8_WAIT_V(0);
    if constexpr (!ALIGN_EPI) { if (wr == 0) PG8_BAR; }
    PG8_BAR;
    if constexpr (Epi::AFTER_DRAIN) { E.fused(acc, cur, wr, wc, fr, fq, lds, wid, lane); S.done(cur); }
#undef PG8_SA
#undef PG8_SB
#undef PG8_STAGE
#undef PG8_LDA
#undef PG8_LDB
#undef PG8_MMA
#undef PG8_MMA1
#undef PG8_WAIT_V
#undef PG8_WAIT_L
#undef PG8_BAR
#undef PG8_SCHED
}
}

#define GAS __attribute__((address_space(1)))
#define LAS __attribute__((address_space(3)))
#define RLX_AGENT __ATOMIC_RELAXED, __HIP_MEMORY_SCOPE_AGENT
#define XB_TMO      128
#define XB_XCNT(j)  (256  + 64 * (j))
#define XB_XSUB(j)  (1280 + 64 * (j))
#define XB_XGEN(j)  (2304 + 64 * (j))
#define XB_TOP      3328
#define XB_TOPGEN   3392
#define XCD_BAR_WORDS 3456
#define XB_SPIN_CAP (1u << 18)

__device__ __forceinline__ unsigned xb_ld(unsigned* p)              { return __hip_atomic_load(p, __ATOMIC_RELAXED, __HIP_MEMORY_SCOPE_AGENT); }
__device__ __forceinline__ unsigned xb_add(unsigned* p, unsigned v) { return __hip_atomic_fetch_add(p, v, __ATOMIC_RELAXED, __HIP_MEMORY_SCOPE_AGENT); }
__device__ __forceinline__ unsigned xb_xcc_id() { return (unsigned)__builtin_amdgcn_s_getreg((3 << 11) | 20) & 0xFu; }
#define XB_SPIN(cond, bar) do { unsigned _sp = 0; while (cond) { __builtin_amdgcn_s_sleep(1); \
    if ((++_sp & 255u) == 0u) { if (xb_ld(&(bar)[XB_TMO])) break; if (_sp > XB_SPIN_CAP) { atomicAdd(&(bar)[XB_TMO], 1u); break; } } } } while (0)

struct XcdBarrier {
    unsigned* bar; unsigned x;
    volatile LAS unsigned* st;
};

__device__ __forceinline__ XcdBarrier xcd_barrier_post(unsigned* bar, volatile LAS unsigned* st) {
    XcdBarrier b; b.bar = bar; b.x = xb_xcc_id(); b.st = st;
    if (threadIdx.x == 0) (void)xb_add(&bar[XB_XCNT(b.x)], 1u);
    return b;
}
__device__ __forceinline__ void xcd_barrier_complete(unsigned* bar, unsigned x, unsigned& nloc, unsigned& nx) {
    const unsigned G = gridDim.x * gridDim.y * gridDim.z;
    unsigned sum, cnt, mine, sp = 0u;
    for (;;) {
        sum = 0u; cnt = 0u; mine = 0u;
#pragma unroll
        for (unsigned j = 0; j < 16; ++j) { const unsigned c = xb_ld(&bar[XB_XCNT(j)]); sum += c; cnt += (c > 0u) ? 1u : 0u; mine = (j == x) ? c : mine; }
        if (sum == G) break;
        __builtin_amdgcn_s_sleep(1);
        if ((++sp & 255u) == 0u) { if (xb_ld(&bar[XB_TMO])) break; if (sp > XB_SPIN_CAP) { atomicAdd(&bar[XB_TMO], 1u); break; } }
    }
    nloc = mine > 0u ? mine : 1u; nx = cnt > 0u ? cnt : 1u;
}

__device__ __forceinline__ void xcd_barrier(const XcdBarrier& b) {
    asm volatile("s_waitcnt vmcnt(0)" ::: "memory");
    __syncthreads();
    if (threadIdx.x == 0) {
        unsigned* bar = b.bar;
        __builtin_amdgcn_s_waitcnt(0);
        unsigned nloc = b.st[0], nx = b.st[1];
        if (nloc == 0u) { xcd_barrier_complete(bar, b.x, nloc, nx); b.st[0] = nloc; b.st[1] = nx; }
        const unsigned old = xb_add(&bar[XB_XSUB(b.x)], 1u);
        const unsigned gen = old / nloc;
        if (old + 1u == (gen + 1u) * nloc) {
            __builtin_amdgcn_fence(__ATOMIC_RELEASE, "agent");
            asm volatile("s_waitcnt vmcnt(0)" ::: "memory");
            const unsigned og = xb_add(&bar[XB_TOP], 1u);
            const unsigned tg = og / nx;
            if (og + 1u == (tg + 1u) * nx) xb_add(&bar[XB_TOPGEN], 1u);
            else XB_SPIN(xb_ld(&bar[XB_TOPGEN]) == tg, bar);
            __builtin_amdgcn_fence(__ATOMIC_ACQUIRE, "agent");
            xb_add(&bar[XB_XGEN(b.x)], 1u);
            asm volatile("s_waitcnt vmcnt(0)" ::: "memory");
        } else {
            XB_SPIN(xb_ld(&bar[XB_XGEN(b.x)]) == gen, bar);
            __builtin_amdgcn_fence(__ATOMIC_ACQUIRE, "agent");
            asm volatile("s_waitcnt vmcnt(0)" ::: "memory");
        }
    }
    __syncthreads();
}


namespace att {
using bf16x8 = __attribute__((ext_vector_type(8))) short;
using s16x4  = __attribute__((ext_vector_type(4))) short;
using f32x16 = __attribute__((ext_vector_type(16))) float;
using u32x4  = __attribute__((ext_vector_type(4))) unsigned;
typedef unsigned short bf16_t;
constexpr int NW = 8, QBLK = 32, KVBLK = 64, DV = 64;
constexpr float THR = 8.f;
#define ATT_SBAR() __builtin_amdgcn_sched_barrier(0)
__device__ __forceinline__ int crow(int r, int hi) { return (r & 3) + 8 * (r >> 2) + 4 * hi; }
__device__ __forceinline__ unsigned cvtpk(float lo, float hi) { unsigned r; asm volatile("v_cvt_pk_bf16_f32 %0, %1, %2" : "=v"(r) : "v"(lo), "v"(hi)); return r; }
template <int DK> __device__ __forceinline__ int kswz(int row, int chunk) {
    if (DK == 64) return row * 128 + ((chunk ^ ((row >> 1) & 7)) << 4);
    else          return row * 192 + ((chunk ^ ((row >> 2) & 3)) << 4);
}
__device__ __forceinline__ int v_st(int k, int c) { const int kk = (k & ~0xC) | ((k & 4) << 1) | ((k & 8) >> 1); return ((kk >> 3) * 2 + (c >> 5)) * 512 + ((kk & 7) * 32 + (c & 31)) * 2; }
__device__ __forceinline__ int v_rd_base(int lane) { return ((lane & 3) << 3) | (((lane >> 2) & 3) << 6) | (((lane >> 4) & 1) << 5) | (((lane >> 5) & 1) << 8); }
constexpr int v_rd_off(int d0, int ks, int half) { return d0 * 512 + ks * 2048 + half * 1024; }
template <int OFF> __device__ __forceinline__ s16x4 tr_read(int vb) { s16x4 r; asm volatile("ds_read_b64_tr_b16 %0, %1 offset:%2" : "=&v"(r) : "v"(vb), "i"(OFF) : "memory"); return r; }
template <int D0> __device__ __forceinline__ void pv_one(f32x16& od, int vb, bf16x8 pa0, bf16x8 pa1, bf16x8 pa2, bf16x8 pa3) {
    const s16x4 l0 = tr_read<v_rd_off(D0, 0, 0)>(vb), h0 = tr_read<v_rd_off(D0, 0, 1)>(vb), l1 = tr_read<v_rd_off(D0, 1, 0)>(vb), h1 = tr_read<v_rd_off(D0, 1, 1)>(vb);
    const s16x4 l2 = tr_read<v_rd_off(D0, 2, 0)>(vb), h2 = tr_read<v_rd_off(D0, 2, 1)>(vb), l3 = tr_read<v_rd_off(D0, 3, 0)>(vb), h3 = tr_read<v_rd_off(D0, 3, 1)>(vb);
    asm volatile("s_waitcnt lgkmcnt(0)" ::: "memory"); ATT_SBAR();
#define ATT_PK(L, H) (bf16x8){L[0], L[1], L[2], L[3], H[0], H[1], H[2], H[3]}
    od = __builtin_amdgcn_mfma_f32_32x32x16_bf16(pa0, ATT_PK(l0, h0), od, 0, 0, 0);
    od = __builtin_amdgcn_mfma_f32_32x32x16_bf16(pa1, ATT_PK(l1, h1), od, 0, 0, 0);
    od = __builtin_amdgcn_mfma_f32_32x32x16_bf16(pa2, ATT_PK(l2, h2), od, 0, 0, 0);
    od = __builtin_amdgcn_mfma_f32_32x32x16_bf16(pa3, ATT_PK(l3, h3), od, 0, 0, 0);
#undef ATT_PK
}
__device__ __forceinline__ void pv_d0(f32x16* o, int vb, bf16x8 pa0, bf16x8 pa1, bf16x8 pa2, bf16x8 pa3) { pv_one<0>(o[0], vb, pa0, pa1, pa2, pa3); pv_one<1>(o[1], vb, pa0, pa1, pa2, pa3); }
#define ATT_MX3(a, b, c) __builtin_fmaxf(__builtin_fmaxf((a), (b)), (c))
__device__ __forceinline__ void partialSM(f32x16& p0, f32x16& p1, float& mhat, f32x16& negm, float& alpha, bool first) {
    float a = ATT_MX3(p0[0], p0[1], p1[0]), b = ATT_MX3(p0[2], p0[3], p1[1]); a = ATT_MX3(a, p1[2], p1[3]);
#pragma unroll
    for (int r = 4; r < 16; r += 4) { a = ATT_MX3(a, p0[r], p0[r + 1]); b = ATT_MX3(b, p0[r + 2], p0[r + 3]); a = ATT_MX3(a, p1[r], p1[r + 1]); b = ATT_MX3(b, p1[r + 2], p1[r + 3]); }
    float pmax = fmaxf(a, b);
    { auto rr = __builtin_amdgcn_permlane32_swap(__float_as_uint(pmax), __float_as_uint(pmax), false, false); pmax = fmaxf(__uint_as_float(rr[0]), __uint_as_float(rr[1])); }
    alpha = 1.f;
    if (__builtin_expect(first || __any(pmax > THR), 0)) { const float dl = first ? pmax : fmaxf(pmax, 0.f); mhat += dl;
#pragma unroll
        for (int r = 0; r < 16; ++r) { p0[r] -= dl; p1[r] -= dl; }
#pragma unroll
        for (int r = 0; r < 16; ++r) negm[r] = -mhat;
        alpha = first ? 1.f : __builtin_amdgcn_exp2f(-dl); }
#pragma unroll
    for (int r = 0; r < 16; ++r) p0[r] = __builtin_amdgcn_exp2f(p0[r]);
}
__device__ __forceinline__ void finishSM(f32x16& p0, f32x16& p1, bf16x8& pa0, bf16x8& pa1, bf16x8& pa2, bf16x8& pa3) {
#pragma unroll
    for (int r = 0; r < 16; ++r) p1[r] = __builtin_amdgcn_exp2f(p1[r]);
#define ATT_PK4(P, BASE, OUT) do { unsigned a0 = cvtpk(P[BASE + 0], P[BASE + 1]), a1 = cvtpk(P[BASE + 2], P[BASE + 3]);   \
    unsigned b0 = cvtpk(P[BASE + 4], P[BASE + 5]), b1 = cvtpk(P[BASE + 6], P[BASE + 7]);                              \
    auto r0 = __builtin_amdgcn_permlane32_swap(a0, b0, false, false); auto r1 = __builtin_amdgcn_permlane32_swap(a1, b1, false, false); \
    u32x4 w = {r0[0], r1[0], r0[1], r1[1]}; OUT = *reinterpret_cast<bf16x8*>(&w); } while (0)
    ATT_PK4(p0, 0, pa0); ATT_PK4(p0, 8, pa1); ATT_PK4(p1, 0, pa2); ATT_PK4(p1, 8, pa3);
#undef ATT_PK4
}
__device__ __forceinline__ void lsum(f32x16& lacc, bf16x8 pa0, bf16x8 pa1, bf16x8 pa2, bf16x8 pa3) {
    const bf16x8 ones = {0x3F80, 0x3F80, 0x3F80, 0x3F80, 0x3F80, 0x3F80, 0x3F80, 0x3F80};
    lacc = __builtin_amdgcn_mfma_f32_32x32x16_bf16(pa0, ones, lacc, 0, 0, 0); lacc = __builtin_amdgcn_mfma_f32_32x32x16_bf16(pa1, ones, lacc, 0, 0, 0);
    lacc = __builtin_amdgcn_mfma_f32_32x32x16_bf16(pa2, ones, lacc, 0, 0, 0); lacc = __builtin_amdgcn_mfma_f32_32x32x16_bf16(pa3, ones, lacc, 0, 0, 0);
}
template <int DK> __device__ __forceinline__ void qkt(f32x16& p0, f32x16& p1, const char* Ks, const bf16x8* qr, const f32x16& negm, int r32, int hi) {
#pragma unroll
    for (int d0 = 0; d0 < DK / 16; ++d0) {
        const bf16x8 b0 = *reinterpret_cast<const bf16x8*>(Ks + kswz<DK>(r32, 2 * d0 + hi));
        const bf16x8 b1 = *reinterpret_cast<const bf16x8*>(Ks + kswz<DK>(32 + r32, 2 * d0 + hi));
        if (d0 == 0) { p0 = __builtin_amdgcn_mfma_f32_32x32x16_bf16(b0, qr[0], negm, 0, 0, 0); p1 = __builtin_amdgcn_mfma_f32_32x32x16_bf16(b1, qr[0], negm, 0, 0, 0); }
        else { p0 = __builtin_amdgcn_mfma_f32_32x32x16_bf16(b0, qr[d0], p0, 0, 0, 0); p1 = __builtin_amdgcn_mfma_f32_32x32x16_bf16(b1, qr[d0], p1, 0, 0, 0); } }
}
template <int DK> struct Lds { static constexpr int SHM_V = KVBLK * DV * 2, SHM_K = KVBLK * DK * 2, BYTES = 2 * SHM_V + 2 * SHM_K + NW * 64 * 4; };

template <int DK, int LDQ, int LDK, int LDV, int LDO>
__device__ __forceinline__ void attn_unit(const bf16_t* __restrict__ Qb, const bf16_t* __restrict__ Kh, const bf16_t* __restrict__ Vh, bf16_t* __restrict__ Ob, int nkeys, char* lds, int tid_in) {
    constexpr int SHM_V = Lds<DK>::SHM_V, SHM_K = Lds<DK>::SHM_K, NQD = DK / 16, KCH = DK / 8;
    int tid_ = tid_in; asm volatile("" : "+v"(tid_));
    const int tid = tid_, wid = tid >> 6, lane = tid & 63, r32 = lane & 31, hi = lane >> 5;
    char* V_lds = lds; char* K_lds = lds + 2 * SHM_V;
    float* al_l = (float*)(lds + 2 * SHM_V + 2 * SHM_K) + wid * 64;
    __syncthreads();
    float mhat = 0.f; f32x16 o[2] = {}; f32x16 lacc = {}; f32x16 negm = {}; bf16x8 qr[NQD];
    typedef const __attribute__((address_space(1))) bf16x8* gptr8;
    const bf16_t* Qw = Qb + (long)(wid * QBLK + r32) * LDQ + hi * 8;
#pragma unroll
    for (int d0 = 0; d0 < NQD; ++d0) qr[d0] = *(gptr8)(Qw + d0 * 16);
    const int vr = tid >> 3, vc = (tid & 7) * 8, vst = v_st(vr, vc);
    const int kp0 = tid, kr0 = kp0 / KCH, kc0 = kp0 % KCH, kst0 = kswz<DK>(kr0, kc0);
    const bool k2 = (DK == 96) && (tid < 256);
    const int kp1 = k2 ? tid + 512 : tid, kr1 = kp1 / KCH, kc1 = kp1 % KCH, kst1 = kswz<DK>(kr1, kc1);
    const int vb0 = (int)(uintptr_t)V_lds + v_rd_base(lane);
    struct { bf16x8 vs, ks0, ks1; } sr_[2];
#define ATT_SLOAD(i, k0) do { sr_[i].vs = *(gptr8)(&Vh[(long)((k0) + vr) * LDV + vc]); \
    sr_[i].ks0 = *(gptr8)(&Kh[(long)((k0) + kr0) * LDK + kc0 * 8]); \
    if (DK == 96) sr_[i].ks1 = *(gptr8)(&Kh[(long)((k0) + kr1) * LDK + kc1 * 8]); } while (0)
#define ATT_SWRITE(b, i) do { *(bf16x8*)(V_lds + (b) * SHM_V + vst) = sr_[i].vs; *(bf16x8*)(K_lds + (b) * SHM_K + kst0) = sr_[i].ks0; \
    if (DK == 96) { if (k2) *(bf16x8*)(K_lds + (b) * SHM_K + kst1) = sr_[i].ks1; } } while (0)
#define ATT_SWAIT() do { if (DK == 96) asm volatile("s_waitcnt vmcnt(3)" ::: "memory"); else asm volatile("s_waitcnt vmcnt(2)" ::: "memory"); } while (0)
#define ATT_RESC(a) do { if (__any((a) < 1.f)) { if (hi == 0) al_l[r32] = (a); asm volatile("s_waitcnt lgkmcnt(0)" ::: "memory"); \
    _Pragma("unroll") for (int r = 0; r < 16; ++r) { const float f_ = al_l[crow(r, hi)]; o[0][r] *= f_; o[1][r] *= f_; lacc[r] *= f_; } } } while (0)
    f32x16 pA0, pA1, pB0, pB1; float alA, alB; bf16x8 pa0, pa1, pa2, pa3; const int NT = nkeys / KVBLK;
    constexpr int SE = 0, SO = 1;
    ATT_SLOAD(SE, 0); asm volatile("s_waitcnt vmcnt(0)" ::: "memory"); ATT_SWRITE(0, SE); __syncthreads();
    qkt<DK>(pA0, pA1, K_lds, qr, negm, r32, hi); partialSM(pA0, pA1, mhat, negm, alA, true);
    ATT_SLOAD(SO, KVBLK); if (2 < NT) ATT_SLOAD(SE, 2 * KVBLK);
    if (2 < NT) ATT_SWAIT(); else asm volatile("s_waitcnt vmcnt(0)" ::: "memory");
    ATT_SWRITE(1, SO); __syncthreads();
    for (int j = 1; j + 1 < NT; j += 2) {
        ATT_SBAR(); qkt<DK>(pB0, pB1, K_lds + SHM_K, qr, negm, r32, hi);
        finishSM(pA0, pA1, pa0, pa1, pa2, pa3); ATT_SBAR();
        ATT_SLOAD(SO, (j + 2) * KVBLK); ATT_SBAR();
        pv_d0(o, vb0, pa0, pa1, pa2, pa3); lsum(lacc, pa0, pa1, pa2, pa3); partialSM(pB0, pB1, mhat, negm, alB, false);
        __syncthreads(); ATT_SWAIT(); ATT_SWRITE(0, SE);
        ATT_RESC(alB); __syncthreads();
        ATT_SBAR(); qkt<DK>(pA0, pA1, K_lds, qr, negm, r32, hi);
        finishSM(pB0, pB1, pa0, pa1, pa2, pa3); ATT_SBAR();
        if (j + 3 < NT) ATT_SLOAD(SE, (j + 3) * KVBLK); ATT_SBAR();
        pv_d0(o, vb0 + SHM_V, pa0, pa1, pa2, pa3); lsum(lacc, pa0, pa1, pa2, pa3); partialSM(pA0, pA1, mhat, negm, alA, false);
        __syncthreads(); if (j + 3 < NT) ATT_SWAIT(); else asm volatile("s_waitcnt vmcnt(0)" ::: "memory");
        ATT_SWRITE(1, SO);
        ATT_RESC(alA); __syncthreads();
    }
    ATT_SBAR(); qkt<DK>(pB0, pB1, K_lds + SHM_K, qr, negm, r32, hi);
    finishSM(pA0, pA1, pa0, pa1, pa2, pa3); ATT_SBAR();
    pv_d0(o, vb0, pa0, pa1, pa2, pa3); lsum(lacc, pa0, pa1, pa2, pa3); partialSM(pB0, pB1, mhat, negm, alB, false);
    __syncthreads(); ATT_RESC(alB);
    finishSM(pB0, pB1, pa0, pa1, pa2, pa3); ATT_SBAR();
    pv_d0(o, vb0 + SHM_V, pa0, pa1, pa2, pa3); lsum(lacc, pa0, pa1, pa2, pa3);
    __attribute__((address_space(1))) bf16_t* Ow = (__attribute__((address_space(1))) bf16_t*)(Ob + (long)(wid * QBLK) * LDO);
#pragma unroll
    for (int r = 0; r < 16; ++r) { const int orow = crow(r, hi); const float rl = __builtin_amdgcn_rcpf(lacc[r]);
#pragma unroll
        for (int d0 = 0; d0 < 2; ++d0) { const unsigned w = cvtpk(o[d0][r] * rl, 0.f); Ow[(long)orow * LDO + d0 * 32 + r32] = (bf16_t)(w & 0xffffu); } }
#undef ATT_SLOAD
#undef ATT_SWRITE
#undef ATT_SWAIT
#undef ATT_RESC
}

typedef __attribute__((address_space(3))) const char* lcp;
typedef short v4i16_t __attribute__((ext_vector_type(4)));
__device__ __forceinline__ unsigned cvtpk_b(float lo, float hi) { typedef float f2 __attribute__((ext_vector_type(2))); typedef __bf16 b2 __attribute__((ext_vector_type(2)));
    f2 v = {lo, hi}; b2 b = __builtin_convertvector(v, b2); return __builtin_bit_cast(unsigned, b); }
__device__ __forceinline__ int v3_st(int k, int c) { return (c >> 5) * 4096 + k * 64 + (c & 31) * 2; }
__device__ __forceinline__ int v3_rd_base(int lane) { return (4 * (lane >> 5) + ((lane & 15) >> 2)) * 64 + ((lane >> 4) & 1) * 32 + (lane & 3) * 8; }
constexpr int v3_rd_off(int d0, int ks) { return d0 * 4096 + ks * 1024; }
__device__ __forceinline__ bf16x8 vfrag3(lcp p) {
    const s16x4 l = __builtin_bit_cast(s16x4, __builtin_amdgcn_ds_read_tr16_b64_v4i16((__attribute__((address_space(3))) v4i16_t*)p));
    const s16x4 h = __builtin_bit_cast(s16x4, __builtin_amdgcn_ds_read_tr16_b64_v4i16((__attribute__((address_space(3))) v4i16_t*)(p + 512)));
    return (bf16x8){l[0], l[1], l[2], l[3], h[0], h[1], h[2], h[3]}; }
__device__ __forceinline__ bf16x8 vfrag(lcp p) {
    const s16x4 l = __builtin_bit_cast(s16x4, __builtin_amdgcn_ds_read_tr16_b64_v4i16((__attribute__((address_space(3))) v4i16_t*)p));
    const s16x4 h = __builtin_bit_cast(s16x4, __builtin_amdgcn_ds_read_tr16_b64_v4i16((__attribute__((address_space(3))) v4i16_t*)(p + 1024)));
    return (bf16x8){l[0], l[1], l[2], l[3], h[0], h[1], h[2], h[3]}; }
template <int DK> struct Lds3 { static constexpr int NSL = 6, SHM_V = KVBLK * DV * 2, SHM_K = KVBLK * DK * 2, OFF_K = NSL * SHM_V, OFF_AL = OFF_K + NSL * SHM_K, BYTES = OFF_AL + NW * 64 * 4; };
template <int DK, int LDQ, int LDK, int LDV, int LDO>
__device__ __forceinline__ void attn_unit3(const bf16_t* __restrict__ Qb, const bf16_t* __restrict__ Kh, const bf16_t* __restrict__ Vh, bf16_t* __restrict__ Ob, int nkeys, __attribute__((address_space(3))) char* lds, int tid_in) {
    constexpr int SHM_V = Lds3<DK>::SHM_V, SHM_K = Lds3<DK>::SHM_K, NQD = DK / 16, KCH = DK / 8;
    int tid_ = tid_in; asm volatile("" : "+v"(tid_));
    const int tid = tid_, wid = tid >> 6, lane = tid & 63, r32 = lane & 31, hi = lane >> 5;
    typedef __attribute__((address_space(3))) char* lp; typedef __attribute__((address_space(3))) bf16x8* lp8;
    const lp V_lds = lds; const lp K_lds = lds + Lds3<DK>::OFF_K;
    __attribute__((address_space(3))) float* al_l = (__attribute__((address_space(3))) float*)(lds + Lds3<DK>::OFF_AL) + wid * 64;
    typedef const __attribute__((address_space(1))) bf16x8* gptr8;
    float mhat = 0.f; f32x16 o0 = {}, o1 = {}, lacc = {}, negm = {}; bf16x8 qr[NQD];
    const bf16_t* Qw = Qb + (long)(wid * QBLK + r32) * LDQ + hi * 8;
#pragma unroll
    for (int d0 = 0; d0 < NQD; ++d0) qr[d0] = *(gptr8)(Qw + d0 * 16);
    const int vr = tid >> 3, vc = (tid & 7) * 8, vst = v3_st(vr, vc);
    const int kp0 = tid, kr0 = kp0 / KCH, kc0 = kp0 % KCH, kst0 = kswz<DK>(kr0, kc0);
    const bool k2 = (DK == 96) && (tid < 256);
    const int kp1 = k2 ? tid + 512 : tid, kr1 = kp1 / KCH, kc1 = kp1 % KCH, kst1 = kswz<DK>(kr1, kc1);
    const int vrd = v3_rd_base(lane);
    const int kq0 = kswz<DK>(r32, hi), kq1 = kswz<DK>(32 + r32, hi);
    bf16x8 sv[2], sk0[2], sk1[2];
#define A3_SLOAD(i, k0) do { sv[i] = *(gptr8)(&Vh[(long)((k0) + vr) * LDV + vc]); sk0[i] = *(gptr8)(&Kh[(long)((k0) + kr0) * LDK + kc0 * 8]); \
    if (DK == 96) sk1[i] = *(gptr8)(&Kh[(long)((k0) + kr1) * LDK + kc1 * 8]); } while (0)
#define A3_SWRITE(i, so) do { *(lp8)(V_lds + (so) * SHM_V + vst) = sv[i]; *(lp8)(K_lds + (so) * SHM_K + kst0) = sk0[i]; if (DK == 96) { if (k2) *(lp8)(K_lds + (so) * SHM_K + kst1) = sk1[i]; } } while (0)
#define A3_QKT(P0, P1, so) do { const lp kb_ = K_lds + (so) * SHM_K; \
    _Pragma("unroll") for (int d0 = 0; d0 < NQD; ++d0) { const bf16x8 b0_ = *(lp8)(kb_ + kswz<DK>(r32, 2 * d0 + hi)), b1_ = *(lp8)(kb_ + kswz<DK>(32 + r32, 2 * d0 + hi)); \
        if (d0 == 0) { P0 = __builtin_amdgcn_mfma_f32_32x32x16_bf16(b0_, qr[0], negm, 0, 0, 0); P1 = __builtin_amdgcn_mfma_f32_32x32x16_bf16(b1_, qr[0], negm, 0, 0, 0); } \
        else { P0 = __builtin_amdgcn_mfma_f32_32x32x16_bf16(b0_, qr[d0], P0, 0, 0, 0); P1 = __builtin_amdgcn_mfma_f32_32x32x16_bf16(b1_, qr[d0], P1, 0, 0, 0); } } } while (0)
#define A3_PK4(P, BASE, OUT) do { const u32x4 w_ = {cvtpk_b(P[BASE + 0], P[BASE + 1]), cvtpk_b(P[BASE + 2], P[BASE + 3]), cvtpk_b(P[BASE + 4], P[BASE + 5]), cvtpk_b(P[BASE + 6], P[BASE + 7])}; OUT = __builtin_bit_cast(bf16x8, w_); } while (0)
#define A3_ROWMAX(P0, P1, OUT) do { float a_ = ATT_MX3(P0[0], P0[1], P1[0]), b_ = ATT_MX3(P0[2], P0[3], P1[1]); a_ = ATT_MX3(a_, P1[2], P1[3]); \
    _Pragma("unroll") for (int r = 4; r < 16; r += 4) { a_ = ATT_MX3(a_, P0[r], P0[r + 1]); b_ = ATT_MX3(b_, P0[r + 2], P0[r + 3]); a_ = ATT_MX3(a_, P1[r], P1[r + 1]); b_ = ATT_MX3(b_, P1[r + 2], P1[r + 3]); } \
    float m_ = fmaxf(a_, b_); const auto rr_ = __builtin_amdgcn_permlane32_swap(__float_as_uint(m_), __float_as_uint(m_), false, false); OUT = fmaxf(__uint_as_float(rr_[0]), __uint_as_float(rr_[1])); } while (0)
#define A3_DECIDE(P0, P1, PMAX, FIRST, ALPHA) do { ALPHA = 1.f; if (__builtin_expect((FIRST) || __any(PMAX > THR), 0)) { const float dl_ = (FIRST) ? PMAX : fmaxf(PMAX, 0.f); mhat += dl_; const float nm_ = -mhat; \
    _Pragma("unroll") for (int r = 0; r < 16; ++r) { asm volatile("v_sub_f32_e32 %0, %0, %1" : "+v"(P0[r]) : "v"(dl_)); asm volatile("v_sub_f32_e32 %0, %0, %1" : "+v"(P1[r]) : "v"(dl_)); } \
    _Pragma("unroll") for (int r = 0; r < 16; ++r) asm volatile("v_mov_b32_e32 %0, %1" : "+v"(negm[r]) : "v"(nm_)); \
    ALPHA = (FIRST) ? 1.f : __builtin_amdgcn_exp2f(-dl_); } } while (0)
#define A3_EXP(P) do { _Pragma("unroll") for (int r = 0; r < 16; ++r) P[r] = __builtin_amdgcn_exp2f(P[r]); } while (0)
#define A3_RESC(a) do { if (__any((a) < 1.f)) { if (hi == 0) al_l[r32] = (a); \
    _Pragma("unroll") for (int r = 0; r < 16; ++r) { const float f_ = al_l[crow(r, hi)]; o0[r] *= f_; o1[r] *= f_; lacc[r] *= f_; } } } while (0)
    bf16x8 ones = {0x3F80, 0x3F80, 0x3F80, 0x3F80, 0x3F80, 0x3F80, 0x3F80, 0x3F80}; asm volatile("" : "+v"(ones));
#define A3_SB() __builtin_amdgcn_sched_barrier(0)
#define A3_KPF(d0, so) do { if (PREF && (d0) < NQD) { const lp kb_ = K_lds + (so) * SHM_K; kf_[2 * (d0)] = *(lp8)(kb_ + kswz<DK>(r32, 2 * (d0) + hi)); kf_[2 * (d0) + 1] = *(lp8)(kb_ + kswz<DK>(32 + r32, 2 * (d0) + hi)); } } while (0)
#define slot6(t) ((r0_ + ((t) - (s))) >= 6 ? (r0_ + ((t) - (s))) - 6 : (r0_ + ((t) - (s))))
#define A3_EX4(P, B) do { P[B] = __builtin_amdgcn_exp2f(P[B]); P[B + 1] = __builtin_amdgcn_exp2f(P[B + 1]); P[B + 2] = __builtin_amdgcn_exp2f(P[B + 2]); P[B + 3] = __builtin_amdgcn_exp2f(P[B + 3]); asm volatile("" : "+v"(P)); } while (0)
#define A3_MX4(P0, P1, B) do { mxa_ = ATT_MX3(mxa_, P0[B], P0[B + 1]); mxb_ = ATT_MX3(mxb_, P0[B + 2], P0[B + 3]); mxa_ = ATT_MX3(mxa_, P1[B], P1[B + 1]); mxb_ = ATT_MX3(mxb_, P1[B + 2], P1[B + 3]); } while (0)
#define A3_GAP1(g, P0, P1) do { \
    if (NQD == 4) { if ((g) == 0) A3_PK4(P0, 0, pa0); else if ((g) == 1) A3_PK4(P0, 8, pa1); else if ((g) == 2) A3_EX4(P1, 0); else if ((g) == 3) A3_EX4(P1, 4); else if ((g) == 4) A3_EX4(P1, 8); else if ((g) == 5) A3_EX4(P1, 12); \
                    else if ((g) == 6) A3_PK4(P1, 0, pa2); else A3_PK4(P1, 8, pa3); } \
    else { if ((g) == 0) A3_PK4(P0, 0, pa0); else if ((g) == 2) A3_PK4(P0, 8, pa1); else if ((g) == 3) A3_EX4(P1, 0); else if ((g) == 4) A3_EX4(P1, 4); else if ((g) == 5) A3_EX4(P1, 8); else if ((g) == 6) A3_EX4(P1, 12); \
           else if ((g) == 8) A3_PK4(P1, 0, pa2); else if ((g) == 10) A3_PK4(P1, 8, pa3); } } while (0)
#define A3_STEP(EVEN, s, P0, P1, N0, N1, sv_, sk_, skn_) do { float pmax_, alpha_; bf16x8 pa0, pa1, pa2, pa3; bf16x8 vf_[4]; \
    if (EVEN) { __syncthreads();        \
        if ((s) + 4 < NT) { A3_SWRITE(0, slot6((s) + 4)); A3_SWRITE(1, slot6((s) + 5)); } \
        if ((s) + 6 < NT) { A3_SLOAD(0, ((s) + 6) * KVBLK); A3_SLOAD(1, ((s) + 7) * KVBLK); } } \
    if (!PREF) { const lp kb_ = K_lds + (sk_) * SHM_K; \
      _Pragma("unroll") for (int d0 = 0; d0 < NQD; ++d0) { kf_[2 * d0] = *(lp8)(kb_ + kswz<DK>(r32, 2 * d0 + hi)); kf_[2 * d0 + 1] = *(lp8)(kb_ + kswz<DK>(32 + r32, 2 * d0 + hi)); } } \
    A3_SB(); \
    const lcp vp_ = (lcp)(V_lds + (sv_) * SHM_V + vrd); \
      \
    _Pragma("unroll") for (int d0 = 0; d0 < NQD; ++d0) { \
        if (d0 == 0) N0 = __builtin_amdgcn_mfma_f32_32x32x16_bf16(kf_[0], qr[0], negm, 0, 0, 0); else N0 = __builtin_amdgcn_mfma_f32_32x32x16_bf16(kf_[2 * d0], qr[d0], N0, 0, 0, 0); \
        A3_GAP1(2 * d0, P0, P1); A3_SB(); \
        if (d0 == 0) N1 = __builtin_amdgcn_mfma_f32_32x32x16_bf16(kf_[1], qr[0], negm, 0, 0, 0); else N1 = __builtin_amdgcn_mfma_f32_32x32x16_bf16(kf_[2 * d0 + 1], qr[d0], N1, 0, 0, 0); \
        if (d0 == NQD - 1) { vf_[0] = vfrag3(vp_ + v3_rd_off(0, 0)); vf_[1] = vfrag3(vp_ + v3_rd_off(0, 1)); vf_[2] = vfrag3(vp_ + v3_rd_off(0, 2)); vf_[3] = vfrag3(vp_ + v3_rd_off(0, 3)); } \
        A3_GAP1(2 * d0 + 1, P0, P1); A3_SB(); } \
      \
    { float mxa_ = ATT_MX3(N0[0], N0[1], N1[0]), mxb_ = ATT_MX3(N0[2], N0[3], N1[1]); \
      o0 = __builtin_amdgcn_mfma_f32_32x32x16_bf16(pa0, vf_[0], o0, 0, 0, 0); mxa_ = ATT_MX3(mxa_, N1[2], N1[3]); A3_MX4(N0, N1, 4); A3_SB(); \
      o0 = __builtin_amdgcn_mfma_f32_32x32x16_bf16(pa1, vf_[1], o0, 0, 0, 0); A3_MX4(N0, N1, 8); A3_SB(); \
      o0 = __builtin_amdgcn_mfma_f32_32x32x16_bf16(pa2, vf_[2], o0, 0, 0, 0); A3_MX4(N0, N1, 12); A3_SB(); \
      o0 = __builtin_amdgcn_mfma_f32_32x32x16_bf16(pa3, vf_[3], o0, 0, 0, 0); \
      vf_[0] = vfrag3(vp_ + v3_rd_off(1, 0)); vf_[1] = vfrag3(vp_ + v3_rd_off(1, 1)); vf_[2] = vfrag3(vp_ + v3_rd_off(1, 2)); vf_[3] = vfrag3(vp_ + v3_rd_off(1, 3)); \
      { float m_ = fmaxf(mxa_, mxb_); const auto rr_ = __builtin_amdgcn_permlane32_swap(__float_as_uint(m_), __float_as_uint(m_), false, false); pmax_ = fmaxf(__uint_as_float(rr_[0]), __uint_as_float(rr_[1])); } \
      A3_SB(); } \
    A3_DECIDE(N0, N1, pmax_, false, alpha_); \
    A3_SB(); \
      \
    lacc = __builtin_amdgcn_mfma_f32_32x32x16_bf16(pa0, ones, lacc, 0, 0, 0); A3_KPF(0, skn_); N0[0] = __builtin_amdgcn_exp2f(N0[0]); N0[1] = __builtin_amdgcn_exp2f(N0[1]); asm volatile("" : "+v"(N0)); A3_SB(); \
    lacc = __builtin_amdgcn_mfma_f32_32x32x16_bf16(pa1, ones, lacc, 0, 0, 0); A3_KPF(1, skn_); N0[2] = __builtin_amdgcn_exp2f(N0[2]); N0[3] = __builtin_amdgcn_exp2f(N0[3]); asm volatile("" : "+v"(N0)); A3_SB(); \
    lacc = __builtin_amdgcn_mfma_f32_32x32x16_bf16(pa2, ones, lacc, 0, 0, 0); A3_KPF(2, skn_); N0[4] = __builtin_amdgcn_exp2f(N0[4]); N0[5] = __builtin_amdgcn_exp2f(N0[5]); asm volatile("" : "+v"(N0)); A3_SB(); \
    lacc = __builtin_amdgcn_mfma_f32_32x32x16_bf16(pa3, ones, lacc, 0, 0, 0); A3_KPF(3, skn_); N0[6] = __builtin_amdgcn_exp2f(N0[6]); N0[7] = __builtin_amdgcn_exp2f(N0[7]); asm volatile("" : "+v"(N0)); A3_SB(); \
    o1 = __builtin_amdgcn_mfma_f32_32x32x16_bf16(pa0, vf_[0], o1, 0, 0, 0); N0[8] = __builtin_amdgcn_exp2f(N0[8]); N0[9] = __builtin_amdgcn_exp2f(N0[9]); asm volatile("" : "+v"(N0)); A3_SB(); \
    o1 = __builtin_amdgcn_mfma_f32_32x32x16_bf16(pa1, vf_[1], o1, 0, 0, 0); N0[10] = __builtin_amdgcn_exp2f(N0[10]); N0[11] = __builtin_amdgcn_exp2f(N0[11]); asm volatile("" : "+v"(N0)); A3_SB(); \
    o1 = __builtin_amdgcn_mfma_f32_32x32x16_bf16(pa2, vf_[2], o1, 0, 0, 0); N0[12] = __builtin_amdgcn_exp2f(N0[12]); N0[13] = __builtin_amdgcn_exp2f(N0[13]); asm volatile("" : "+v"(N0)); A3_SB(); \
    o1 = __builtin_amdgcn_mfma_f32_32x32x16_bf16(pa3, vf_[3], o1, 0, 0, 0); N0[14] = __builtin_amdgcn_exp2f(N0[14]); N0[15] = __builtin_amdgcn_exp2f(N0[15]); asm volatile("" : "+v"(N0)); A3_SB(); \
    if ((s) + 1 < NT) A3_RESC(alpha_); } while (0)
    const int NT = nkeys / KVBLK;
    constexpr bool PREF = true;
    bf16x8 kf_[2 * NQD];
    f32x16 pA0, pA1, pB0, pB1;
    __syncthreads();
    A3_SLOAD(0, 0); A3_SLOAD(1, KVBLK); A3_SWRITE(0, 0); A3_SWRITE(1, 1); A3_SLOAD(0, 2 * KVBLK); A3_SLOAD(1, 3 * KVBLK); A3_SWRITE(0, 2); A3_SWRITE(1, 3);
    if (4 < NT) { A3_SLOAD(0, 4 * KVBLK); A3_SLOAD(1, 5 * KVBLK); }
    __syncthreads();
    { float pmax_, alpha_; A3_QKT(pA0, pA1, 0); A3_ROWMAX(pA0, pA1, pmax_); A3_DECIDE(pA0, pA1, pmax_, true, alpha_); A3_EXP(pA0); (void)alpha_; }
    if (PREF) {
#pragma unroll
        for (int d0 = 0; d0 < NQD; ++d0) A3_KPF(d0, 1); }
    int r0_ = 0;
    for (int s = 0; s < NT; s += 2) {
        A3_STEP(true, s, pA0, pA1, pB0, pB1, r0_, r0_ + 1, (r0_ == 4 ? 0 : r0_ + 2));
        A3_STEP(false, s + 1, pB0, pB1, pA0, pA1, r0_ + 1, (r0_ == 4 ? 0 : r0_ + 2), (r0_ >= 3 ? r0_ - 3 : r0_ + 3));
        r0_ = (r0_ == 4) ? 0 : r0_ + 2;
    }
    __attribute__((address_space(1))) bf16_t* Ow = (__attribute__((address_space(1))) bf16_t*)(Ob + (long)(wid * QBLK) * LDO);
#pragma unroll
    for (int r = 0; r < 16; ++r) { const int orow = crow(r, hi); const float rl = __builtin_amdgcn_rcpf(lacc[r]);
        Ow[(long)orow * LDO + r32] = (bf16_t)(cvtpk_b(o0[r] * rl, 0.f) & 0xffffu); Ow[(long)orow * LDO + 32 + r32] = (bf16_t)(cvtpk_b(o1[r] * rl, 0.f) & 0xffffu); }
#undef A3_SLOAD
#undef A3_SWRITE
#undef A3_QKT
#undef A3_PK4
#undef A3_ROWMAX
#undef A3_DECIDE
#undef A3_EXP
#undef A3_RESC
#undef A3_STEP
#undef A3_SB
#undef A3_KPF
#undef slot6
#undef A3_EX4
#undef A3_MX4
#undef A3_GAP1
}
__device__ __forceinline__ unsigned pk4f8(float a, float b, float c, float d) { int w = 0; w = __builtin_amdgcn_cvt_pk_fp8_f32(a, b, w, false); w = __builtin_amdgcn_cvt_pk_fp8_f32(c, d, w, true); return (unsigned)w; }
template <int DK> struct Lds4 { static constexpr int NSL = 6, SHM_V = KVBLK * DV  , SHM_K = KVBLK * DK * 2, OFF_K = NSL * SHM_V, OFF_AL = OFF_K + NSL * SHM_K, BYTES = OFF_AL + NW * 64 * 4; };
template <int DK, int LDQ, int LDK, int LDO, bool QK8>
__device__ __forceinline__ void attn_unit4(const bf16_t* __restrict__ Qb, const bf16_t* __restrict__ Kh, const unsigned char* __restrict__ VT, bf16_t* __restrict__ Ob, int nkeys, __attribute__((address_space(3))) char* lds, int tid_in) {
    static_assert(QK8, "the tile step is written for e4m3 Q/K");
    constexpr int KRB = (DK == 64) ? 64 : 128, KPC = KRB / 16;
    constexpr int SHM_V = Lds4<DK>::SHM_V, SHM_K = Lds4<DK>::SHM_K, NQD = DK / 16, KCH = DK / 8;
    int tid_ = tid_in; asm volatile("" : "+v"(tid_));
    const int tid = tid_, wid = tid >> 6, lane = tid & 63, r32 = lane & 31, hi = lane >> 5;
    typedef __attribute__((address_space(3))) char* lp; typedef __attribute__((address_space(3))) bf16x8* lp8;
    const lp V_lds = lds; const lp K_lds = lds + Lds4<DK>::OFF_K;
    typedef const __attribute__((address_space(1))) bf16x8* gptr8;
    float mhat = 0.f; f32x16 o0 = {}, o1 = {}, negm = {}; typedef float f4v_ __attribute__((ext_vector_type(4))); f4v_ lacc = {}; bf16x8 qr[NQD];
    typedef int i8v __attribute__((ext_vector_type(8))); typedef int i4v __attribute__((ext_vector_type(4)));
    constexpr bool LSUMV = (DK == 96) && !QK8;
    float lsum_ = 0.f;
    i8v q8 = {};
    i8v q8b = {};
    if (QK8) { const unsigned char* Q8 = (const unsigned char*)Qb + (long)(wid * QBLK + r32) * LDQ + hi * 32; const i4v a_ = *(const __attribute__((address_space(1))) i4v*)Q8, b_ = *(const __attribute__((address_space(1))) i4v*)(Q8 + 16);
        q8 = __builtin_shufflevector(a_, b_, 0, 1, 2, 3, 4, 5, 6, 7);
        if (DK == 96) { const i4v c_ = *(const __attribute__((address_space(1))) i4v*)(Q8 + 64), d_ = *(const __attribute__((address_space(1))) i4v*)(Q8 + 80); q8b = __builtin_shufflevector(c_, d_, 0, 1, 2, 3, 4, 5, 6, 7); } }
    else { const bf16_t* Qw = Qb + (long)(wid * QBLK + r32) * LDQ + hi * 8;
#pragma unroll
        for (int d0 = 0; d0 < NQD; ++d0) qr[d0] = *(gptr8)(Qw + d0 * 16); }
    const int vpc = (tid & 255) * 16;
    const int kp0 = QK8 ? (DK == 64 ? (tid & 255) : tid) : tid, kr0 = QK8 ? kp0 / KPC : kp0 / KCH, kc0 = QK8 ? kp0 % KPC : kp0 % KCH;
    const int kst0 = QK8 ? kr0 * KRB + ((kc0 ^ (DK == 64 ? ((kr0 >> 2) & 3) : ((kr0 >> 1) & 7))) << 4) : kswz<DK>(kr0, kc0);
    const bool k2 = (DK == 96) && !QK8 && (tid < 256);
    const unsigned vpcu_ = (unsigned)vpc, koff_ = (unsigned)(kr0 * LDK + kc0 * 16);
    const __amdgpu_buffer_rsrc_t rsV_ = __builtin_amdgcn_make_buffer_rsrc((void*)VT, 0, 0x7fffffff, 0x27000), rsK_ = __builtin_amdgcn_make_buffer_rsrc((void*)Kh, 0, 0x7fffffff, 0x27000);
    const int kp1 = k2 ? tid + 512 : tid, kr1 = kp1 / KCH, kc1 = kp1 % KCH, kst1 = kswz<DK>(kr1, kc1);
    const int vrow = lane & 31, vsw = (vrow >> 2) & 3;
    const int vrd = vrow * 64 + (((2 * hi) ^ vsw) << 4), vrd2 = vrow * 64 + (((2 * hi + 1) ^ vsw) << 4);
    const int ksz_ = (DK == 64) ? ((r32 >> 2) & 3) : ((r32 >> 1) & 7);
    const int kq0 = r32 * KRB + (((2 * hi) ^ ksz_) << 4), kq1 = r32 * KRB + (((2 * hi + 1) ^ ksz_) << 4);
    const int kq2 = r32 * KRB + (((4 + 2 * hi) ^ ksz_) << 4), kq3 = r32 * KRB + (((5 + 2 * hi) ^ ksz_) << 4);
    i8v kq_[4];
    bf16x8 sv[2], sk0[2], sk1[2];
#define A3_SLOAD(i, k0) do {   \
    sv[i] = __builtin_bit_cast(bf16x8, __builtin_amdgcn_raw_buffer_load_b128(rsV_, vpcu_, (int)(((k0) / KVBLK) * 4096), 0)); \
    if (QK8) sk0[i] = __builtin_bit_cast(bf16x8, __builtin_amdgcn_raw_buffer_load_b128(rsK_, koff_, (int)((k0) * LDK), 0)); else sk0[i] = *(gptr8)(&Kh[(long)((k0) + kr0) * LDK + kc0 * 8]); \
    if (DK == 96 && !QK8) sk1[i] = *(gptr8)(&Kh[(long)((k0) + kr1) * LDK + kc1 * 8]); } while (0)
#define A3_SWRITE(i, so) do { if (tid < 256) *(lp8)(V_lds + (so) * SHM_V + vpc) = sv[i]; if (!QK8 || DK == 96 || tid < 256) *(lp8)(K_lds + (so) * SHM_K + kst0) = sk0[i]; if (DK == 96 && !QK8) { if (k2) *(lp8)(K_lds + (so) * SHM_K + kst1) = sk1[i]; } } while (0)
#define A3_MXQ(OUT, A8) asm volatile("s_nop 0\n\tv_mfma_scale_f32_32x32x64_f8f6f4 %0, %1, %2, %3, %4, %4 op_sel_hi:[0,0,0]" : "=&v"(OUT) : "v"(A8), "v"(q8), "v"(negm), "v"(mxs_))
#define A3_KLD8(so) do { const lp kb_ = K_lds + (so) * SHM_K; const i4v a_ = *(__attribute__((address_space(3))) i4v*)(kb_ + kq0), b_ = *(__attribute__((address_space(3))) i4v*)(kb_ + kq1), c_ = *(__attribute__((address_space(3))) i4v*)(kb_ + 32 * KRB + kq0), d_ = *(__attribute__((address_space(3))) i4v*)(kb_ + 32 * KRB + kq1); \
    kq_[0] = __builtin_shufflevector(a_, b_, 0, 1, 2, 3, 4, 5, 6, 7); kq_[1] = __builtin_shufflevector(c_, d_, 0, 1, 2, 3, 4, 5, 6, 7); \
    if (DK == 96) { const i4v e_ = *(__attribute__((address_space(3))) i4v*)(kb_ + kq2), f_ = *(__attribute__((address_space(3))) i4v*)(kb_ + kq3), g_ = *(__attribute__((address_space(3))) i4v*)(kb_ + 32 * KRB + kq2), h_ = *(__attribute__((address_space(3))) i4v*)(kb_ + 32 * KRB + kq3); \
        kq_[2] = __builtin_shufflevector(e_, f_, 0, 1, 2, 3, 4, 5, 6, 7); kq_[3] = __builtin_shufflevector(g_, h_, 0, 1, 2, 3, 4, 5, 6, 7); } } while (0)
#define A3_MXQ2(ACC, A8) asm volatile("s_nop 0\n\tv_mfma_scale_f32_32x32x64_f8f6f4 %0, %1, %2, %0, %3, %3 op_sel_hi:[0,0,0]" : "+v"(ACC) : "v"(A8), "v"(q8b), "v"(mxs_))
#define A3_QKT(P0, P1, so) do { if (QK8) { A3_KLD8(so); A3_MXQ(P0, kq_[0]); A3_MXQ(P1, kq_[1]); if (DK == 96) { asm volatile("s_nop 15\n\ts_nop 15" : "+v"(P0), "+v"(P1)); A3_MXQ2(P0, kq_[2]); A3_MXQ2(P1, kq_[3]); }     asm volatile("s_nop 15\n\ts_nop 15" : "+v"(P0), "+v"(P1)); } else { const lp kb_ = K_lds + (so) * SHM_K; \
    _Pragma("unroll") for (int d0 = 0; d0 < NQD; ++d0) { const bf16x8 b0_ = *(lp8)(kb_ + kswz<DK>(r32, 2 * d0 + hi)), b1_ = *(lp8)(kb_ + kswz<DK>(32 + r32, 2 * d0 + hi)); \
        if (d0 == 0) { P0 = __builtin_amdgcn_mfma_f32_32x32x16_bf16(b0_, qr[0], negm, 0, 0, 0); P1 = __builtin_amdgcn_mfma_f32_32x32x16_bf16(b1_, qr[0], negm, 0, 0, 0); } \
        else { P0 = __builtin_amdgcn_mfma_f32_32x32x16_bf16(b0_, qr[d0], P0, 0, 0, 0); P1 = __builtin_amdgcn_mfma_f32_32x32x16_bf16(b1_, qr[d0], P1, 0, 0, 0); } } } } while (0)
#define A3_PK4(P, BASE, IDX) do { p8_[IDX] = __builtin_amdgcn_cvt_pk_fp8_f32(P[BASE + 0], P[BASE + 1], p8_[IDX], false); p8_[IDX] = __builtin_amdgcn_cvt_pk_fp8_f32(P[BASE + 2], P[BASE + 3], p8_[IDX], true); \
    p8_[IDX + 1] = __builtin_amdgcn_cvt_pk_fp8_f32(P[BASE + 4], P[BASE + 5], p8_[IDX + 1], false); p8_[IDX + 1] = __builtin_amdgcn_cvt_pk_fp8_f32(P[BASE + 6], P[BASE + 7], p8_[IDX + 1], true); } while (0)
#define A3_ROWMAX(P0, P1, OUT) do { float a_ = ATT_MX3(P0[0], P0[1], P1[0]), b_ = ATT_MX3(P0[2], P0[3], P1[1]); a_ = ATT_MX3(a_, P1[2], P1[3]); \
    _Pragma("unroll") for (int r = 4; r < 16; r += 4) { a_ = ATT_MX3(a_, P0[r], P0[r + 1]); b_ = ATT_MX3(b_, P0[r + 2], P0[r + 3]); a_ = ATT_MX3(a_, P1[r], P1[r + 1]); b_ = ATT_MX3(b_, P1[r + 2], P1[r + 3]); } \
    float m_ = fmaxf(a_, b_); const auto rr_ = __builtin_amdgcn_permlane32_swap(__float_as_uint(m_), __float_as_uint(m_), false, false); OUT = fmaxf(__uint_as_float(rr_[0]), __uint_as_float(rr_[1])); } while (0)
#define A3_DECIDE(P0, P1, PMAX, FIRST, ALPHA) do { ALPHA = 1.f; if (__builtin_expect((FIRST) || __any(PMAX > THR), 0)) { const float dl_ = (FIRST) ? PMAX : fmaxf(PMAX, 0.f); mhat += dl_; const float nm_ = -mhat; \
    _Pragma("unroll") for (int r = 0; r < 16; ++r) { asm volatile("v_sub_f32_e32 %0, %0, %1" : "+v"(P0[r]) : "v"(dl_)); asm volatile("v_sub_f32_e32 %0, %0, %1" : "+v"(P1[r]) : "v"(dl_)); } \
    _Pragma("unroll") for (int r = 0; r < 16; ++r) asm volatile("v_mov_b32_e32 %0, %1" : "+v"(negm[r]) : "v"(nm_)); \
    ALPHA = (FIRST) ? 1.f : __builtin_amdgcn_exp2f(-dl_); } } while (0)
#define A3_DECIDE2(P0, P1, MH, ALPHA, RARE, BETWEEN) do { ALPHA = 1.f; RARE = __ballot(MH > THR) != 0ull; BETWEEN; if (__builtin_expect(RARE, 0)) {       \
    const auto rr_ = __builtin_amdgcn_permlane32_swap(__float_as_uint(MH), __float_as_uint(MH), false, false); const float pm_ = fmaxf(__uint_as_float(rr_[0]), __uint_as_float(rr_[1])); \
    const float dl_ = fmaxf(pm_, 0.f); mhat += dl_; const float nm_ = -mhat; \
    _Pragma("unroll") for (int r = 0; r < 16; ++r) { asm volatile("v_sub_f32_e32 %0, %0, %1" : "+v"(P0[r]) : "v"(dl_)); asm volatile("v_sub_f32_e32 %0, %0, %1" : "+v"(P1[r]) : "v"(dl_)); } \
    _Pragma("unroll") for (int r = 0; r < 16; ++r) asm volatile("v_mov_b32_e32 %0, %1" : "+v"(negm[r]) : "v"(nm_)); \
    ALPHA = __builtin_amdgcn_exp2f(-dl_); } } while (0)
#define A3_EXP(P) do { _Pragma("unroll") for (int r = 0; r < 16; ++r) P[r] = __builtin_amdgcn_exp2f(P[r]); } while (0)
#define A3_RESC2(a) do { { const float f_ = (a); asm volatile("s_nop 15\n\ts_nop 15" : "+v"(o0), "+v"(o1)); if (!LSUMV) asm volatile("" : "+v"(lacc)); \
    lsum_ *= f_; _Pragma("unroll") for (int r = 0; r < 16; ++r) { o0[r] *= f_; o1[r] *= f_; } if (!LSUMV) lacc *= f_; } } while (0)
#define A3_RESC(a) do { if (__any((a) < 1.f)) { const float f_ = (a); asm volatile("s_nop 15\n\ts_nop 15" : "+v"(o0), "+v"(o1)); if (!LSUMV) asm volatile("" : "+v"(lacc)); \
    lsum_ *= f_; _Pragma("unroll") for (int r = 0; r < 16; ++r) { o0[r] *= f_; o1[r] *= f_; } if (!LSUMV) lacc *= f_; } } while (0)
    const int onev_ = ((((lane >> 4) ^ lane) & 1) == 0) ? 0x38383838 : 0;
    i8v ones = {onev_, onev_, onev_, onev_, onev_, onev_, onev_, onev_}; asm volatile("" : "+v"(ones));
    int mxs_ = 0x7F7F7F7F; asm volatile("" : "+v"(mxs_));
#define A3_MXL(ACC, A8, B8) asm volatile("s_nop 0\n\tv_mfma_scale_f32_16x16x128_f8f6f4 %0, %1, %2, %0, %3, %3 op_sel_hi:[0,0,0]" : "+v"(ACC) : "v"(A8), "v"(B8), "v"(mxs_))
#define A3_MX0(ACC, A8, B8) asm volatile("v_mfma_scale_f32_32x32x64_f8f6f4 %0, %1, %2, %0, %3, %3 op_sel_hi:[0,0,0]" : "+v"(ACC) : "v"(A8), "v"(B8), "v"(mxs_))
#define A3_MX(ACC, A8, B8) asm volatile("s_nop 1\n\tv_mfma_scale_f32_32x32x64_f8f6f4 %0, %1, %2, %0, %3, %3 op_sel_hi:[0,0,0]" : "+v"(ACC) : "v"(A8), "v"(B8), "v"(mxs_))
#define A3_SB() __builtin_amdgcn_sched_barrier(0)
#define A3_KPF(d0, so) do { if (QK8) { if (PREF && (d0) == 0) A3_KLD8(so); } else if (PREF && (d0) < NQD) { const lp kb_ = K_lds + (so) * SHM_K; kf_[2 * (d0)] = *(lp8)(kb_ + kswz<DK>(r32, 2 * (d0) + hi)); kf_[2 * (d0) + 1] = *(lp8)(kb_ + kswz<DK>(32 + r32, 2 * (d0) + hi)); } } while (0)
#define slot6(t) ((r0_ + ((t) - (s))) >= 6 ? (r0_ + ((t) - (s))) - 6 : (r0_ + ((t) - (s))))
#define A3_EX8(P, B) do { _Pragma("unroll") for (int r_ = 0; r_ < 8; ++r_) P[(B) + r_] = __builtin_amdgcn_exp2f(P[(B) + r_]); asm volatile("" : "+v"(P)); } while (0)
#define A3_EX4(P, B) do { P[B] = __builtin_amdgcn_exp2f(P[B]); P[B + 1] = __builtin_amdgcn_exp2f(P[B + 1]); P[B + 2] = __builtin_amdgcn_exp2f(P[B + 2]); P[B + 3] = __builtin_amdgcn_exp2f(P[B + 3]); asm volatile("" : "+v"(P)); } while (0)
#define A3_MX4(P0, P1, B) do { mxa_ = ATT_MX3(mxa_, P0[B], P0[B + 1]); mxb_ = ATT_MX3(mxb_, P0[B + 2], P0[B + 3]); mxa_ = ATT_MX3(mxa_, P1[B], P1[B + 1]); mxb_ = ATT_MX3(mxb_, P1[B + 2], P1[B + 3]); } while (0)
#define A3_GAP1(g, P0, P1) do { \
    if (NQD == 4 || !LSUMV) { if ((g) == 0) A3_PK4(P0, 0, 0); else if ((g) == 1) A3_PK4(P0, 8, 2); else if ((g) == 2) A3_EX4(P1, 0); else if ((g) == 3) A3_EX4(P1, 4); else if ((g) == 4) A3_EX4(P1, 8); else if ((g) == 5) A3_EX4(P1, 12); \
                    else if ((g) == 6) A3_PK4(P1, 0, 4); else if ((g) == 7) A3_PK4(P1, 8, 6); } \
    else { if ((g) == 1) { if (LSUMV) { float s_ = (P0[0] + P0[1]) + (P0[2] + P0[3]); _Pragma("unroll") for (int r = 4; r < 16; r += 4) s_ += (P0[r] + P0[r + 1]) + (P0[r + 2] + P0[r + 3]); lsum_ += s_; } } \
           else if ((g) == 7) { if (LSUMV) lsum_ += ((P1[0] + P1[1]) + (P1[2] + P1[3])) + ((P1[4] + P1[5]) + (P1[6] + P1[7])); } else if ((g) == 9) { if (LSUMV) lsum_ += ((P1[8] + P1[9]) + (P1[10] + P1[11])) + ((P1[12] + P1[13]) + (P1[14] + P1[15])); } \
           else if ((g) == 0) A3_PK4(P0, 0, 0); else if ((g) == 2) A3_PK4(P0, 8, 2); else if ((g) == 3) A3_EX4(P1, 0); else if ((g) == 4) A3_EX4(P1, 4); else if ((g) == 5) A3_EX4(P1, 8); else if ((g) == 6) A3_EX4(P1, 12); \
           else if ((g) == 8) A3_PK4(P1, 0, 4); else if ((g) == 10) A3_PK4(P1, 8, 6); } } while (0)
#define A3_VTLD() do { const i4v a_ = *(__attribute__((address_space(3))) i4v*)(vp_ + vrd), b_ = *(__attribute__((address_space(3))) i4v*)(vp_ + vrd2), c_ = *(__attribute__((address_space(3))) i4v*)(vp_ + 2048 + vrd), d_ = *(__attribute__((address_space(3))) i4v*)(vp_ + 2048 + vrd2); \
    vt0_ = __builtin_shufflevector(a_, b_, 0, 1, 2, 3, 4, 5, 6, 7); vt1_ = __builtin_shufflevector(c_, d_, 0, 1, 2, 3, 4, 5, 6, 7); } while (0)
#define A3_EX2(P, B) do { P[B] = __builtin_amdgcn_exp2f(P[B]); P[(B) + 1] = __builtin_amdgcn_exp2f(P[(B) + 1]); asm volatile("" : "+v"(P)); A3_SB(); } while (0)
#define A3_STEP(EVEN, R0, s, P0, P1, N0, N1, sv_, sk_, skn_) do { float pmax_, alpha_; i8v vt0_, vt1_; \
    if (EVEN) { __syncthreads();        \
        if ((s) + 4 < NT) { A3_SWRITE(0, ((R0) + 4) % 6); A3_SWRITE(1, ((R0) + 5) % 6); }     \
        if ((s) + 6 < NT) { A3_SLOAD(0, ((s) + 6) * KVBLK); A3_SLOAD(1, ((s) + 7) * KVBLK); } } \
    if (!PREF) A3_KLD8(sk_); \
    A3_SB(); \
    const lp vp_ = V_lds + (sv_) * SHM_V; \
      \
    A3_MXQ(N0, kq_[0]); A3_SB(); A3_PK4(P0, 0, 0); A3_EX4(P1, 0); A3_SB(); \
    if (DK == 96) { A3_MXQ(N1, kq_[1]); A3_SB(); A3_VTLD(); } \
    A3_PK4(P0, 8, 2); A3_EX4(P1, 4); A3_SB(); \
    if (DK == 96) { A3_MXQ2(N0, kq_[2]); A3_SB(); } else { A3_MXQ(N1, kq_[1]); A3_SB(); A3_VTLD(); } \
    A3_EX4(P1, 8); A3_PK4(P1, 0, 4); A3_SB(); \
    if (DK == 96) { A3_MXQ2(N1, kq_[3]); A3_SB(); } \
    A3_EX4(P1, 12); A3_PK4(P1, 8, 6); A3_SB(); \
      \
    A3_MX(o0, vt0_, p8_); A3_SB(); \
    { float m0_, m1_, m2_, m3_;       \
      asm("v_max3_f32 %0, %4, %5, %6\n\tv_max3_f32 %1, %7, %8, %9\n\tv_max3_f32 %2, %10, %11, %12\n\tv_max3_f32 %3, %13, %14, %15\n\tv_max3_f32 %0, %0, %16, %17\n\tv_max3_f32 %1, %1, %18, %19" \
          : "=&v"(m0_), "=&v"(m1_), "=&v"(m2_), "=&v"(m3_) : "v"(N0[0]), "v"(N0[1]), "v"(N0[2]), "v"(N0[3]), "v"(N0[4]), "v"(N0[5]), "v"(N0[6]), "v"(N0[7]), "v"(N0[8]), "v"(N0[9]), "v"(N0[10]), "v"(N0[11]), "v"(N0[12]), "v"(N0[13]), "v"(N0[14]), "v"(N0[15])); \
      asm("v_max3_f32 %2, %2, %4, %5\n\tv_max3_f32 %3, %3, %6, %7\n\tv_max3_f32 %0, %0, %8, %9\n\tv_max3_f32 %1, %1, %10, %11\n\tv_max3_f32 %2, %2, %12, %13\n\tv_max3_f32 %3, %3, %14, %15\n\tv_max3_f32 %0, %0, %16, %17\n\tv_max3_f32 %1, %1, %18, %19\n\tv_max3_f32 %0, %0, %2, %3\n\tv_max_f32_e32 %0, %0, %1" \
          : "+v"(m0_), "+v"(m1_), "+v"(m2_), "+v"(m3_) : "v"(N1[0]), "v"(N1[1]), "v"(N1[2]), "v"(N1[3]), "v"(N1[4]), "v"(N1[5]), "v"(N1[6]), "v"(N1[7]), "v"(N1[8]), "v"(N1[9]), "v"(N1[10]), "v"(N1[11]), "v"(N1[12]), "v"(N1[13]), "v"(N1[14]), "v"(N1[15])); \
      pmax_ = m0_; \
      A3_SB(); \
      A3_MX0(o1, vt1_, p8_); A3_SB(); } \
    bool rare_; A3_DECIDE2(N0, N1, pmax_, alpha_, rare_, A3_KPF(0, skn_)); \
    A3_SB(); \
      \
    A3_EX8(N0, 0); A3_SB(); \
    if (!LSUMV) { A3_MXL(lacc, ones, p8_); A3_SB(); } \
    A3_EX8(N0, 8); A3_SB(); \
    if (rare_ && (s) + 1 < NT) A3_RESC2(alpha_); } while (0)
    const int NT = nkeys / KVBLK;
    constexpr bool PREF = true;
    bf16x8 kf_[2 * NQD];
    f32x16 pA0, pA1, pB0, pB1; i8v p8_ = {};
    __syncthreads();
    A3_SLOAD(0, 0); A3_SLOAD(1, KVBLK); A3_SWRITE(0, 0); A3_SWRITE(1, 1); A3_SLOAD(0, 2 * KVBLK); A3_SLOAD(1, 3 * KVBLK); A3_SWRITE(0, 2); A3_SWRITE(1, 3);
    if (4 < NT) { A3_SLOAD(0, 4 * KVBLK); A3_SLOAD(1, 5 * KVBLK); }
    __syncthreads();
    { float pmax_, alpha_; A3_QKT(pA0, pA1, 0); A3_ROWMAX(pA0, pA1, pmax_); A3_DECIDE(pA0, pA1, pmax_, true, alpha_); A3_EXP(pA0); (void)alpha_; }
    if (PREF) {
#pragma unroll
        for (int d0 = 0; d0 < NQD; ++d0) A3_KPF(d0, 1); }
    for (int s = 0; s < NT; s += 6) {
        A3_STEP(true, 0, s, pA0, pA1, pB0, pB1, 0, 1, 2);
        A3_STEP(false, 0, s + 1, pB0, pB1, pA0, pA1, 1, 2, 3);
        if (s + 2 >= NT) break;
        A3_STEP(true, 2, s + 2, pA0, pA1, pB0, pB1, 2, 3, 4);
        A3_STEP(false, 2, s + 3, pB0, pB1, pA0, pA1, 3, 4, 5);
        if (s + 4 >= NT) break;
        A3_STEP(true, 4, s + 4, pA0, pA1, pB0, pB1, 4, 5, 0);
        A3_STEP(false, 4, s + 5, pB0, pB1, pA0, pA1, 5, 0, 1);
    }
    asm volatile("s_nop 15\n\ts_nop 15" : "+v"(o0), "+v"(o1)); if (!LSUMV) asm volatile("" : "+v"(lacc));
    { float lt_ = (r32 & 16) ? lacc[1] : lacc[0];
        if (LSUMV) { const auto rr_ = __builtin_amdgcn_permlane32_swap(__float_as_uint(lsum_), __float_as_uint(lsum_), false, false); lt_ = __uint_as_float(rr_[0]) + __uint_as_float(rr_[1]); }
        const float rl = __builtin_amdgcn_rcpf(lt_);
        __attribute__((address_space(1))) bf16_t* Ow = (__attribute__((address_space(1))) bf16_t*)(Ob + (long)(wid * QBLK + r32) * LDO);
        typedef unsigned u4v_ __attribute__((ext_vector_type(4)));
#pragma unroll
        for (int blk = 0; blk < 2; ++blk)
#pragma unroll
            for (int j = 0; j < 2; ++j) { const int ga = 8 * j, gb = 8 * j + 4;
                const unsigned ax = blk ? cvtpk_b(o1[ga] * rl, o1[ga + 1] * rl) : cvtpk_b(o0[ga] * rl, o0[ga + 1] * rl), ay = blk ? cvtpk_b(o1[ga + 2] * rl, o1[ga + 3] * rl) : cvtpk_b(o0[ga + 2] * rl, o0[ga + 3] * rl);
                const unsigned bx = blk ? cvtpk_b(o1[gb] * rl, o1[gb + 1] * rl) : cvtpk_b(o0[gb] * rl, o0[gb + 1] * rl), by = blk ? cvtpk_b(o1[gb + 2] * rl, o1[gb + 3] * rl) : cvtpk_b(o0[gb + 2] * rl, o0[gb + 3] * rl);
                const auto rx = __builtin_amdgcn_permlane32_swap(ax, bx, false, false), ry = __builtin_amdgcn_permlane32_swap(ay, by, false, false);
                const u4v_ w = {rx[0], ry[0], rx[1], ry[1]};
                *(__attribute__((address_space(1))) u4v_*)(Ow + 32 * blk + 16 * j + 8 * hi) = w; } }
#undef A3_MX
#undef A3_MX0
#undef A3_MXL
#undef A3_MXQ
#undef A3_MXQ2
#undef A3_KLD8
#undef A3_SLOAD
#undef A3_SWRITE
#undef A3_QKT
#undef A3_PK4
#undef A3_ROWMAX
#undef A3_DECIDE
#undef A3_EXP
#undef A3_RESC
#undef A3_RESC2
#undef A3_STEP
#undef A3_SB
#undef A3_KPF
#undef slot6
#undef A3_EX4
#undef A3_EX8
#undef A3_MX4
#undef A3_GAP1
#undef A3_VTLD
#undef A3_DECIDE2
#undef A3_EX2
}
#undef ATT_SBAR
}

constexpr int NWAVES = 8;
constexpr int BATCH = 4, SEQ = 8192, CTXL = 256, D = 1024, ROWS_B = CTXL + SEQ, M = BATCH * ROWS_B, NPAN = M / 256;
constexpr int MLAT = BATCH * SEQ;
constexpr int AB_IN = 1536, CD_IN = 1440, CD_INP = 1536, DFF = 2816, NEXP = 8;
constexpr int MOE_ROWS = 2 * M + NEXP * 256;
constexpr float EPS = 1e-6f;
static_assert(M == 33792 && NPAN == 132 && NPAN == BATCH * pg8::PAN_B, "row layout");

#ifndef HDP_FP8
#define HDP_FP8 14
#endif
constexpr int FP8G2 = (HDP_FP8 & 8) != 0;
constexpr bool FP8F = (HDP_FP8 & 1) != 0, FP8M = (HDP_FP8 & 2) != 0, FP8D = FP8F || (HDP_FP8 & 4) != 0;
#ifndef HDP_MX
#define HDP_MX 2
#endif
constexpr int MXM = HDP_MX;
#ifndef HDP_MOE_SP2
#define HDP_MOE_SP2 0
#endif
constexpr bool MOE_SP2 = HDP_MOE_SP2 != 0;
#ifndef HDP_MOE_ALIGN
#define HDP_MOE_ALIGN 1
#endif
constexpr bool MOE_ALIGN = HDP_MOE_ALIGN != 0;
constexpr float WSC = 64.0f, WSC_INV = 1.0f / 64.0f;
constexpr size_t MiB = 1u << 20;
constexpr size_t WS_CTL = 0, CTL_ZERO_BYTES = 1 * MiB;
constexpr size_t WS_MOD = 1 * MiB;
constexpr size_t WS_TOPK = 2 * MiB;
constexpr size_t WS_TOKSLOT = 3 * MiB;
constexpr size_t WS_CNT = 3 * MiB + 512 * 1024;
constexpr size_t WS_PEXP = 3 * MiB + 768 * 1024;
constexpr size_t WS_ROPE = 4 * MiB;
constexpr size_t WS_WSMALL = 5 * MiB;
constexpr size_t EV_WIN = 0, EV_WS = 3 * MiB, EV_WPOOL = EV_WS + 128 * 1024, EV_WOUT = EV_WPOOL + 128 * 1024, EV_WGU = EV_WOUT + 2 * MiB, EV_WDN = EV_WGU + 11 * MiB, EV_STRIDE = EV_WDN + 5632 * 1024;
constexpr size_t WS_WODD = WS_WSMALL + 2 * EV_STRIDE;
constexpr size_t OD_WCD = 0, OD_WUQ = 3 * MiB, OD_WUKV = OD_WUQ + 576 * 1024, OD_WCDO = OD_WUKV + 512 * 1024, OD_STRIDE = OD_WCDO + 2 * MiB;
constexpr size_t WS_WMOE = (WS_WODD + 2 * OD_STRIDE + MiB - 1) / MiB * MiB;
constexpr size_t MOE_WGU = (size_t)5632 * 1024 * 2, MOE_WDN = (size_t)1024 * 2816 * 2, MOE_WDN_OFF = NEXP * MOE_WGU;
constexpr size_t MOE_WGU8 = (size_t)5632 * 1024, MOE_WDN8 = (size_t)1024 * 2816, MOE_WDN_OFF8 = NEXP * MOE_WGU8;
constexpr size_t WS_XS = WS_WMOE + NEXP * (MOE_WGU + MOE_WDN);
constexpr size_t WS_BIG = WS_XS + (size_t)M * D * 2;
constexpr size_t B_Z = 0;
constexpr size_t B_Y = B_Z + (size_t)M * 1536 * 2;
constexpr size_t B_HB = B_Y + (size_t)M * 1024 * 2;
constexpr size_t B_QC = B_Y + (size_t)M * 1024 * 2;
constexpr size_t B_KC = B_QC + (size_t)M * 512 * 2;
constexpr size_t B_CQN = B_KC + (size_t)M * 128 * 2;
constexpr size_t B_CKVN = B_CQN + (size_t)M * 384 * 2;
constexpr size_t B_QD = B_CKVN + (size_t)M * 256 * 2;
constexpr size_t B_KD = B_QD + (size_t)M * 768 * 2;
constexpr size_t B_VD = B_KD + (size_t)M * 768 * 2;
constexpr size_t B_VT8 = B_VD + (size_t)M * 512 * 2;
constexpr size_t B_QC8 = B_VT8 + (size_t)BATCH * 10 * (ROWS_B / 64) * 4096;
constexpr size_t B_KC8 = B_QC8 + (size_t)M * 512;
constexpr size_t B_ATT_END = B_KC8 + (size_t)M * 128;
constexpr size_t B_HS = 0;
constexpr size_t B_HM = B_HS + (size_t)MOE_ROWS * 1024 * 2;
constexpr size_t B_END = B_HM + (size_t)MOE_ROWS * 2816 * 2;
constexpr size_t B_H = B_END - (size_t)M * 1024 * 2;
static_assert(B_HB + (size_t)M * 2816 * 2 <= B_H && B_ATT_END <= B_H, "H must stay clear of the even-layer / attention buffers");
constexpr size_t WS_END = WS_BIG + B_END;

constexpr int RING_OFF = 0, RING_BYTES = 131072;
constexpr int LDSCTL_OFF = RING_BYTES, MISC_OFF = LDSCTL_OFF + 320;
constexpr int LDS_BYTES = 147456;
static_assert(att::Lds3<96>::BYTES <= RING_BYTES && att::Lds4<96>::BYTES <= RING_BYTES && pg8::STAGE_BYTES <= RING_BYTES, "LDS");

typedef unsigned short bf16;
typedef unsigned v4u __attribute__((ext_vector_type(4)));
typedef unsigned v2u __attribute__((ext_vector_type(2)));
typedef float f32x4 __attribute__((ext_vector_type(4)));
typedef short bf16x8 __attribute__((ext_vector_type(8)));
#define LDS_WAIT() asm volatile("s_waitcnt lgkmcnt(0)" ::: "memory")
#define VM_WAIT() asm volatile("s_waitcnt vmcnt(0)" ::: "memory")
__device__ __forceinline__ unsigned pk2(float lo, float hi) { unsigned r; asm volatile("v_cvt_pk_bf16_f32 %0, %1, %2" : "=v"(r) : "v"(lo), "v"(hi)); return r; }
__device__ __forceinline__ float bf_lo(unsigned w) { return __uint_as_float(w << 16); }
__device__ __forceinline__ float bf_hi(unsigned w) { return __uint_as_float(w & 0xffff0000u); }
__device__ __forceinline__ float bf1(unsigned short h) { return __uint_as_float(((unsigned)h) << 16); }
__device__ __forceinline__ float wave_sum(float v) {
#pragma unroll
    for (int o = 1; o < 64; o <<= 1) v += __shfl_xor(v, o);
    return v;
}
typedef unsigned short xs_t;
__device__ __forceinline__ v2u xs_ld(const xs_t* XS, size_t row, int lane, int q) { return *((const v2u*)(XS + row * D) + lane + 64 * q); }
__device__ __forceinline__ f32x4 xs_cvt(v2u r) { return (f32x4){bf_lo(r.x), bf_hi(r.x), bf_lo(r.y), bf_hi(r.y)}; }
__device__ __forceinline__ void xs_st(xs_t* XS, size_t row, int lane, int q, f32x4 v) { v2u o; o.x = pk2(v[0], v[1]); o.y = pk2(v[2], v[3]); *((v2u*)(XS + row * D) + lane + 64 * q) = o; }

struct Args { const float* in[29]; float* out; unsigned char* ws; int ph_lo, ph_hi; };
enum { I_X = 0, I_C, I_CTX, I_CCTX, I_ADAW, I_ADAB, I_ABWIN, I_AVGAIN, I_AWS, I_ABS, I_BWPOOL, I_BSCALE, I_ABWOUT, I_FFNG, I_FFNU, I_FFND, I_CDWIN, I_CQGAIN, I_CKGAIN, I_DCQGAIN,
       I_DCKVGAIN, I_DWUQ, I_DWUKV, I_CDWOUT, I_ROUTER, I_MOEG, I_MOEU, I_MOED, I_FGAIN };
struct Ctx {
    LAS unsigned char* lds; unsigned char* ldsg;
    int tid, lane, wave, vcu, G, bx;
    GAS unsigned char* ws;
};
__device__ __forceinline__ int modrow_of_row(int row) { const int b = row / ROWS_B; return (row - b * ROWS_B < CTXL) ? 4 : b; }

__device__ __forceinline__ void tr_item(const float* W, int K, int N, bf16* WT, int il, int off, LAS float* scr, int item, int lane) {
    const int nblk = N / 32, kb = item / nblk, nb = item - kb * nblk, k0 = 64 * kb, n0 = 32 * nb;
    float wv[32];
#pragma unroll
    for (int i = 0; i < 32; ++i) wv[i] = W[(size_t)(k0 + 2 * i + (lane >> 5)) * N + n0 + (lane & 31)];
#pragma unroll
    for (int i = 0; i < 32; ++i) scr[(2 * i + (lane >> 5)) * 33 + (lane & 31)] = wv[i];
    LDS_WAIT(); asm volatile("" ::: "memory");
    const int c = lane & 7;
#pragma unroll
    for (int j = 0; j < 4; ++j) { const int n = (lane >> 3) + 8 * j; const LAS float* s = scr + (8 * c) * 33 + n;
        v4u o; o.x = pk2(s[0 * 33], s[1 * 33]); o.y = pk2(s[2 * 33], s[3 * 33]); o.z = pk2(s[4 * 33], s[5 * 33]); o.w = pk2(s[6 * 33], s[7 * 33]);
        const int nn = n0 + n; const int drow = il ? ((nn >> 7) * 256 + (nn & 127) + off) : (nn + off);
        *(v4u*)(WT + (size_t)drow * K + k0 + 8 * c) = o; }
    LDS_WAIT(); asm volatile("" ::: "memory");
}
__device__ __forceinline__ void tr_item8(const float* W, int K, int N, unsigned char* WT, int il, int off, LAS float* scr, int item, int lane) {
    const int nblk = N / 32, kb = item / nblk, nb = item - kb * nblk, k0 = 64 * kb, n0 = 32 * nb;
    float wv[32];
#pragma unroll
    for (int i = 0; i < 32; ++i) wv[i] = W[(size_t)(k0 + 2 * i + (lane >> 5)) * N + n0 + (lane & 31)];
#pragma unroll
    for (int i = 0; i < 32; ++i) scr[(2 * i + (lane >> 5)) * 33 + (lane & 31)] = wv[i];
    LDS_WAIT(); asm volatile("" ::: "memory");
    const int n = lane >> 1, hf = lane & 1; const LAS float* s = scr + (32 * hf) * 33 + n;
    v4u o0, o1;
    o0.x = pg8::pk4_fp8(s[0 * 33] * WSC, s[1 * 33] * WSC, s[2 * 33] * WSC, s[3 * 33] * WSC);     o0.y = pg8::pk4_fp8(s[4 * 33] * WSC, s[5 * 33] * WSC, s[6 * 33] * WSC, s[7 * 33] * WSC);
    o0.z = pg8::pk4_fp8(s[8 * 33] * WSC, s[9 * 33] * WSC, s[10 * 33] * WSC, s[11 * 33] * WSC);   o0.w = pg8::pk4_fp8(s[12 * 33] * WSC, s[13 * 33] * WSC, s[14 * 33] * WSC, s[15 * 33] * WSC);
    o1.x = pg8::pk4_fp8(s[16 * 33] * WSC, s[17 * 33] * WSC, s[18 * 33] * WSC, s[19 * 33] * WSC); o1.y = pg8::pk4_fp8(s[20 * 33] * WSC, s[21 * 33] * WSC, s[22 * 33] * WSC, s[23 * 33] * WSC);
    o1.z = pg8::pk4_fp8(s[24 * 33] * WSC, s[25 * 33] * WSC, s[26 * 33] * WSC, s[27 * 33] * WSC); o1.w = pg8::pk4_fp8(s[28 * 33] * WSC, s[29 * 33] * WSC, s[30 * 33] * WSC, s[31 * 33] * WSC);
    const int nn = n0 + n; const int drow = il ? ((nn >> 7) * 256 + (nn & 127) + off) : (nn + off);
    unsigned char* dst = WT + (size_t)drow * K + k0 + 32 * hf;
    *(v4u*)dst = o0; *(v4u*)(dst + 16) = o1;
    LDS_WAIT(); asm volatile("" ::: "memory");
}
struct MatDesc { const float* W; bf16* WT; int K, N, il, off, f8; };
__device__ __forceinline__ MatDesc small_desc(const Args& a, unsigned char* ws, int m) {
    const int i = m / 13, k = m - i * 13; MatDesc d; d.il = 0; d.off = 0; d.f8 = (((FP8F || (FP8G2 && i == 1)) && (k == 6 || k == 7)) || (FP8D && k == 8)) ? 1 : 0;
    unsigned char* ev = ws + WS_WSMALL + (size_t)i * EV_STRIDE; unsigned char* od = ws + WS_WODD + (size_t)i * OD_STRIDE;
    if (k == 0)       { d.W = a.in[I_ABWIN] + (size_t)i * 1024 * 1536; d.K = 1024; d.N = 1536; d.WT = (bf16*)(ev + EV_WIN); }
    else if (k <= 4)  { d.W = a.in[I_BWPOOL] + (size_t)(i * 4 + k - 1) * 128 * 128; d.K = 128; d.N = 128; d.WT = (bf16*)(ev + EV_WPOOL) + (size_t)(k - 1) * 128 * 128; }
    else if (k == 5)  { d.W = a.in[I_ABWOUT] + (size_t)i * 1024 * 1024; d.K = 1024; d.N = 1024; d.WT = (bf16*)(ev + EV_WOUT); }
    else if (k == 6)  { d.W = a.in[I_FFNG] + (size_t)i * 1024 * DFF; d.K = 1024; d.N = DFF; d.WT = (bf16*)(ev + EV_WGU); d.il = 1; }
    else if (k == 7)  { d.W = a.in[I_FFNU] + (size_t)i * 1024 * DFF; d.K = 1024; d.N = DFF; d.WT = (bf16*)(ev + EV_WGU); d.il = 1; d.off = 128; }
    else if (k == 8)  { d.W = a.in[I_FFND] + (size_t)i * DFF * 1024; d.K = DFF; d.N = 1024; d.WT = (bf16*)(ev + EV_WDN); }
    else if (k == 9)  { d.W = a.in[I_CDWIN] + (size_t)i * 1024 * CD_IN; d.K = 1024; d.N = CD_IN; d.WT = (bf16*)(od + OD_WCD); }
    else if (k == 10) { d.W = a.in[I_DWUQ] + (size_t)i * 384 * 768; d.K = 384; d.N = 768; d.WT = (bf16*)(od + OD_WUQ); }
    else if (k == 11) { d.W = a.in[I_DWUKV] + (size_t)i * 256 * 1024; d.K = 256; d.N = 1024; d.WT = (bf16*)(od + OD_WUKV); }
    else              { d.W = a.in[I_CDWOUT] + (size_t)i * 1024 * 1024; d.K = 1024; d.N = 1024; d.WT = (bf16*)(od + OD_WCDO); }
    return d;
}
__device__ __forceinline__ MatDesc moe_desc(const Args& a, unsigned char* ws, int li, int m) {
    const int e = m / 3, k = m - e * 3; MatDesc d; d.il = 0; d.off = 0; d.f8 = FP8M ? 1 : 0;
    const size_t wgu = FP8M ? MOE_WGU8 : MOE_WGU, wdn = FP8M ? MOE_WDN8 : MOE_WDN, wdo = FP8M ? MOE_WDN_OFF8 : MOE_WDN_OFF;
    if (k == 0)      { d.W = a.in[I_MOEG] + (size_t)(li * NEXP + e) * 1024 * DFF; d.K = 1024; d.N = DFF; d.WT = (bf16*)(ws + WS_WMOE + (size_t)e * wgu); d.il = 1; }
    else if (k == 1) { d.W = a.in[I_MOEU] + (size_t)(li * NEXP + e) * 1024 * DFF; d.K = 1024; d.N = DFF; d.WT = (bf16*)(ws + WS_WMOE + (size_t)e * wgu); d.il = 1; d.off = 128; }
    else             { d.W = a.in[I_MOED] + (size_t)(li * NEXP + e) * DFF * 1024; d.K = DFF; d.N = 1024; d.WT = (bf16*)(ws + WS_WMOE + wdo + (size_t)e * wdn); }
    return d;
}
__device__ __forceinline__ void convert_small(const Ctx& F, const Args& a) {
    LAS float* scr = (LAS float*)(F.lds + RING_OFF + F.wave * 16384);
    const int gw = F.vcu * NWAVES + F.wave, NGW = F.G * NWAVES;
    int it = gw, base = 0;
    for (int m = 0; m < 26; ++m) { const MatDesc d = small_desc(a, (unsigned char*)F.ws, m); const int items = (d.K / 64) * (d.N / 32);
        for (; it < base + items; it += NGW) { if (d.f8) tr_item8(d.W, d.K, d.N, (unsigned char*)d.WT, d.il, d.off, scr, it - base, F.lane); else tr_item(d.W, d.K, d.N, d.WT, d.il, d.off, scr, it - base, F.lane); }
        base += items; }
    const int gt = F.vcu * (NWAVES * 64) + F.tid, NGT = F.G * NWAVES * 64;
    for (int i = gt; i < 2 * 96 * 1024 / 8; i += NGT) { const int l = i / (96 * 128), r = i - l * (96 * 128);
        *(v4u*)(F.ws + WS_WODD + (size_t)l * OD_STRIDE + OD_WCD + (size_t)CD_IN * 1024 * 2 + (size_t)r * 16) = (v4u){0u, 0u, 0u, 0u}; }
    for (int i = gt; i < 2 * 4 * 128 * 128 / 8; i += NGT) { const int l = i / (4 * 128 * 128 / 8), r = i - l * (4 * 128 * 128 / 8);
        const f32x4 x0 = *(const f32x4*)(a.in[I_AWS] + (size_t)i * 8), x1 = *(const f32x4*)(a.in[I_AWS] + (size_t)i * 8 + 4);
        v4u o; o.x = pk2(x0[0], x0[1]); o.y = pk2(x0[2], x0[3]); o.z = pk2(x1[0], x1[1]); o.w = pk2(x1[2], x1[3]);
        *(v4u*)(F.ws + WS_WSMALL + (size_t)l * EV_STRIDE + EV_WS + (size_t)r * 16) = o; }
}
__device__ __forceinline__ void rope_table(const Ctx& F) {
    const int gt = F.vcu * (NWAVES * 64) + F.tid, NGT = F.G * NWAVES * 64; float* T = (float*)(F.ws + WS_ROPE);
    for (int i = gt; i < SEQ * 32; i += NGT) { const int s = i >> 5, k = i & 31, t = k & 15;
        const float ang = (float)((t < 8) ? (s >> 6) : (s & 63)) * __builtin_amdgcn_exp2f(-(float)(t & 7) * (13.287712379549449f / 8.0f));
        T[i] = (k < 16) ? __cosf(ang) : __sinf(ang); }
}
__device__ __forceinline__ void convert_moe(const Ctx& F, const Args& a, int li) {
    LAS float* scr = (LAS float*)(F.lds + RING_OFF + F.wave * 16384);
    const int gw = F.vcu * NWAVES + F.wave, NGW = F.G * NWAVES;
    int it = gw, base = 0;
    for (int m = 0; m < 24; ++m) { const MatDesc d = moe_desc(a, (unsigned char*)F.ws, li, m); const int items = (d.K / 64) * (d.N / 32);
        for (; it < base + items; it += NGW) { if (d.f8) tr_item8(d.W, d.K, d.N, (unsigned char*)d.WT, d.il, d.off, scr, it - base, F.lane); else tr_item(d.W, d.K, d.N, d.WT, d.il, d.off, scr, it - base, F.lane); }
        base += items; }
}
__device__ __forceinline__ void adaln_phase(const Ctx& F, const Args& a) {
    LAS float* sc = (LAS float*)(F.lds + 65536);
    LAS float* red = (LAS float*)(F.lds + 65536 + 20480);
    __syncthreads();
    for (int idx = F.tid; idx < 5 * 1024; idx += NWAVES * 64) { const int r = idx >> 10, k = idx & 1023; const float v = (r < 4) ? a.in[I_C][r * 1024 + k] : a.in[I_CCTX][k];
        sc[idx] = v / (1.0f + __expf(-v)); }
    __syncthreads();
    float* MOD = (float*)(F.ws + WS_MOD);
    for (int task = F.bx; task < 4 * 96; task += F.G) { const int layer = task / 96, n0 = (task - layer * 96) * 64;
        const float* W = a.in[I_ADAW] + (size_t)layer * 1024 * 6144 + n0 + F.lane;
        float a0 = 0.f, a1 = 0.f, a2 = 0.f, a3 = 0.f, a4 = 0.f;
        for (int kb = F.wave * 128; kb < F.wave * 128 + 128; kb += 32) { float wv[32];
#pragma unroll
            for (int i = 0; i < 32; ++i) wv[i] = W[(size_t)(kb + i) * 6144];
#pragma unroll
            for (int i = 0; i < 32; ++i) { const float w = wv[i]; const int k = kb + i;
                a0 += sc[k] * w; a1 += sc[1024 + k] * w; a2 += sc[2048 + k] * w; a3 += sc[3072 + k] * w; a4 += sc[4096 + k] * w; } }
        red[(F.wave * 5 + 0) * 64 + F.lane] = a0; red[(F.wave * 5 + 1) * 64 + F.lane] = a1; red[(F.wave * 5 + 2) * 64 + F.lane] = a2; red[(F.wave * 5 + 3) * 64 + F.lane] = a3; red[(F.wave * 5 + 4) * 64 + F.lane] = a4;
        __syncthreads();
        if (F.wave < 5) { float s = a.in[I_ADAB][layer * 6144 + n0 + F.lane];
#pragma unroll
            for (int w = 0; w < 8; ++w) s += red[(w * 5 + F.wave) * 64 + F.lane];
            MOD[(size_t)(layer * 5 + F.wave) * 6144 + n0 + F.lane] = s; }
        __syncthreads();
    }
}

__device__ __forceinline__ float row_rstd(const f32x4 (&v)[4]) {
    float s = 0.f;
#pragma unroll
    for (int j = 0; j < 4; ++j) s += (v[j][0] * v[j][0] + v[j][1] * v[j][1]) + (v[j][2] * v[j][2] + v[j][3] * v[j][3]);
    return 1.0f / sqrtf(wave_sum(s) * (1.0f / 1024.0f) + EPS);
}
__device__ __forceinline__ void store_mod_row(const f32x4 (&v)[4], float rstd, const float* shift, const float* scale, bf16* hrow, int lane) {
#pragma unroll
    for (int j = 0; j < 4; ++j) { const f32x4 sc = *((const f32x4*)scale + lane + 64 * j), sh = *((const f32x4*)shift + lane + 64 * j);
        const f32x4 h = v[j] * rstd * (sc + 1.0f) + sh; v2u o; o.x = pk2(h[0], h[1]); o.y = pk2(h[2], h[3]);
        *((v2u*)hrow + lane + 64 * j) = o; }
}
__device__ __forceinline__ void store_mod_row8(const f32x4 (&v)[4], float rstd, const float* shift, const float* scale, unsigned char* hrow, int lane) {
#pragma unroll
    for (int j = 0; j < 4; ++j) { const f32x4 sc = *((const f32x4*)scale + lane + 64 * j), sh = *((const f32x4*)shift + lane + 64 * j);
        const f32x4 h = v[j] * rstd * (sc + 1.0f) + sh; *((unsigned*)hrow + lane + 64 * j) = pg8::pk4_fp8(h[0], h[1], h[2], h[3]); }
}
struct ModVec { f32x4 sc[4], sh[4]; };
__device__ __forceinline__ void modvec_load(ModVec& m, const float* shift, const float* scale, int lane) {
#pragma unroll
    for (int j = 0; j < 4; ++j) { m.sc[j] = *((const f32x4*)scale + lane + 64 * j) + 1.0f; m.sh[j] = *((const f32x4*)shift + lane + 64 * j); }
}
__device__ __forceinline__ void store_mod_row_v(const f32x4 (&v)[4], float rstd, const ModVec& m, bf16* hrow, int lane) {
#pragma unroll
    for (int j = 0; j < 4; ++j) { const f32x4 h = v[j] * rstd * m.sc[j] + m.sh[j]; v2u o; o.x = pk2(h[0], h[1]); o.y = pk2(h[2], h[3]); *((v2u*)hrow + lane + 64 * j) = o; }
}
__device__ __forceinline__ void store_mod_row8_v(const f32x4 (&v)[4], float rstd, const ModVec& m, unsigned char* hrow, int lane) {
#pragma unroll
    for (int j = 0; j < 4; ++j) { const f32x4 h = v[j] * rstd * m.sc[j] + m.sh[j]; *((unsigned*)hrow + lane + 64 * j) = pg8::pk4_fp8(h[0], h[1], h[2], h[3]); }
}
__device__ __forceinline__ void nm_phase(const Ctx& F, const Args& a, bool first, const float* modl, int shift_off, int scale_off, bool out8 = false) {
    const int gw = F.vcu * NWAVES + F.wave, NGW = F.G * NWAVES;
    const int rpw = (M + NGW - 1) / NGW, rbeg = gw * rpw, rend = (rbeg + rpw < M) ? rbeg + rpw : M;
    xs_t* XS = (xs_t*)(F.ws + WS_XS); bf16* H = (bf16*)(F.ws + WS_BIG + B_H);
    ModVec mv; int cur_mr = -1;
    if (first) {
        f32x4 nx[4];
#define NM_SRC(row_) ({ const int b_ = (row_) / ROWS_B, j_ = (row_) - b_ * ROWS_B; (j_ < CTXL) ? a.in[I_CTX] + (size_t)(b_ * CTXL + j_) * D : a.in[I_X] + (size_t)(b_ * SEQ + j_ - CTXL) * D; })
        if (rbeg < rend) { const float* s0 = NM_SRC(rbeg);
#pragma unroll
            for (int q = 0; q < 4; ++q) nx[q] = *((const f32x4*)s0 + F.lane + 64 * q); }
        for (int row = rbeg; row < rend; ++row) { const int mr = modrow_of_row(row);
            if (mr != cur_mr) { modvec_load(mv, modl + (size_t)mr * 6144 + shift_off, modl + (size_t)mr * 6144 + scale_off, F.lane); cur_mr = mr; }
            f32x4 v[4];
#pragma unroll
            for (int q = 0; q < 4; ++q) v[q] = nx[q];
            if (row + 1 < rend) { const float* s1 = NM_SRC(row + 1);
#pragma unroll
                for (int q = 0; q < 4; ++q) nx[q] = *((const f32x4*)s1 + F.lane + 64 * q); }
#pragma unroll
            for (int q = 0; q < 4; ++q) xs_st(XS, row, F.lane, q, v[q]);
            const float rstd = row_rstd(v);
            store_mod_row_v(v, rstd, mv, H + (size_t)row * D, F.lane);
        }
#undef NM_SRC
    } else {
        v2u nx[4], ny[4];
        if (rbeg < rend) {
#pragma unroll
            for (int q = 0; q < 4; ++q) nx[q] = xs_ld(XS, rbeg, F.lane, q); }
        if (rbeg + 1 < rend) {
#pragma unroll
            for (int q = 0; q < 4; ++q) ny[q] = xs_ld(XS, rbeg + 1, F.lane, q); }
        for (int row = rbeg; row < rend; ++row) { const int mr = modrow_of_row(row);
            if (mr != cur_mr) { modvec_load(mv, modl + (size_t)mr * 6144 + shift_off, modl + (size_t)mr * 6144 + scale_off, F.lane); cur_mr = mr; }
            f32x4 v[4];
#pragma unroll
            for (int q = 0; q < 4; ++q) { v[q] = xs_cvt(nx[q]); nx[q] = ny[q]; }
            if (row + 2 < rend) {
#pragma unroll
                for (int q = 0; q < 4; ++q) ny[q] = xs_ld(XS, row + 2, F.lane, q); }
            const float rstd = row_rstd(v);
            if (out8) store_mod_row8_v(v, rstd, mv, (unsigned char*)H + (size_t)row * D, F.lane);
            else store_mod_row_v(v, rstd, mv, H + (size_t)row * D, F.lane);
        }
    }
}

#ifndef AB_REP3
#define AB_REP3 1
#endif
#ifndef AB_REP4
#define AB_REP4 1
#endif
#ifndef AB_REP5
#define AB_REP5 1
#endif
__device__ __forceinline__ void abmid_unit(const Ctx& F, int c, int g, const bf16* Z, bf16* Y, const bf16* Wsb, const bf16* WpT, const float* vgain, const float* bsv, const float* pscale, int& cur_g) {
    typedef float f32x4v __attribute__((ext_vector_type(4)));
    const int r0 = c * 128, tid = F.tid, lane = F.lane, wave = F.wave;
    const int b = r0 / ROWS_B, j0 = r0 - b * ROWS_B;
    const int S0 = (j0 < CTXL) ? b * ROWS_B : b * ROWS_B + CTXL, S1 = (j0 < CTXL) ? b * ROWS_B + CTXL : (b + 1) * ROWS_B;
    LAS float* rstd = (LAS float*)F.lds;
    LAS unsigned short* T = (LAS unsigned short*)(F.lds + 1024);
    LAS unsigned short* P = (LAS unsigned short*)(F.lds + 1024 + 144 * 256);
    LAS unsigned char* WSL = F.lds + 1024 + 144 * 256 + 128 * 272;
    __syncthreads();
    const int fr = lane & 15, fq = lane >> 4;
    if (g != cur_g) { cur_g = g;
#pragma unroll
        for (int i = 0; i < 4; ++i) { const int p = tid + i * (NWAVES * 64), row = p >> 4, ch = p & 15;
            *(LAS v4u*)(WSL + row * 272 + ch * 16) = *(const v4u*)(Wsb + (size_t)(g * 128 + row) * 128 + ch * 8); }
    }
    v4u xr[16], xs[5]; unsigned short gv[32]; bf16x8 afp[4]; v2u uur[8]; float biasr[8];
#pragma unroll
    for (int rr = 0; rr < 16; ++rr) xr[rr] = *(const v4u*)(Z + (size_t)(r0 + 16 * wave + rr) * AB_IN + 512 + lane * 8);
#pragma unroll
    for (int i = 0; i < 5; ++i) { const int p = tid + i * (NWAVES * 64), lr = p >> 4, ch = p & 15, R = r0 - 8 + lr; xs[i] = (v4u){0u, 0u, 0u, 0u};
        if (p < 144 * 16 && R >= S0 && R < S1) xs[i] = *(const v4u*)(Z + (size_t)R * AB_IN + 1024 + 128 * g + ch * 8); }
    const int dcol = 128 * g + 16 * wave + fr;
#pragma unroll
    for (int ks = 0; ks < 4; ++ks)
#pragma unroll
        for (int jj = 0; jj < 8; ++jj) gv[ks * 8 + jj] = Z[(size_t)(r0 + 32 * ks + 8 * fq + jj) * AB_IN + 512 + dcol];
#pragma unroll
    for (int pb = 0; pb < 8; ++pb) { uur[pb] = *(const v2u*)(Z + (size_t)(r0 + 16 * pb + fr) * AB_IN + 128 * g + 16 * wave + 4 * fq); biasr[pb] = bsv[g * 128 + 16 * pb + fr]; }
#pragma unroll
    for (int ks = 0; ks < 4; ++ks) afp[ks] = *(const bf16x8*)(WpT + (size_t)(g * 128 + 16 * wave + fr) * 128 + 32 * ks + 8 * fq);
    { float mine = 0.f;
#pragma unroll
        for (int rr = 0; rr < 16; ++rr) { const v4u x = xr[rr];
            float s = bf_lo(x.x) * bf_lo(x.x) + bf_hi(x.x) * bf_hi(x.x) + bf_lo(x.y) * bf_lo(x.y) + bf_hi(x.y) * bf_hi(x.y) + bf_lo(x.z) * bf_lo(x.z) + bf_hi(x.z) * bf_hi(x.z) + bf_lo(x.w) * bf_lo(x.w) + bf_hi(x.w) * bf_hi(x.w);
            s = wave_sum(s); if (lane == rr) mine = s; }
        if (lane < 16) rstd[16 * wave + lane] = 1.0f / sqrtf(mine * (1.0f / 512.0f) + EPS); }
#pragma unroll
    for (int i = 0; i < 5; ++i) { const int p = tid + i * (NWAVES * 64), lr = p >> 4, ch = p & 15;
        if (p < 144 * 16) *(LAS v4u*)((LAS unsigned char*)T + lr * 256 + ch * 16) = xs[i]; }
    __syncthreads();
    for (int rep3_ = 0; rep3_ < AB_REP3; ++rep3_)
    { const int i = tid & 127, rq = tid >> 7, w = 2 << g, half = w >> 1, l0 = 32 * rq;
        float s = 0.f;
        for (int t = 0; t < w; ++t) s += bf1(T[(l0 + 8 - half + t) * 128 + i]);
#pragma unroll 8
        for (int l = l0; l < l0 + 32; ++l) { const int R = r0 + l; int lo = R - half, hi = R - half + w; lo = lo < S0 ? S0 : lo; hi = hi > S1 ? S1 : hi;
            const float mean = s * __builtin_amdgcn_rcpf((float)(hi - lo)); const float pv = mean - bf1(T[(l + 8) * 128 + i]);
            P[l * 136 + i] = (unsigned short)(pk2(pv, 0.f) & 0xffffu);
            s += bf1(T[(l + 8 - half + w) * 128 + i]) - bf1(T[(l + 8 - half) * 128 + i]); } }
    __syncthreads();
    for (int rep4_ = 0; rep4_ < AB_REP4; ++rep4_)
    { const f32x4v psc = *(const f32x4v*)(pscale + 128 * g + 16 * wave + 4 * fq);
#pragma unroll 2
        for (int lb = 0; lb < 8; ++lb) { pg8::f32x4 acc = {0.f, 0.f, 0.f, 0.f};
#pragma unroll
            for (int ks = 0; ks < 4; ++ks) { const bf16x8 bfr = *(const LAS bf16x8*)((LAS unsigned char*)P + (16 * lb + fr) * 272 + (32 * ks + 8 * fq) * 2);
                acc = __builtin_amdgcn_mfma_f32_16x16x32_bf16(afp[ks], bfr, acc, 0, 0, 0); }
            v2u o; o.x = pk2(acc[0] * psc[0], acc[1] * psc[1]); o.y = pk2(acc[2] * psc[2], acc[3] * psc[3]);
            *(v2u*)(Y + (size_t)(r0 + 16 * lb + fr) * 1024 + 512 + 128 * g + 16 * wave + 4 * fq) = o; } }
    for (int rep5_ = 0; rep5_ < AB_REP5; ++rep5_)
    { bf16x8 af[4]; const float gn = vgain[dcol];
#pragma unroll
        for (int ks = 0; ks < 4; ++ks) { float t[8];
#pragma unroll
            for (int jj = 0; jj < 8; ++jj) { const int q = 32 * ks + 8 * fq + jj; t[jj] = bf1(gv[ks * 8 + jj]) * rstd[q] * gn; }
            v4u w; w.x = pk2(t[0], t[1]); w.y = pk2(t[2], t[3]); w.z = pk2(t[4], t[5]); w.w = pk2(t[6], t[7]); af[ks] = __builtin_bit_cast(bf16x8, w); }
#pragma unroll
        for (int pb = 0; pb < 8; ++pb) { pg8::f32x4 acc = {0.f, 0.f, 0.f, 0.f};
#pragma unroll
            for (int ks = 0; ks < 4; ++ks) { const bf16x8 bfr = *(const LAS bf16x8*)(WSL + (16 * pb + fr) * 272 + (32 * ks + 8 * fq) * 2);
                acc = __builtin_amdgcn_mfma_f32_16x16x32_bf16(af[ks], bfr, acc, 0, 0, 0); }
            const int prow = 16 * pb + fr; const float bias = biasr[pb];
            const v2u uu = uur[pb];
            v2u o; o.x = pk2(bf_lo(uu.x) * (acc[0] + bias), bf_hi(uu.x) * (acc[1] + bias)); o.y = pk2(bf_lo(uu.y) * (acc[2] + bias), bf_hi(uu.y) * (acc[3] + bias));
            *(v2u*)(Y + (size_t)(r0 + prow) * 1024 + 128 * g + 16 * wave + 4 * fq) = o; } }
}

__device__ __forceinline__ void unpack8(const v4u x, float (&f)[8]) { f[0] = bf_lo(x.x); f[1] = bf_hi(x.x); f[2] = bf_lo(x.y); f[3] = bf_hi(x.y); f[4] = bf_lo(x.z); f[5] = bf_hi(x.z); f[6] = bf_lo(x.w); f[7] = bf_hi(x.w); }
__device__ __forceinline__ v4u pack8(const float (&f)[8]) { v4u o; o.x = pk2(f[0], f[1]); o.y = pk2(f[2], f[3]); o.z = pk2(f[4], f[5]); o.w = pk2(f[6], f[7]); return o; }
__device__ __forceinline__ void head_norm_rope(float (&f)[8], int sub, const float (&gain)[8], bool rope, float grow, float gcol, float oscale) {
    float s = 0.f;
#pragma unroll
    for (int j = 0; j < 8; ++j) s += f[j] * f[j];
    s += __shfl_xor(s, 1); s += __shfl_xor(s, 2); s += __shfl_xor(s, 4);
    const float r = 1.0f / sqrtf(s * (1.0f / 64.0f) + EPS);
#pragma unroll
    for (int j = 0; j < 8; ++j) f[j] = f[j] * r * gain[j];
    float o[8];
#pragma unroll
    for (int j = 0; j < 8; ++j) o[j] = __shfl_xor(f[j], 4);
    if (rope) {
#pragma unroll
        for (int j = 0; j < 8; ++j) { const int dp = (sub & 3) * 8 + j;
            const float ang = ((dp < 16) ? grow : gcol) * __builtin_amdgcn_exp2f(-(float)(dp & 15) * (13.287712379549449f / 16.0f));
            const float cs = __cosf(ang), sn = __sinf(ang);
            f[j] = (sub < 4) ? (f[j] * cs - o[j] * sn) : (o[j] * sn + f[j] * cs); }
    }
#pragma unroll
    for (int j = 0; j < 8; ++j) f[j] *= oscale;
}
__device__ __forceinline__ void cdmid_phase(const Ctx& F, const Args& a, int li) {
    const int gw = F.vcu * NWAVES + F.wave, NGW = F.G * NWAVES, lane = F.lane;
    GAS unsigned char* big = F.ws + WS_BIG;
    const bf16* Z = (const bf16*)(big + B_Z); bf16* QC = (bf16*)(big + B_QC); bf16* KC = (bf16*)(big + B_KC); bf16* CQN = (bf16*)(big + B_CQN); bf16* CKVN = (bf16*)(big + B_CKVN); unsigned char* KD8 = (unsigned char*)(big + B_KD); unsigned char* QD8 = (unsigned char*)(big + B_QD); unsigned char* QC8 = (unsigned char*)(big + B_QC8); unsigned char* KC8 = (unsigned char*)(big + B_KC8);
    const float* qg = a.in[I_CQGAIN] + li * 64; const float* kg = a.in[I_CKGAIN] + li * 64; const float* cqg = a.in[I_DCQGAIN] + li * 384; const float* ckvg = a.in[I_DCKVGAIN] + li * 256;
    float qgv[8], kgv[8], cq1[8], cq2[8], ckv[8];
    { const int c1 = (lane >= 32) ? (lane - 32) * 8 : 0, c2 = (lane < 16) ? 256 + lane * 8 : 0, c3 = (lane >= 16 && lane < 48) ? (lane - 16) * 8 : 0;
#pragma unroll
        for (int t = 0; t < 8; ++t) { qgv[t] = qg[(lane & 7) * 8 + t]; kgv[t] = kg[(lane & 7) * 8 + t]; cq1[t] = cqg[c1 + t]; cq2[t] = cqg[c2 + t]; ckv[t] = ckvg[c3 + t]; } }
    v4u nx0 = (v4u){0u, 0u, 0u, 0u}, nx1 = nx0, nx2 = nx0;
    if (gw < M) { const bf16* zn = Z + (size_t)gw * CD_INP; nx0 = *(const v4u*)(zn + lane * 8); nx1 = *(const v4u*)(zn + (64 + lane) * 8); nx2 = *(const v4u*)(zn + (128 + lane) * 8); }
    for (int row = gw; row < M; row += NGW) { const int b = row / ROWS_B, j = row - b * ROWS_B; const bool latent = j >= CTXL; const int s = j - CTXL;
        const float grow = (float)(s >> 6), gcol = (float)(s & 63);
        const v4u x0 = nx0, x1 = nx1, x2 = nx2;
        if (row + NGW < M) { const bf16* zn = Z + (size_t)(row + NGW) * CD_INP; nx0 = *(const v4u*)(zn + lane * 8); nx1 = *(const v4u*)(zn + (64 + lane) * 8); nx2 = *(const v4u*)(zn + (128 + lane) * 8); }
        float f0[8], f1[8], f2[8]; unpack8(x0, f0); unpack8(x1, f1); unpack8(x2, f2);
        head_norm_rope(f0, lane & 7, qgv, latent, grow, gcol, 0.125f * 1.4426950408889634f);
        *(v4u*)(QC + (size_t)row * 512 + lane * 8) = pack8(f0);
        { v2u q8; q8.x = pg8::pk4_fp8(f0[0], f0[1], f0[2], f0[3]); q8.y = pg8::pk4_fp8(f0[4], f0[5], f0[6], f0[7]); *(v2u*)(QC8 + (size_t)row * 512 + lane * 8) = q8; }
        float ssq = 0.f, sskv = 0.f;
        if (lane >= 32) {
#pragma unroll
            for (int t = 0; t < 8; ++t) ssq += f1[t] * f1[t]; }
        if (lane < 16) {
#pragma unroll
            for (int t = 0; t < 8; ++t) ssq += f2[t] * f2[t]; }
        else if (lane < 48) {
#pragma unroll
            for (int t = 0; t < 8; ++t) sskv += f2[t] * f2[t]; }
        { float fk[8];
#pragma unroll
            for (int t = 0; t < 8; ++t) fk[t] = f1[t];
            head_norm_rope(fk, lane & 7, kgv, latent, grow, gcol, 1.0f);
            if (lane < 16) { *(v4u*)(KC + (size_t)row * 128 + lane * 8) = pack8(fk); v2u k8; k8.x = pg8::pk4_fp8(fk[0], fk[1], fk[2], fk[3]); k8.y = pg8::pk4_fp8(fk[4], fk[5], fk[6], fk[7]); *(v2u*)(KC8 + (size_t)row * 128 + lane * 8) = k8; } }
        ssq = wave_sum(ssq); sskv = wave_sum(sskv);
        const float rq = 1.0f / sqrtf(ssq * (1.0f / 384.0f) + EPS), rkv = 1.0f / sqrtf(sskv * (1.0f / 256.0f) + EPS);
        if (lane >= 32) { float o[8]; const int c0 = (lane - 32) * 8;
#pragma unroll
            for (int t = 0; t < 8; ++t) o[t] = f1[t] * rq * cq1[t];
            *(v4u*)(CQN + (size_t)row * 384 + c0) = pack8(o); }
        if (lane < 16) { float o[8]; const int c0 = 256 + lane * 8;
#pragma unroll
            for (int t = 0; t < 8; ++t) o[t] = f2[t] * rq * cq2[t];
            *(v4u*)(CQN + (size_t)row * 384 + c0) = pack8(o); }
        else if (lane < 48) { float o[8]; const int c0 = (lane - 16) * 8;
#pragma unroll
            for (int t = 0; t < 8; ++t) o[t] = f2[t] * rkv * ckv[t];
            *(v4u*)(CKVN + (size_t)row * 256 + c0) = pack8(o); }
        { float o[8];
#pragma unroll
            for (int t = 0; t < 8; ++t) o[t] = __shfl_xor(f2[t], 2);
            if (lane >= 48 && lane < 52) { const int sub = lane - 48;
                if (latent) {
#pragma unroll
                    for (int t = 0; t < 8; ++t) { const int dp = (sub & 1) * 8 + t; const float ang = ((dp < 8) ? grow : gcol) * __builtin_amdgcn_exp2f(-(float)(dp & 7) * (13.287712379549449f / 8.0f));
                        const float cs = __cosf(ang), sn = __sinf(ang);
                        f2[t] = (sub < 2) ? (f2[t] * cs - o[t] * sn) : (o[t] * sn + f2[t] * cs); } }
                v2u w8; w8.x = pg8::pk4_fp8(f2[0], f2[1], f2[2], f2[3]); w8.y = pg8::pk4_fp8(f2[4], f2[5], f2[6], f2[7]);
#pragma unroll
                for (int h = 0; h < 8; ++h) *(v2u*)(KD8 + (size_t)row * 1024 + 128 * h + 64 + sub * 8) = w8; }
            if (lane < 16) { const v4u z = (v4u){0u, 0u, 0u, 0u};
                *(v4u*)(KD8 + (size_t)row * 1024 + 128 * (lane >> 1) + 96 + 16 * (lane & 1)) = z; *(v4u*)(QD8 + (size_t)row * 1024 + 128 * (lane >> 1) + 96 + 16 * (lane & 1)) = z; } }
    }
}

constexpr int RPB_MAX = 1056;
__device__ __forceinline__ void route_phase(const Ctx& F, const Args& a, int li, const float* modl) {
    LAS float* R = (LAS float*)F.lds;
    LAS unsigned* cnt = (LAS unsigned*)(F.lds + 40960);
    const float* rw = a.in[I_ROUTER] + (size_t)li * 1024 * 8;
    __syncthreads();
    for (int i = F.tid; i < 1024 * 8 / 4; i += NWAVES * 64) { const int c = i >> 1, hf = i & 1; *((LAS f32x4*)(R + (c >> 2) * 36 + (c & 3) * 8 + hf * 4)) = *((const f32x4*)rw + i); }
    if (F.tid < 8) cnt[F.tid] = 0u;
    __syncthreads();
    const int rpb = (M + F.G - 1) / F.G, rbeg = F.bx * rpb, rend = (rbeg + rpb < M) ? rbeg + rpb : M;
    const xs_t* XS = (const xs_t*)(F.ws + WS_XS); v4u* TOPK = (v4u*)(F.ws + WS_TOPK);
    v2u nx[4], ny[4];
    if (rbeg + F.wave < rend) {
#pragma unroll
        for (int q = 0; q < 4; ++q) nx[q] = xs_ld(XS, rbeg + F.wave, F.lane, q); }
    if (rbeg + F.wave + NWAVES < rend) {
#pragma unroll
        for (int q = 0; q < 4; ++q) ny[q] = xs_ld(XS, rbeg + F.wave + NWAVES, F.lane, q); }
    ModVec mv; int cur_mr = -1;
    for (int row = rbeg + F.wave; row < rend; row += NWAVES) { const int mr = modrow_of_row(row);
        if (mr != cur_mr) { modvec_load(mv, modl + (size_t)mr * 6144 + 3 * 1024, modl + (size_t)mr * 6144 + 4 * 1024, F.lane); cur_mr = mr; }
        f32x4 v[4];
#pragma unroll
        for (int q = 0; q < 4; ++q) { v[q] = xs_cvt(nx[q]); nx[q] = ny[q]; }
        if (row + 2 * NWAVES < rend) {
#pragma unroll
            for (int q = 0; q < 4; ++q) ny[q] = xs_ld(XS, row + 2 * NWAVES, F.lane, q); }
        const float rstd = row_rstd(v);
        float lg[8] = {0.f, 0.f, 0.f, 0.f, 0.f, 0.f, 0.f, 0.f};
#pragma unroll
        for (int q = 0; q < 4; ++q) { const f32x4 h = v[q] * rstd * mv.sc[q] + mv.sh[q];
#pragma unroll
            for (int t = 0; t < 4; ++t) { const LAS float* rp = R + (F.lane + 64 * q) * 36 + t * 8; const f32x4 r0 = *((const LAS f32x4*)rp), r1 = *((const LAS f32x4*)(rp + 4));
                lg[0] += h[t] * r0[0]; lg[1] += h[t] * r0[1]; lg[2] += h[t] * r0[2]; lg[3] += h[t] * r0[3]; lg[4] += h[t] * r1[0]; lg[5] += h[t] * r1[1]; lg[6] += h[t] * r1[2]; lg[7] += h[t] * r1[3]; } }
        { float t4[4], t2[2], t1;
#pragma unroll
            for (int i = 0; i < 4; ++i) { const float keep = (F.lane & 1) ? lg[4 + i] : lg[i], send = (F.lane & 1) ? lg[i] : lg[4 + i]; t4[i] = keep + __shfl_xor(send, 1); }
#pragma unroll
            for (int i = 0; i < 2; ++i) { const float keep = (F.lane & 2) ? t4[2 + i] : t4[i], send = (F.lane & 2) ? t4[i] : t4[2 + i]; t2[i] = keep + __shfl_xor(send, 2); }
            { const float keep = (F.lane & 4) ? t2[1] : t2[0], send = (F.lane & 4) ? t2[0] : t2[1]; t1 = keep + __shfl_xor(send, 4); }
            t1 += __shfl_xor(t1, 8); t1 += __shfl_xor(t1, 16); t1 += __shfl_xor(t1, 32);
#pragma unroll
            for (int e = 0; e < 8; ++e) lg[e] = __int_as_float(__builtin_amdgcn_readlane(__float_as_int(t1), (e >> 2) | (((e >> 1) & 1) << 1) | ((e & 1) << 2))); }
        int i0 = 0; float v0 = lg[0];
#pragma unroll
        for (int e = 1; e < 8; ++e) if (lg[e] > v0) { v0 = lg[e]; i0 = e; }
        int i1 = -1; float v1 = -3.0e38f;
#pragma unroll
        for (int e = 0; e < 8; ++e) if (e != i0 && (i1 < 0 || lg[e] > v1)) { v1 = lg[e]; i1 = e; }
        const float w0 = 1.0f / (1.0f + __expf(v1 - v0)), w1 = 1.0f - w0;
        if (F.lane == 0) { TOPK[row] = (v4u){(unsigned)i0, (unsigned)i1, __float_as_uint(w0), __float_as_uint(w1)}; __hip_atomic_fetch_add((unsigned*)&cnt[i0], 1u, __ATOMIC_RELAXED, __HIP_MEMORY_SCOPE_WORKGROUP); __hip_atomic_fetch_add((unsigned*)&cnt[i1], 1u, __ATOMIC_RELAXED, __HIP_MEMORY_SCOPE_WORKGROUP); }
    }
    __syncthreads();
    if (F.tid < 8) __hip_atomic_store((unsigned*)(F.ws + WS_CNT) + F.bx * 8 + F.tid, cnt[F.tid], __ATOMIC_RELAXED, __HIP_MEMORY_SCOPE_AGENT);
}
__device__ __forceinline__ void slots_phase(const Ctx& F, const Args& a, const float* modl) {
    LAS unsigned* tot = (LAS unsigned*)F.lds;
    LAS unsigned* e01 = (LAS unsigned*)(F.lds + 256);
    LAS unsigned* sl0 = e01 + RPB_MAX; LAS unsigned* sl1 = sl0 + RPB_MAX;
    const int rpb = (M + F.G - 1) / F.G, rbeg = F.bx * rpb, rend = (rbeg + rpb < M) ? rbeg + rpb : M, nr = rend > rbeg ? rend - rbeg : 0;
    const unsigned* CNT = (const unsigned*)(F.ws + WS_CNT); const v4u* TOPK = (const v4u*)(F.ws + WS_TOPK); unsigned* PEXP = (unsigned*)(F.ws + WS_PEXP);
    __syncthreads();
    LAS unsigned* cl = sl1 + RPB_MAX;
    for (int i = F.tid; i < F.G * 8; i += NWAVES * 64) cl[i] = __hip_atomic_load(CNT + i, __ATOMIC_RELAXED, __HIP_MEMORY_SCOPE_AGENT);
    for (int r = F.tid; r < nr; r += NWAVES * 64) { const v4u tk = TOPK[rbeg + r]; e01[r] = tk.x | (tk.y << 8); }
    __syncthreads();
    if (F.tid < 8) { unsigned t = 0u, pre = 0u;
        for (int g = 0; g < F.G; ++g) { const unsigned cv = cl[g * 8 + F.tid]; t += cv; if (g < F.bx) pre += cv; }
        tot[F.tid] = t; tot[8 + F.tid] = pre; }
    __syncthreads();
    if (F.tid == 0) { unsigned pb = 0u;
        for (int e = 0; e < 8; ++e) { const unsigned np = (tot[e] + 255u) >> 8; tot[16 + e] = pb * 256u + tot[8 + e];
            if (F.bx == 0) for (unsigned p = 0; p < np; ++p) __hip_atomic_store(PEXP + pb + p, (unsigned)e, __ATOMIC_RELAXED, __HIP_MEMORY_SCOPE_AGENT);
            pb += np; }
        if (F.bx == 0) __hip_atomic_store(PEXP + 511, pb, __ATOMIC_RELAXED, __HIP_MEMORY_SCOPE_AGENT); }
    __syncthreads();
    if (F.tid < 8) { unsigned c = tot[16 + F.tid]; const unsigned e = (unsigned)F.tid;
        for (int r = 0; r < nr; ++r) { const unsigned w = e01[r]; if ((w & 0xffu) == e) sl0[r] = c++; else if ((w >> 8) == e) sl1[r] = c++; } }
    __syncthreads();
    const xs_t* XS = (const xs_t*)(F.ws + WS_XS); bf16* HS = (bf16*)(F.ws + WS_BIG + B_HS); v2u* TOKSLOT = (v2u*)(F.ws + WS_TOKSLOT);
    v2u nx[4], ny[4];
    if (F.wave < nr) {
#pragma unroll
        for (int q = 0; q < 4; ++q) nx[q] = xs_ld(XS, rbeg + F.wave, F.lane, q); }
    if (F.wave + NWAVES < nr) {
#pragma unroll
        for (int q = 0; q < 4; ++q) ny[q] = xs_ld(XS, rbeg + F.wave + NWAVES, F.lane, q); }
    ModVec mv; int cur_mr = -1;
    for (int r = F.wave; r < nr; r += NWAVES) { const int row = rbeg + r; const int mr = modrow_of_row(row);
        if (mr != cur_mr) { modvec_load(mv, modl + (size_t)mr * 6144 + 3 * 1024, modl + (size_t)mr * 6144 + 4 * 1024, F.lane); cur_mr = mr; }
        f32x4 v[4];
#pragma unroll
        for (int q = 0; q < 4; ++q) { v[q] = xs_cvt(nx[q]); nx[q] = ny[q]; }
        if (r + 2 * NWAVES < nr) {
#pragma unroll
            for (int q = 0; q < 4; ++q) ny[q] = xs_ld(XS, row + 2 * NWAVES, F.lane, q); }
        const float rstd = row_rstd(v); const unsigned s0 = sl0[r], s1 = sl1[r];
#pragma unroll
        for (int q = 0; q < 4; ++q) { const f32x4 h = v[q] * rstd * mv.sc[q] + mv.sh[q];
            if (FP8M) { const unsigned o8 = pg8::pk4_fp8(h[0], h[1], h[2], h[3]); *((unsigned*)((unsigned char*)HS + (size_t)s0 * D) + F.lane + 64 * q) = o8; *((unsigned*)((unsigned char*)HS + (size_t)s1 * D) + F.lane + 64 * q) = o8; }
            else { v2u o; o.x = pk2(h[0], h[1]); o.y = pk2(h[2], h[3]);
                *((v2u*)(HS + (size_t)s0 * D) + F.lane + 64 * q) = o; *((v2u*)(HS + (size_t)s1 * D) + F.lane + 64 * q) = o; } }
        if (F.lane == 0) TOKSLOT[row] = (v2u){s0, s1};
    }
}
__device__ __forceinline__ void combine_phase(const Ctx& F, const Args& a, const float* modl, bool final_layer, const float* modn, float gscale) {
    const int gw = F.vcu * NWAVES + F.wave, NGW = F.G * NWAVES;
    const int rpw = (M + NGW - 1) / NGW, rbeg = gw * rpw, rend = (rbeg + rpw < M) ? rbeg + rpw : M;
    xs_t* XS = (xs_t*)(F.ws + WS_XS); bf16* H = (bf16*)(F.ws + WS_BIG + B_H); const bf16* Y = (const bf16*)(F.ws + WS_BIG + B_HS);
    const v4u* TOPK = (const v4u*)(F.ws + WS_TOPK); const v2u* TOKSLOT = (const v2u*)(F.ws + WS_TOKSLOT);
    v2u nx[4]; v2u ny0[4], ny1[4]; v4u ntk = (v4u){0u, 0u, 0u, 0u}, ftk = ntk; v2u fts = (v2u){0u, 0u};
#define CB_DATA(row_, ts_) do { _Pragma("unroll") for (int q = 0; q < 4; ++q) { nx[q] = xs_ld(XS, (row_), F.lane, q); \
        ny0[q] = *((const v2u*)(Y + (size_t)(ts_).x * D) + F.lane + 64 * q); ny1[q] = *((const v2u*)(Y + (size_t)(ts_).y * D) + F.lane + 64 * q); } } while (0)
    if (rbeg < rend) { ntk = TOPK[rbeg]; const v2u ts0 = TOKSLOT[rbeg]; CB_DATA(rbeg, ts0); }
    if (rbeg + 1 < rend) { ftk = TOPK[rbeg + 1]; fts = TOKSLOT[rbeg + 1]; }
    ModVec mv; f32x4 gv[4], fg[4]; int cur_mr = -1;
    if (final_layer) {
#pragma unroll
        for (int q = 0; q < 4; ++q) fg[q] = *((const f32x4*)a.in[I_FGAIN] + F.lane + 64 * q); }
    for (int row = rbeg; row < rend; ++row) { const int b = row / ROWS_B, j = row - b * ROWS_B; const int mr = (j < CTXL) ? 4 : b;
        const v4u tk = ntk; f32x4 x[4]; v2u y0[4], y1[4];
#pragma unroll
        for (int q = 0; q < 4; ++q) { x[q] = xs_cvt(nx[q]); y0[q] = ny0[q]; y1[q] = ny1[q]; }
        if (row + 1 < rend) { ntk = ftk; const v2u ts1 = fts; CB_DATA(row + 1, ts1); }
        if (row + 2 < rend) { ftk = TOPK[row + 2]; fts = TOKSLOT[row + 2]; }
        if (final_layer && j < CTXL) continue;
        if (mr != cur_mr) { cur_mr = mr;
#pragma unroll
            for (int q = 0; q < 4; ++q) gv[q] = *((const f32x4*)(modl + (size_t)mr * 6144 + 5 * 1024) + F.lane + 64 * q) * gscale;
            if (!final_layer) modvec_load(mv, modn + (size_t)mr * 6144, modn + (size_t)mr * 6144 + 1024, F.lane); }
        const float w0 = __uint_as_float(tk.z), w1 = __uint_as_float(tk.w);
        f32x4 v[4];
#pragma unroll
        for (int q = 0; q < 4; ++q) {
            f32x4 y; y[0] = w0 * bf_lo(y0[q].x) + w1 * bf_lo(y1[q].x); y[1] = w0 * bf_hi(y0[q].x) + w1 * bf_hi(y1[q].x); y[2] = w0 * bf_lo(y0[q].y) + w1 * bf_lo(y1[q].y); y[3] = w0 * bf_hi(y0[q].y) + w1 * bf_hi(y1[q].y);
            v[q] = x[q] + gv[q] * y; }
        const float rstd = row_rstd(v);
        if (!final_layer) {
#pragma unroll
            for (int q = 0; q < 4; ++q) xs_st(XS, row, F.lane, q, v[q]);
            store_mod_row_v(v, rstd, mv, H + (size_t)row * D, F.lane);
        } else { float* orow = a.out + (size_t)(b * SEQ + j - CTXL) * D;
#pragma unroll
            for (int q = 0; q < 4; ++q) *((f32x4*)orow + F.lane + 64 * q) = v[q] * rstd * fg[q]; }
    }
#undef CB_DATA
}
template <bool F8, class E> __device__ __forceinline__ void ctx_gemm(const Ctx& F, const void* Av, const void* Btv, int Kb  , int N, const E& epi) {
    const int fr = F.lane & 15, fq = F.lane >> 4, ntn = N / 64, ntask = 16 * ntn, nks = Kb / 64;
    typedef const __attribute__((address_space(1))) bf16x8* gp8;
    const unsigned char* A = (const unsigned char*)Av; const unsigned char* Bt = (const unsigned char*)Btv;
    LAS pg8::f32x4* red = (LAS pg8::f32x4*)(F.lds + RING_OFF);
    for (int t = F.vcu; t < ntask; t += F.G) { const int rt = t / ntn, ct = t - rt * ntn; const int p = rt >> 2, rq = rt & 3;
        const int row0 = p * ROWS_B + rq * 64, col0 = ct * 64;
        const unsigned char* ap = A + (size_t)(row0 + fr) * Kb + 16 * fq; const unsigned char* bp = Bt + (size_t)(col0 + fr) * Kb + 16 * fq;
        pg8::f32x4 acc[4][4];
#pragma unroll
        for (int mb = 0; mb < 4; ++mb)
#pragma unroll
            for (int nb = 0; nb < 4; ++nb) acc[mb][nb] = (pg8::f32x4){0.f, 0.f, 0.f, 0.f};
#pragma unroll 2
        for (int s = F.wave; s < nks; s += NWAVES) { const int k = 64 * s; bf16x8 av[4], wv[4];
#pragma unroll
            for (int i = 0; i < 4; ++i) { av[i] = *(gp8)(ap + (size_t)(16 * i) * Kb + k); wv[i] = *(gp8)(bp + (size_t)(16 * i) * Kb + k); }
#pragma unroll
            for (int mb = 0; mb < 4; ++mb)
#pragma unroll
                for (int nb = 0; nb < 4; ++nb) {
                    if constexpr (F8) { typedef long l2_ __attribute__((ext_vector_type(2))); const l2_ b_ = __builtin_bit_cast(l2_, wv[nb]), a_ = __builtin_bit_cast(l2_, av[mb]);
                        acc[mb][nb] = __builtin_amdgcn_mfma_f32_16x16x32_fp8_fp8(b_[0], a_[0], acc[mb][nb], 0, 0, 0); acc[mb][nb] = __builtin_amdgcn_mfma_f32_16x16x32_fp8_fp8(b_[1], a_[1], acc[mb][nb], 0, 0, 0); }
                    else acc[mb][nb] = __builtin_amdgcn_mfma_f32_16x16x32_bf16(wv[nb], av[mb], acc[mb][nb], 0, 0, 0); } }
        __syncthreads();
#pragma unroll
        for (int mb = 0; mb < 4; ++mb)
#pragma unroll
            for (int nb = 0; nb < 4; ++nb) red[(F.wave * 16 + mb * 4 + nb) * 64 + F.lane] = acc[mb][nb];
        __syncthreads();
#pragma unroll
        for (int i = 0; i < 2; ++i) { const int tile = 2 * F.wave + i, mb = tile >> 2, nb = tile & 3; pg8::f32x4 v = red[tile * 64 + F.lane];
#pragma unroll
            for (int w = 1; w < 8; ++w) v = v + red[(w * 16 + tile) * 64 + F.lane];
            epi(row0 + 16 * mb + fr, col0 + 16 * nb + 4 * fq, v); }
    }
    __syncthreads();
}
template <bool F8, class E> __device__ __forceinline__ void ctx_gemm_gu(const Ctx& F, const void* Av, const void* Btv, int Kb, int NH  , const E& epi) {
    const int fr = F.lane & 15, fq = F.lane >> 4, ntn = NH / 64, ntask = 16 * ntn, nks = Kb / 64;
    typedef const __attribute__((address_space(1))) bf16x8* gp8;
    const unsigned char* A = (const unsigned char*)Av; const unsigned char* Bt = (const unsigned char*)Btv;
    LAS pg8::f32x4* red = (LAS pg8::f32x4*)(F.lds + RING_OFF);
    for (int t = F.vcu; t < ntask; t += F.G) { const int rt = t / ntn, ct = t - rt * ntn; const int p = rt >> 2, rq = rt & 3;
        const int row0 = p * ROWS_B + rq * 64, hc0 = ct * 64, brow = (hc0 >> 7) * 256 + (hc0 & 127);
        const unsigned char* ap = A + (size_t)(row0 + fr) * Kb + 16 * fq; const unsigned char* bp = Bt + (size_t)(brow + fr) * Kb + 16 * fq;
        pg8::f32x4 ag[4][4], au[4][4];
#pragma unroll
        for (int mb = 0; mb < 4; ++mb)
#pragma unroll
            for (int nb = 0; nb < 4; ++nb) { ag[mb][nb] = (pg8::f32x4){0.f, 0.f, 0.f, 0.f}; au[mb][nb] = (pg8::f32x4){0.f, 0.f, 0.f, 0.f}; }
        for (int s = F.wave; s < nks; s += NWAVES) { const int k = 64 * s; bf16x8 av[4], wg[4], wu[4];
#pragma unroll
            for (int i = 0; i < 4; ++i) { av[i] = *(gp8)(ap + (size_t)(16 * i) * Kb + k); wg[i] = *(gp8)(bp + (size_t)(16 * i) * Kb + k); wu[i] = *(gp8)(bp + (size_t)(128 + 16 * i) * Kb + k); }
#pragma unroll
            for (int mb = 0; mb < 4; ++mb)
#pragma unroll
                for (int nb = 0; nb < 4; ++nb) {
                    if constexpr (F8) { typedef long l2_ __attribute__((ext_vector_type(2))); const l2_ g_ = __builtin_bit_cast(l2_, wg[nb]), u_ = __builtin_bit_cast(l2_, wu[nb]), a_ = __builtin_bit_cast(l2_, av[mb]);
                        ag[mb][nb] = __builtin_amdgcn_mfma_f32_16x16x32_fp8_fp8(g_[0], a_[0], ag[mb][nb], 0, 0, 0); ag[mb][nb] = __builtin_amdgcn_mfma_f32_16x16x32_fp8_fp8(g_[1], a_[1], ag[mb][nb], 0, 0, 0);
                        au[mb][nb] = __builtin_amdgcn_mfma_f32_16x16x32_fp8_fp8(u_[0], a_[0], au[mb][nb], 0, 0, 0); au[mb][nb] = __builtin_amdgcn_mfma_f32_16x16x32_fp8_fp8(u_[1], a_[1], au[mb][nb], 0, 0, 0); }
                    else { ag[mb][nb] = __builtin_amdgcn_mfma_f32_16x16x32_bf16(wg[nb], av[mb], ag[mb][nb], 0, 0, 0); au[mb][nb] = __builtin_amdgcn_mfma_f32_16x16x32_bf16(wu[nb], av[mb], au[mb][nb], 0, 0, 0); } } }
        pg8::f32x4 vg[2], vu[2];
        __syncthreads();
#pragma unroll
        for (int mb = 0; mb < 4; ++mb)
#pragma unroll
            for (int nb = 0; nb < 4; ++nb) red[(F.wave * 16 + mb * 4 + nb) * 64 + F.lane] = ag[mb][nb];
        __syncthreads();
#pragma unroll
        for (int i = 0; i < 2; ++i) { const int tile = 2 * F.wave + i; pg8::f32x4 v = red[tile * 64 + F.lane];
#pragma unroll
            for (int w = 1; w < 8; ++w) v = v + red[(w * 16 + tile) * 64 + F.lane];
            vg[i] = v; }
        __syncthreads();
#pragma unroll
        for (int mb = 0; mb < 4; ++mb)
#pragma unroll
            for (int nb = 0; nb < 4; ++nb) red[(F.wave * 16 + mb * 4 + nb) * 64 + F.lane] = au[mb][nb];
        __syncthreads();
#pragma unroll
        for (int i = 0; i < 2; ++i) { const int tile = 2 * F.wave + i, mb = tile >> 2, nb = tile & 3; pg8::f32x4 v = red[tile * 64 + F.lane];
#pragma unroll
            for (int w = 1; w < 8; ++w) v = v + red[(w * 16 + tile) * 64 + F.lane];
            vu[i] = v; epi(row0 + 16 * mb + fr, hc0 + 16 * nb + 4 * fq, vg[i], vu[i]); }
    }
    __syncthreads();
}
struct CtxEpiSwiglu { void* O; int ldc; float iscale; bool out8;
    __device__ __forceinline__ void operator()(int row, int col, pg8::f32x4 g, pg8::f32x4 u) const {
        float h[4];
#pragma unroll
        for (int j = 0; j < 4; ++j) h[j] = pg8::silu_f(g[j] * iscale) * (u[j] * iscale);
        if (out8) *(unsigned*)((unsigned char*)O + (size_t)row * ldc + col) = pg8::pk4_fp8(h[0], h[1], h[2], h[3]);
        else { v2u o; o.x = pk2(h[0], h[1]); o.y = pk2(h[2], h[3]); *(v2u*)((bf16*)O + (size_t)row * ldc + col) = o; } } };
struct CtxEpiZ { bf16* O; int ldc; int gelu_cols;
    __device__ __forceinline__ void operator()(int row, int col, pg8::f32x4 v) const {
        if (col < gelu_cols) { const pg8::f32x2 a = pg8::gelu_pk((pg8::f32x2){v[0], v[1]}), b = pg8::gelu_pk((pg8::f32x2){v[2], v[3]}); v = (pg8::f32x4){a.x, a.y, b.x, b.y}; }
        v2u o; o.x = pk2(v[0], v[1]); o.y = pk2(v[2], v[3]); *(v2u*)(O + (size_t)row * ldc + col) = o; } };
struct CtxEpiResid { xs_t* X; const float* gate; float gscale;
    __device__ __forceinline__ void operator()(int row, int col, pg8::f32x4 v) const {
        xs_t* p = X + (size_t)row * D + col; const f32x4 g = *(const f32x4*)(gate + col) * gscale; f32x4 x = xs_cvt(*(const v2u*)p); x = x + g * v; v2u o; o.x = pk2(x[0], x[1]); o.y = pk2(x[2], x[3]); *(v2u*)p = o; } };
__device__ __forceinline__ void vtrans_phase(const Ctx& F) {
    GAS unsigned char* big = F.ws + WS_BIG;
    const bf16* Z = (const bf16*)(big + B_Z); const bf16* VD = (const bf16*)(big + B_VD); unsigned char* VT = (unsigned char*)(big + B_VT8);
    LAS unsigned char* T = F.lds + F.wave * 4096;
    const int gw = F.vcu * NWAVES + F.wave, NGW = F.G * NWAVES, lane = F.lane, NTL = ROWS_B / 64;
    const int k = lane, h = (k >> 2) & 1, jj = (k & 3) + 4 * ((k & 31) >> 3), pos = 32 * h + jj + 16 * (k >> 5);
    for (int it = gw; it < BATCH * 10 * NTL; it += NGW) { const int b = it / (10 * NTL), r = it - b * 10 * NTL, hd = r / NTL, tile = r - hd * NTL;
        const size_t row = (size_t)b * ROWS_B + tile * 64 + k;
        const bf16* src = (hd < 2) ? Z + row * CD_INP + 640 + hd * 64 : VD + row * 512 + (hd - 2) * 64;
        v4u x[8];
#pragma unroll
        for (int i = 0; i < 8; ++i) x[i] = *(const v4u*)(src + 8 * i);
#pragma unroll
        for (int i = 0; i < 8; ++i) { float f[8]; unpack8(x[i], f);
#pragma unroll
            for (int t = 0; t < 8; t += 2) { const int w = __builtin_amdgcn_cvt_pk_fp8_f32(f[t], f[t + 1], 0, false); const int d0 = 8 * i + t, d1 = d0 + 1;
                T[d0 * 64 + ((((pos >> 4) ^ ((d0 >> 2) & 3)) << 4) | (pos & 15))] = (unsigned char)(w & 0xff);
                T[d1 * 64 + ((((pos >> 4) ^ ((d1 >> 2) & 3)) << 4) | (pos & 15))] = (unsigned char)((w >> 8) & 0xff); } }
        LDS_WAIT(); asm volatile("" ::: "memory");
        unsigned char* dst = VT + (size_t)it * 4096;
#pragma unroll
        for (int i = 0; i < 4; ++i) *(v4u*)(dst + (i * 64 + lane) * 16) = *(const LAS v4u*)(T + (i * 64 + lane) * 16);
        LDS_WAIT(); asm volatile("" ::: "memory");
    }
}
__device__ __forceinline__ void attn_do_unit(const Ctx& F, int kind  , int b, int h, int qb  ) {
    GAS unsigned char* big = F.ws + WS_BIG;
    const size_t rowb = (size_t)b * ROWS_B, qrow = rowb + (qb < 0 ? 0 : CTXL + qb * 256); const int nkeys = qb < 0 ? CTXL : ROWS_B;
    bf16* O = (bf16*)(big + B_Y);
    if (kind == 0) { const bf16* QC = (const bf16*)(big + B_QC); const bf16* KC = (const bf16*)(big + B_KC); const bf16* Z = (const bf16*)(big + B_Z); const int kvh = h >> 2;
        att::attn_unit4<64, 512, 128, 1024, true>((const bf16*)((const unsigned char*)(big + B_QC8) + qrow * 512 + h * 64), (const bf16*)((const unsigned char*)(big + B_KC8) + rowb * 128 + kvh * 64), (const unsigned char*)(big + B_VT8) + (size_t)(b * 10 + kvh) * (ROWS_B / 64) * 4096, O + qrow * 1024 + h * 64, nkeys, (__attribute__((address_space(3))) char*)F.lds, F.tid); (void)Z; (void)QC; (void)KC;
    } else { const bf16* QD = (const bf16*)(big + B_QD); const bf16* KD = (const bf16*)(big + B_KD); const bf16* VD = (const bf16*)(big + B_VD);
        att::attn_unit4<96, 1024, 1024, 1024, true>((const bf16*)((const unsigned char*)(big + B_QD) + qrow * 1024 + h * 128), (const bf16*)((const unsigned char*)(big + B_KD) + rowb * 1024 + h * 128), (const unsigned char*)(big + B_VT8) + (size_t)(b * 10 + 2 + h) * (ROWS_B / 64) * 4096, O + qrow * 1024 + 512 + h * 64, nkeys, (__attribute__((address_space(3))) char*)F.lds, F.tid); (void)VD; (void)QD; (void)KD;
    }
}

__device__ __forceinline__ bool attn_deal(int G, int blk, int i, int ctx_shift, int& b, int& h, int& qb) {
    if (G == 256) { const int x = blk & 7, c = blk >> 3;
        if (i < 4) { const int pair = 4 * x + i; b = pair >> 3; h = pair & 7; qb = c; return true; }
        if (i == 4) { const int p = blk - ctx_shift; if (p >= 0 && p < 32) { b = p >> 3; h = p & 7; qb = -1; return true; } }
        return false; }
    const int L = i * G + blk;
    if (L < 1024) { const int pair = L >> 5; b = pair >> 3; h = pair & 7; qb = L & 31; return true; }
    if (L < 1056) { const int p = L - 1024; b = p >> 3; h = p & 7; qb = -1; return true; }
    return false;
}

#ifndef HDP_DUP
#define HDP_DUP 0u
#endif
#define NREP(k) (((HDP_DUP >> (k)) & 1u) ? 2 : 1)
#define GS(k) ((NREP(k) == 2) ? 0.5f : 1.0f)
#ifndef HDP_ONLY
#define PH_ON(k) true
#else
#define PH_ON(k) ((k) == HDP_ONLY)
#endif
constexpr int N_PHASES = 2 + 2 * 18;
__global__ void __launch_bounds__(NWAVES * 64, 2) hdp_fwd(Args args_k) {
    extern __shared__ __attribute__((aligned(16))) unsigned char lds[];
    Ctx F0;
    { Ctx& F = F0;
    F.ldsg = lds; F.lds = (LAS unsigned char*)lds;
    F.tid = threadIdx.x; F.lane = F.tid & 63; F.wave = __builtin_amdgcn_readfirstlane(F.tid >> 6);
    F.bx = blockIdx.x; F.G = gridDim.x; { const int bx = blockIdx.x; F.vcu = (F.G % 8 == 0) ? (bx % 8) * (F.G / 8) + bx / 8 : bx; }
    F.ws = (GAS unsigned char*)args_k.ws; }
    const Ctx& F = F0;
    volatile LAS unsigned* MISC = (volatile LAS unsigned*)(F.lds + MISC_OFF);
    for (int u = F.tid; u < (LDS_BYTES - LDSCTL_OFF) / 4; u += NWAVES * 64) ((LAS unsigned*)(F.lds + LDSCTL_OFF))[u] = 0u;
    __syncthreads();
    unsigned* barw = (unsigned*)(args_k.ws + WS_CTL) + 4096;
    XcdBarrier bar = xcd_barrier_post(barw, MISC + 8);
    const int lo = args_k.ph_lo, hi = args_k.ph_hi;
    int ph = 0;
#define IN() (lo <= ph && ph < hi)
#define FRESH() Ctx F = F0; F.lane = (int)__builtin_amdgcn_mbcnt_hi(~0u, __builtin_amdgcn_mbcnt_lo(~0u, 0u)); asm volatile("" : "+v"(F.lane)); F.tid = F.wave * 64 + F.lane; const Args& args = args_k; asm volatile("" : "+s"(F.ws), "+s"(F.G), "+s"(F.vcu), "+s"(F.bx)); GAS unsigned char* ws = F.ws; GAS unsigned char* big = ws + WS_BIG; xs_t* XS = (xs_t*)(ws + WS_XS); const float* MOD = (const float*)(ws + WS_MOD); bf16* H = (bf16*)(big + B_H); (void)XS; (void)MOD; (void)H; (void)big
#ifndef HDP_DBLBAR
#define HDP_DBLBAR 0
#endif
#define SEAM() do { if (lo <= ph && ph + 1 < hi) { xcd_barrier(bar); if (HDP_DBLBAR) xcd_barrier(bar); } ++ph; } while (0)

    for (int rep_ = 0; rep_ < NREP(0); ++rep_) if (PH_ON(0) && IN()) { FRESH(); convert_small(F, args); rope_table(F); adaln_phase(F, args); }
    SEAM();
    for (int rep_ = 0; rep_ < NREP(1); ++rep_) if (PH_ON(1) && IN()) { FRESH(); nm_phase(F, args, true, MOD, 0, 1024); }
    SEAM();

    for (int lp = 0; lp < 2; ++lp) {
#define LAYER_PTRS() const float* mode = MOD + (size_t)(2 * lp) * 5 * 6144; const float* modo = MOD + (size_t)(2 * lp + 1) * 5 * 6144; \
        GAS unsigned char* ev = ws + WS_WSMALL + (size_t)lp * EV_STRIDE; GAS unsigned char* od = ws + WS_WODD + (size_t)lp * OD_STRIDE; (void)mode; (void)modo; (void)ev; (void)od
        for (int rep_ = 0; rep_ < NREP(2); ++rep_) if (PH_ON(2) && IN()) { FRESH(); LAYER_PTRS(); pg8::Gemm g{H, (const bf16*)(ev + EV_WIN), MLAT, AB_IN, D, 0}; pg8::StaticOrder S; S.init(MLAT, AB_IN, F.G, F.bx, 1);
            pg8::EpiZ<true> E{(bf16*)(big + B_Z), AB_IN, 4, 1.0f};
            pg8::gemm_phase<pg8::EpiZ<true>, pg8::StaticOrder, true, true>(F.lds + RING_OFF, g, S, E, F.tid);
            ctx_gemm<false>(F, H, (const bf16*)(ev + EV_WIN), 2 * D, AB_IN, CtxEpiZ{(bf16*)(big + B_Z), AB_IN, 1024}); }
        SEAM();
        for (int rep_ = 0; rep_ < NREP(3); ++rep_) if (PH_ON(3) && IN()) { FRESH(); LAYER_PTRS(); int cur_g = -1;
            for (int u = F.vcu; u < (M / 128) * 4; u += F.G) abmid_unit(F, u >> 2, u & 3, (const bf16*)(big + B_Z), (bf16*)(big + B_Y), (const bf16*)(ev + EV_WS), (const bf16*)(ev + EV_WPOOL),
                args.in[I_AVGAIN] + lp * 512, args.in[I_ABS] + lp * 512, args.in[I_BSCALE] + lp * 512, cur_g); }
        SEAM();
        for (int rep_ = 0; rep_ < NREP(4); ++rep_) if (PH_ON(4) && IN()) { FRESH(); LAYER_PTRS(); pg8::Gemm g{(const bf16*)(big + B_Y), (const bf16*)(ev + EV_WOUT), MLAT, D, D, 0}; pg8::StaticOrder S; S.init(MLAT, D, F.G, F.bx, 1);
            pg8::EpiResid E{XS, mode + 2 * 1024, GS(4)};
            pg8::gemm_phase<pg8::EpiResid, pg8::StaticOrder, true, true>(F.lds + RING_OFF, g, S, E, F.tid);
            ctx_gemm<false>(F, (const bf16*)(big + B_Y), (const bf16*)(ev + EV_WOUT), 2 * D, D, CtxEpiResid{XS, mode + 4 * 6144 + 2 * 1024, GS(4)}); }
        SEAM();
        for (int rep_ = 0; rep_ < NREP(5); ++rep_) if (PH_ON(5) && IN()) { FRESH(); LAYER_PTRS(); nm_phase(F, args, false, mode, 3 * 1024, 4 * 1024, FP8F || (FP8G2 && lp == 1)); }
        SEAM();
        for (int rep_ = 0; rep_ < NREP(6); ++rep_) if (PH_ON(6) && IN()) { FRESH(); LAYER_PTRS(); const bool g8 = FP8F || (FP8G2 && lp == 1);
            pg8::Gemm g{H, (const bf16*)(ev + EV_WGU), M, 2 * DFF, g8 ? D / 2 : D, 0}; pg8::StaticOrder S; S.init(M, 2 * DFF, F.G, F.bx);
            pg8::EpiSwiglu<FP8D> E{(bf16*)(big + B_HB), DFF, g8 ? WSC_INV : 1.0f};
            if (FP8G2 && !FP8F) { if (lp == 1) pg8::gemm_phase<pg8::EpiSwiglu<FP8D>, pg8::StaticOrder, true, true, MXM>(F.lds + RING_OFF, g, S, E, F.tid);
                                  else pg8::gemm_phase<pg8::EpiSwiglu<FP8D>, pg8::StaticOrder, true, true, 0>(F.lds + RING_OFF, g, S, E, F.tid); }
            else pg8::gemm_phase<pg8::EpiSwiglu<FP8D>, pg8::StaticOrder, true, true, FP8F ? MXM : 0>(F.lds + RING_OFF, g, S, E, F.tid); }
        SEAM();
        for (int rep_ = 0; rep_ < NREP(7); ++rep_) if (PH_ON(7) && IN()) { FRESH(); LAYER_PTRS(); pg8::Gemm g{(const bf16*)(big + B_HB), (const bf16*)(ev + EV_WDN), MLAT, D, FP8D ? DFF / 2 : DFF, 0}; pg8::StaticOrder S; S.init(MLAT, D, F.G, F.bx, 1);
            pg8::EpiResid E{XS, mode + 5 * 1024, GS(7) * (FP8D ? WSC_INV : 1.0f)};
            pg8::gemm_phase<pg8::EpiResid, pg8::StaticOrder, true, true, FP8D ? MXM : 0>(F.lds + RING_OFF, g, S, E, F.tid);
            ctx_gemm<FP8D>(F, (const void*)(big + B_HB), (const void*)(ev + EV_WDN), FP8D ? DFF : 2 * DFF, D, CtxEpiResid{XS, mode + 4 * 6144 + 5 * 1024, GS(7) * (FP8D ? WSC_INV : 1.0f)}); }
        SEAM();
        for (int rep_ = 0; rep_ < NREP(8); ++rep_) if (PH_ON(8) && IN()) { FRESH(); LAYER_PTRS(); nm_phase(F, args, false, modo, 0, 1024); }
        SEAM();
        for (int rep_ = 0; rep_ < NREP(9); ++rep_) if (PH_ON(9) && IN()) { FRESH(); LAYER_PTRS(); pg8::Gemm g{H, (const bf16*)(od + OD_WCD), MLAT, CD_INP, D, 0}; pg8::StaticOrder S; S.init(MLAT, CD_INP, F.G, F.bx, 1);
            pg8::EpiZ<false> E{(bf16*)(big + B_Z), CD_INP, 0, 1.0f};
            pg8::gemm_phase<pg8::EpiZ<false>, pg8::StaticOrder, true, true>(F.lds + RING_OFF, g, S, E, F.tid);
            ctx_gemm<false>(F, H, (const bf16*)(od + OD_WCD), 2 * D, CD_INP, CtxEpiZ{(bf16*)(big + B_Z), CD_INP, 0}); }
        SEAM();
        for (int rep_ = 0; rep_ < NREP(10); ++rep_) if (PH_ON(10) && IN()) { FRESH(); cdmid_phase(F, args, lp); convert_moe(F, args, lp); }
        SEAM();
        for (int rep_ = 0; rep_ < NREP(11); ++rep_) if (PH_ON(11) && IN()) { FRESH(); LAYER_PTRS(); pg8::Gemm g{(const bf16*)(big + B_CQN), (const bf16*)(od + OD_WUQ), M, 768, 384, 0}; pg8::StaticOrder S; S.init(M, 768, F.G, F.bx);
              pg8::EpiQD E{(unsigned char*)(big + B_QD), (const float*)(ws + WS_ROPE)};
              pg8::gemm_phase<pg8::EpiQD, pg8::StaticOrder, true, true>(F.lds + RING_OFF, g, S, E, F.tid); }
        for (int rep_ = 0; rep_ < NREP(12); ++rep_) if (PH_ON(12) && IN()) { FRESH(); LAYER_PTRS(); pg8::Gemm g{(const bf16*)(big + B_CKVN), (const bf16*)(od + OD_WUKV), M, 1024, 256, 0}; pg8::StaticOrder S; S.init(M, 1024, F.G, F.bx);
              pg8::EpiKVD E{(unsigned char*)(big + B_KD), (bf16*)(big + B_VD)};
              pg8::gemm_phase<pg8::EpiKVD, pg8::StaticOrder, true, true>(F.lds + RING_OFF, g, S, E, F.tid); }
        SEAM();
        for (int rep_ = 0; rep_ < NREP(21); ++rep_) if (PH_ON(21) && IN()) { FRESH(); vtrans_phase(F); }
        SEAM();
        for (int rep_ = 0; rep_ < NREP(13); ++rep_) if (PH_ON(13) && IN()) { FRESH(); int b, h, qb;
            for (int i = 0; attn_deal(F.G, F.bx, i, 0, b, h, qb); ++i) attn_do_unit(F, 0, b, h, qb); }
        for (int rep_ = 0; rep_ < NREP(14); ++rep_) if (PH_ON(14) && IN()) { FRESH(); int b, h, qb;
            for (int i = 0; attn_deal(F.G, F.bx, i, 32, b, h, qb); ++i) attn_do_unit(F, 1, b, h, qb); }
        SEAM();
        for (int rep_ = 0; rep_ < NREP(15); ++rep_) if (PH_ON(15) && IN()) { FRESH(); LAYER_PTRS(); pg8::Gemm g{(const bf16*)(big + B_Y), (const bf16*)(od + OD_WCDO), MLAT, D, D, 0}; pg8::StaticOrder S; S.init(MLAT, D, F.G, F.bx, 1);
            pg8::EpiResid E{XS, modo + 2 * 1024, GS(15)};
            pg8::gemm_phase<pg8::EpiResid, pg8::StaticOrder, true, true>(F.lds + RING_OFF, g, S, E, F.tid);
            ctx_gemm<false>(F, (const bf16*)(big + B_Y), (const bf16*)(od + OD_WCDO), 2 * D, D, CtxEpiResid{XS, modo + 4 * 6144 + 2 * 1024, GS(15)}); }
        SEAM();
        for (int rep_ = 0; rep_ < NREP(16); ++rep_) if (PH_ON(16) && IN()) { FRESH(); LAYER_PTRS(); route_phase(F, args, lp, modo); }
        SEAM();
        for (int rep_ = 0; rep_ < NREP(17); ++rep_) if (PH_ON(17) && IN()) { FRESH(); LAYER_PTRS(); slots_phase(F, args, modo); }
        SEAM();
        for (int rep_ = 0; rep_ < NREP(18); ++rep_) if (PH_ON(18) && IN()) { FRESH(); const unsigned* pexp = (const unsigned*)(ws + WS_PEXP);
            const int npan = __builtin_amdgcn_readfirstlane((int)__hip_atomic_load(pexp + 511, __ATOMIC_RELAXED, __HIP_MEMORY_SCOPE_AGENT));
            pg8::Gemm g{(const bf16*)(big + B_HS), (const bf16*)(ws + WS_WMOE), npan * 256, 2 * DFF, FP8M ? D / 2 : D, FP8M ? MOE_WGU8 : MOE_WGU}; pg8::MoeOrder S; S.init(npan, 2 * DFF, F.G, F.bx, pexp, F.lane);
            pg8::EpiSwiglu<FP8M> E{(bf16*)(big + B_HM), DFF, FP8M ? WSC_INV : 1.0f};
            pg8::gemm_phase<pg8::EpiSwiglu<FP8M>, pg8::MoeOrder, MOE_ALIGN, MOE_SP2, FP8M ? MXM : 0>(F.lds + RING_OFF, g, S, E, F.tid); }
        SEAM();
        for (int rep_ = 0; rep_ < NREP(19); ++rep_) if (PH_ON(19) && IN()) { FRESH(); const unsigned* pexp = (const unsigned*)(ws + WS_PEXP);
            const int npan = __builtin_amdgcn_readfirstlane((int)__hip_atomic_load(pexp + 511, __ATOMIC_RELAXED, __HIP_MEMORY_SCOPE_AGENT));
            pg8::Gemm g{(const bf16*)(big + B_HM), (const bf16*)(ws + WS_WMOE + (FP8M ? MOE_WDN_OFF8 : MOE_WDN_OFF)), npan * 256, D, FP8M ? DFF / 2 : DFF, FP8M ? MOE_WDN8 : MOE_WDN}; pg8::MoeOrder S; S.init(npan, D, F.G, F.bx, pexp, F.lane);
            pg8::EpiZ<false> E{(bf16*)(big + B_HS), D, 0, FP8M ? WSC_INV : 1.0f};
            pg8::gemm_phase<pg8::EpiZ<false>, pg8::MoeOrder, MOE_ALIGN, MOE_SP2, FP8M ? MXM : 0>(F.lds + RING_OFF, g, S, E, F.tid); }
        SEAM();
        for (int rep_ = 0; rep_ < NREP(20); ++rep_) if (PH_ON(20) && IN()) { FRESH(); LAYER_PTRS(); combine_phase(F, args, modo, lp == 1, MOD + (size_t)(2 * lp + 2 < 4 ? 2 * lp + 2 : 0) * 5 * 6144, (NREP(20) == 2 && rep_ == 0) ? 0.0f : 1.0f); }
        SEAM();
    }
    if (hi == N_PHASES) { if (__hip_atomic_load(barw + XB_TMO, __ATOMIC_RELAXED, __HIP_MEMORY_SCOPE_AGENT) != 0u) {
        const float q = __builtin_nanf("");
        const int tid_e = F0.wave * 64 + (int)__builtin_amdgcn_mbcnt_hi(~0u, __builtin_amdgcn_mbcnt_lo(~0u, 0u));
        for (size_t i = (size_t)blockIdx.x * (NWAVES * 64) + tid_e; i < (size_t)BATCH * SEQ * D; i += (size_t)F.G * NWAVES * 64) args_k.out[i] = q; } }
#undef IN
#undef SEAM
}

#ifndef HDP_N_LAUNCHES
#define HDP_N_LAUNCHES 1
#endif
extern "C" void kernel_launch(void* const* d_in, const int* in_sizes, int n_in, void* d_out, int out_size, void* d_ws, size_t ws_size, hipStream_t stream) {
    static int grid = 0;
    if (grid == 0) {
        int dev = 0, cus = 0;
        if (n_in != 29 || out_size != BATCH * SEQ * D || hipGetDevice(&dev) != hipSuccess || hipDeviceGetAttribute(&cus, hipDeviceAttributeMultiprocessorCount, dev) != hipSuccess) { fprintf(stderr, "kernel_launch: unexpected problem shape or device query failure\n"); grid = -1; }
        else if (hipFuncSetAttribute((const void*)hdp_fwd, hipFuncAttributeMaxDynamicSharedMemorySize, LDS_BYTES) != hipSuccess) { fprintf(stderr, "kernel_launch: hipFuncSetAttribute failed\n"); grid = -1; }
        else { int per_cu = 0; (void)hipOccupancyMaxActiveBlocksPerMultiprocessor(&per_cu, (const void*)hdp_fwd, NWAVES * 64, LDS_BYTES); (void)hipGetLastError();
            grid = (per_cu >= 1 && cus >= 32) ? cus : -1; if (grid > 1024) grid = 1024; }
    }
    if (grid < 0 || ws_size < WS_END) {
        (void)hipMemsetAsync(d_out, 0xFF, (size_t)out_size * 4, stream); return; }
    (void)hipMemsetAsync((char*)d_ws + WS_CTL, 0, CTL_ZERO_BYTES, stream);
    Args a{};
    for (int i = 0; i < 29; ++i) a.in[i] = (const float*)d_in[i];
    a.out = (float*)d_out; a.ws = (unsigned char*)d_ws;
#if HDP_N_LAUNCHES == 1
    a.ph_lo = 0; a.ph_hi = N_PHASES;
    hipLaunchKernelGGL(hdp_fwd, dim3(grid), dim3(NWAVES * 64), LDS_BYTES, stream, a);
#else
    for (int p = 0; p < N_PHASES; ++p) { a.ph_lo = p; a.ph_hi = p + 1; hipLaunchKernelGGL(hdp_fwd, dim3(grid), dim3(NWAVES * 64), LDS_BYTES, stream, a); }
#endif
}
```

```cpp
#include <hip/hip_runtime.h>
#include <cstdio>
#include <cstdint>

namespace pg8 {
#define PG8_LAS __attribute__((address_space(3)))
typedef unsigned short bf16_t;
typedef short bf16x8 __attribute__((ext_vector_type(8)));
typedef float f32x4 __attribute__((ext_vector_type(4)));
typedef unsigned u32x4 __attribute__((ext_vector_type(4)));
constexpr int BM = 256, BK = 64, HALF = 128, HTB = HALF * BK * 2  , STAGE_BYTES = 8 * HTB, NXCD = 8, WGM = 8;

__host__ __device__ __forceinline__ int lds_byte(int r, int c) { const int st = (r >> 4) * 2 + (c >> 5), rr = r & 15, cc = c & 31, ob = rr * 64 + cc * 2; return st * 1024 + (ob ^ (((ob >> 9) & 1) << 5)); }
__host__ __device__ __forceinline__ void stage_rc(int b, int& R, int& C) { const int st = b / 1024, sb = b % 1024, swz = sb ^ (((sb >> 9) & 1) << 5); R = (st >> 1) * 16 + swz / 64; C = (st & 1) * 32 + (swz % 64) / 2; }
__host__ __device__ __forceinline__ int perm32(int rho) { const int n = rho >> 4, i = rho & 15; return 8 * (i >> 2) + 4 * n + (i & 3); }

struct Unit { int pm, pn, e; };
struct Gemm { const bf16_t* A; const bf16_t* Bt; int M, N, K; size_t bes; };

struct StaticOrder {
    int nM, nN, nwg, G, c, lat;
    __host__ __device__ void init(int M, int N, int G_, int c_, int lat_ = 0) { nM = M / BM; nN = N / BM; nwg = nM * nN; G = G_; c = c_; lat = lat_; }
    __host__ __device__ bool next(int i, Unit& u) const {
        const long L = (long)i * G + c; if (L >= nwg) return false;
        int wgid = (int)L; { const int q = nwg / NXCD, r = nwg % NXCD, xcd = wgid % NXCD, off = wgid / NXCD; wgid = (xcd < r ? xcd * (q + 1) : r * (q + 1) + (xcd - r) * q) + off; }
        const int nig = WGM * nN, gid = wgid / nig, fm = gid * WGM, gsz = (nM - fm) < WGM ? (nM - fm) : WGM;
        u.pm = fm + ((wgid % nig) % gsz); u.pn = (wgid % nig) / gsz; u.e = 0; if (lat) u.pm = u.pm + (u.pm >> 5) + 1; return true;
    }
    __device__ __forceinline__ void a_ready(const Unit&) const {}
    __device__ __forceinline__ void done(const Unit&) const {}
};

__device__ __forceinline__ unsigned cvt_pk_bf16(float lo, float hi) { unsigned r; asm volatile("v_cvt_pk_bf16_f32 %0, %1, %2" : "=v"(r) : "v"(lo), "v"(hi)); return r; }
typedef float f32x2 __attribute__((ext_vector_type(2)));
__device__ __forceinline__ f32x2 gelu_pk(f32x2 v) {
    const f32x2 av = __builtin_elementwise_abs(v), d = av * 0.2316418882f + 1.0f;
    f32x2 t; t.x = __builtin_amdgcn_rcpf(d.x); t.y = __builtin_amdgcn_rcpf(d.y);
    f32x2 q = t * 0.5307027145f + (-0.7265760135f); q = q * t + 0.7107068705f; q = q * t + (-0.142248368f); q = q * t + 0.127414796f; q = q * t;
    const f32x2 s = (v * v) * (-0.72134752044f);
    f32x2 e; e.x = __builtin_amdgcn_exp2f(s.x); e.y = __builtin_amdgcn_exp2f(s.y);
    const f32x2 m = v * (q * e), r = v - m;
    f32x2 o; o.x = v.x < 0.f ? m.x : r.x; o.y = v.y < 0.f ? m.y : r.y; return o;
}

template <int ACT  > struct EpiBf16 {
    static constexpr bool PERM = true, AFTER_DRAIN = false; static_assert(ACT == 0 || ACT == 1, "EpiBf16: ACT is 0 (none) or 1 (gelu_pk)");
    bf16_t* O; int ldc; const float* bias; int split_cols; size_t split_stride; float scale0;
    __device__ __forceinline__ void operator()(const f32x4 (&acc)[2][2][4][2], const Unit& u, int wr, int wc, int fr, int fq) const {
        const int row0 = u.pm * BM + wr * 64 + fr; int colt = u.pn * BM; bf16_t* base = O;
        float sc = 1.f; if (split_cols) { const int t = colt / split_cols; base += (size_t)t * split_stride; colt -= t * split_cols; if (t == 0) sc = scale0; }
        const int col0 = colt + wc * 32 + 8 * fq, bcol0 = u.pn * BM + wc * 32 + 8 * fq;
        f32x4 bv[2][2];
#pragma unroll
        for (int bj = 0; bj < 2; ++bj)
#pragma unroll
            for (int n = 0; n < 2; ++n) bv[bj][n] = bias ? *(const f32x4*)(bias + bcol0 + bj * HALF + 4 * n) : (f32x4){0.f, 0.f, 0.f, 0.f};
#pragma unroll
        for (int ai = 0; ai < 2; ++ai)
#pragma unroll
            for (int m = 0; m < 4; ++m) { bf16_t* rowp = base + (size_t)(row0 + ai * HALF + m * 16) * ldc + col0;
#pragma unroll
                for (int bj = 0; bj < 2; ++bj) { f32x4 v0 = acc[ai][bj][m][0] + bv[bj][0], v1 = acc[ai][bj][m][1] + bv[bj][1];
                    if (ACT == 1) { f32x2 a = gelu_pk((f32x2){v0[0], v0[1]}), b = gelu_pk((f32x2){v0[2], v0[3]}), c = gelu_pk((f32x2){v1[0], v1[1]}), d = gelu_pk((f32x2){v1[2], v1[3]});
                        v0 = (f32x4){a.x, a.y, b.x, b.y}; v1 = (f32x4){c.x, c.y, d.x, d.y}; }
                    v0 = v0 * sc; v1 = v1 * sc; u32x4 w; w.x = cvt_pk_bf16(v0[0], v0[1]); w.y = cvt_pk_bf16(v0[2], v0[3]); w.z = cvt_pk_bf16(v1[0], v1[1]); w.w = cvt_pk_bf16(v1[2], v1[3]);
                    *(u32x4*)(rowp + bj * HALF) = w; } }
    }
};

constexpr int PAN_B = 33;
__device__ __forceinline__ int modrow_of_panel(int pm) { const int b = pm / PAN_B; return (pm - b * PAN_B == 0) ? 4 : b; }
__device__ __forceinline__ unsigned pk4_fp8(float a, float b, float c, float d) { int w = 0; w = __builtin_amdgcn_cvt_pk_fp8_f32(a, b, w, false); w = __builtin_amdgcn_cvt_pk_fp8_f32(c, d, w, true); return (unsigned)w; }
__device__ __forceinline__ float silu_f(float g) { return g * __builtin_amdgcn_rcpf(1.0f + __builtin_amdgcn_exp2f(-1.4426950408889634f * g)); }

template <bool GELU> struct EpiZ {
    static constexpr bool PERM = true, AFTER_DRAIN = false;
    bf16_t* O; int ldc; int gelu_tiles; float oscale;
    __device__ __forceinline__ void operator()(const f32x4 (&acc)[2][2][4][2], const Unit& u, int wr, int wc, int fr, int fq) const {
        const int row0 = u.pm * BM + wr * 64 + fr, col0 = u.pn * BM + wc * 32 + 8 * fq;
        const bool g = GELU && (u.pn < gelu_tiles);
#pragma unroll
        for (int ai = 0; ai < 2; ++ai)
#pragma unroll
            for (int m = 0; m < 4; ++m) { bf16_t* rowp = O + (size_t)(row0 + ai * HALF + m * 16) * ldc + col0;
#pragma unroll
                for (int bj = 0; bj < 2; ++bj) { f32x4 v0 = acc[ai][bj][m][0], v1 = acc[ai][bj][m][1];
                    if (GELU) { if (g) { f32x2 a = gelu_pk((f32x2){v0[0], v0[1]}), b = gelu_pk((f32x2){v0[2], v0[3]}), c = gelu_pk((f32x2){v1[0], v1[1]}), d = gelu_pk((f32x2){v1[2], v1[3]});
                        v0 = (f32x4){a.x, a.y, b.x, b.y}; v1 = (f32x4){c.x, c.y, d.x, d.y}; } }
                    v0 = v0 * oscale; v1 = v1 * oscale;
                    u32x4 w; w.x = cvt_pk_bf16(v0[0], v0[1]); w.y = cvt_pk_bf16(v0[2], v0[3]); w.z = cvt_pk_bf16(v1[0], v1[1]); w.w = cvt_pk_bf16(v1[2], v1[3]);
                    *(u32x4*)(rowp + bj * HALF) = w; } }
    }
};
struct EpiResid {
    static constexpr bool PERM = false, AFTER_DRAIN = false;
    bf16_t* X; const float* gate; float gscale;
    __device__ __forceinline__ void operator()(const f32x4 (&acc)[2][2][4][2], const Unit& u, int wr, int wc, int fr, int fq) const {
        const float* gp = gate + (size_t)modrow_of_panel(u.pm) * 6144;
        const int col0 = u.pn * BM + wc * 32 + 4 * fq;
        f32x4 gv[2][2];
#pragma unroll
        for (int bj = 0; bj < 2; ++bj)
#pragma unroll
            for (int n = 0; n < 2; ++n) gv[bj][n] = *(const f32x4*)(gp + col0 + bj * HALF + n * 16) * gscale;
        typedef unsigned u32x2v __attribute__((ext_vector_type(2)));
#pragma unroll
        for (int ai = 0; ai < 2; ++ai)
#pragma unroll
            for (int m = 0; m < 4; ++m) { bf16_t* p = X + (size_t)(u.pm * BM + ai * HALF + wr * 64 + m * 16 + fr) * 1024 + col0;
                u32x2v r[2][2];
#pragma unroll
                for (int bj = 0; bj < 2; ++bj)
#pragma unroll
                    for (int n = 0; n < 2; ++n) r[bj][n] = *(const u32x2v*)(p + bj * HALF + n * 16);
#pragma unroll
                for (int bj = 0; bj < 2; ++bj)
#pragma unroll
                    for (int n = 0; n < 2; ++n) { const u32x2v rr = r[bj][n];
                        f32x4 x = (f32x4){__uint_as_float(rr.x << 16), __uint_as_float(rr.x & 0xffff0000u), __uint_as_float(rr.y << 16), __uint_as_float(rr.y & 0xffff0000u)}; x = x + gv[bj][n] * acc[ai][bj][m][n];
                        u32x2v w; w.x = cvt_pk_bf16(x[0], x[1]); w.y = cvt_pk_bf16(x[2], x[3]); *(u32x2v*)(p + bj * HALF + n * 16) = w; }
                if (m & 1) asm volatile("" ::: "memory"); }
    }
};
template <bool OUT8> struct EpiSwiglu {
    static constexpr bool PERM = true, AFTER_DRAIN = false;
    bf16_t* O; int ldc; float iscale;
    __device__ __forceinline__ void operator()(const f32x4 (&acc)[2][2][4][2], const Unit& u, int wr, int wc, int fr, int fq) const {
        const int row0 = u.pm * BM + wr * 64 + fr, col0 = u.pn * HALF + wc * 32 + 8 * fq;
#pragma unroll
        for (int ai = 0; ai < 2; ++ai)
#pragma unroll
            for (int m = 0; m < 4; ++m) {
                const f32x4 g0 = acc[ai][0][m][0] * iscale, g1 = acc[ai][0][m][1] * iscale, u0 = acc[ai][1][m][0] * iscale, u1 = acc[ai][1][m][1] * iscale;
                float h[8];
#pragma unroll
                for (int j = 0; j < 4; ++j) { h[j] = silu_f(g0[j]) * u0[j]; h[4 + j] = silu_f(g1[j]) * u1[j]; }
                if (OUT8) { typedef unsigned u32x2v __attribute__((ext_vector_type(2))); unsigned char* rowp = (unsigned char*)O + (size_t)(row0 + ai * HALF + m * 16) * ldc + col0;
                    u32x2v w; w.x = pk4_fp8(h[0], h[1], h[2], h[3]); w.y = pk4_fp8(h[4], h[5], h[6], h[7]); *(u32x2v*)rowp = w; }
                else { bf16_t* rowp = O + (size_t)(row0 + ai * HALF + m * 16) * ldc + col0;
                    u32x4 w; w.x = cvt_pk_bf16(h[0], h[1]); w.y = cvt_pk_bf16(h[2], h[3]); w.z = cvt_pk_bf16(h[4], h[5]); w.w = cvt_pk_bf16(h[6], h[7]); *(u32x4*)rowp = w; } }
    }
};
constexpr float QD_SCALE = 0.10206207261596575f * 1.4426950408889634f;
struct EpiQD {
    static constexpr bool PERM = false, AFTER_DRAIN = false;
    unsigned char* O; const float* rope;
    __device__ __forceinline__ void operator()(const f32x4 (&acc)[2][2][4][2], const Unit& u, int wr, int wc, int fr, int fq) const {
        const int pb = u.pm / PAN_B, pj = u.pm - pb * PAN_B; const bool latent = pj != 0;
        f32x4 csv[2][4], snv[2][4];
#pragma unroll
        for (int ai = 0; ai < 2; ++ai)
#pragma unroll
            for (int m = 0; m < 4; ++m) { const int rin = ai * HALF + wr * 64 + m * 16 + fr; const int s = latent ? (pj - 1) * 256 + rin : 0;
                csv[ai][m] = *(const f32x4*)(rope + (size_t)s * 32 + 4 * fq); snv[ai][m] = *(const f32x4*)(rope + (size_t)s * 32 + 16 + 4 * fq); }
#pragma unroll
        for (int ai = 0; ai < 2; ++ai)
#pragma unroll
            for (int m = 0; m < 4; ++m) { const int rin = ai * HALF + wr * 64 + m * 16 + fr;
                const f32x4 cs = csv[ai][m], sn = snv[ai][m];
                unsigned char* rowp = O + (size_t)(u.pm * BM + rin) * 1024;
#pragma unroll
                for (int bj = 0; bj < 2; ++bj) { const int cb = 8 * u.pn + 4 * bj + wc; f32x4 x1 = acc[ai][bj][m][0], x2 = acc[ai][bj][m][1];
                    if (latent && (cb % 3 == 2)) { const f32x4 o1 = x1 * cs - x2 * sn, o2 = x1 * sn + x2 * cs; x1 = o1; x2 = o2; }
                    x1 = x1 * QD_SCALE; x2 = x2 * QD_SCALE;
                    const int c1 = u.pn * BM + bj * HALF + wc * 32 + 4 * fq, c2 = c1 + 16, h1 = c1 / 96, h2 = c2 / 96;
                    *(unsigned*)(rowp + h1 * 128 + (c1 - h1 * 96)) = pk4_fp8(x1[0], x1[1], x1[2], x1[3]); *(unsigned*)(rowp + h2 * 128 + (c2 - h2 * 96)) = pk4_fp8(x2[0], x2[1], x2[2], x2[3]); } }
    }
};
struct EpiKVD {
    static constexpr bool PERM = true, AFTER_DRAIN = false;
    unsigned char* KD; bf16_t* VD;
    __device__ __forceinline__ void operator()(const f32x4 (&acc)[2][2][4][2], const Unit& u, int wr, int wc, int fr, int fq) const {
        const int row0 = u.pm * BM + wr * 64 + fr;
#pragma unroll
        for (int ai = 0; ai < 2; ++ai)
#pragma unroll
            for (int m = 0; m < 4; ++m) { const size_t row = (size_t)(row0 + ai * HALF + m * 16);
#pragma unroll
                for (int bj = 0; bj < 2; ++bj) { const int head = 2 * u.pn + bj; const f32x4 v0 = acc[ai][bj][m][0], v1 = acc[ai][bj][m][1];
                    if (wc < 2) { typedef unsigned u32x2v __attribute__((ext_vector_type(2))); u32x2v w8; w8.x = pk4_fp8(v0[0], v0[1], v0[2], v0[3]); w8.y = pk4_fp8(v1[0], v1[1], v1[2], v1[3]);
                        *(u32x2v*)(KD + row * 1024 + 128 * head + 32 * wc + 8 * fq) = w8; }
                    else { u32x4 w; w.x = cvt_pk_bf16(v0[0], v0[1]); w.y = cvt_pk_bf16(v0[2], v0[3]); w.z = cvt_pk_bf16(v1[0], v1[1]); w.w = cvt_pk_bf16(v1[2], v1[3]);
                        *(u32x4*)(VD + row * 512 + 64 * head + 32 * (wc - 2) + 8 * fq) = w; } } }
    }
};
struct MoeOrder {
    int nM, nN, nwg, G, c; unsigned t0, t1, t2, t3, t4;
    __device__ void init(int npanels, int N, int G_, int c_, const unsigned* pexp, int lane) { nM = npanels; nN = N / BM; nwg = nM * nN; G = G_; c = c_;
        t0 = __hip_atomic_load(pexp + lane, __ATOMIC_RELAXED, __HIP_MEMORY_SCOPE_AGENT); t1 = __hip_atomic_load(pexp + 64 + lane, __ATOMIC_RELAXED, __HIP_MEMORY_SCOPE_AGENT);
        t2 = __hip_atomic_load(pexp + 128 + lane, __ATOMIC_RELAXED, __HIP_MEMORY_SCOPE_AGENT); t3 = __hip_atomic_load(pexp + 192 + lane, __ATOMIC_RELAXED, __HIP_MEMORY_SCOPE_AGENT);
        t4 = __hip_atomic_load(pexp + 256 + lane, __ATOMIC_RELAXED, __HIP_MEMORY_SCOPE_AGENT); }
    __device__ bool next(int i, Unit& u) const {
        const long L = (long)i * G + c; if (L >= nwg) return false;
        int wgid = (int)L; { const int q = nwg / NXCD, r = nwg % NXCD, xcd = wgid % NXCD, off = wgid / NXCD; wgid = (xcd < r ? xcd * (q + 1) : r * (q + 1) + (xcd - r) * q) + off; }
        const int nig = WGM * nN, gid = wgid / nig, fm = gid * WGM, gsz = (nM - fm) < WGM ? (nM - fm) : WGM;
        u.pm = fm + ((wgid % nig) % gsz); u.pn = (wgid % nig) / gsz;
        const int k = u.pm >> 6; const unsigned tv = (k == 0) ? t0 : (k == 1) ? t1 : (k == 2) ? t2 : (k == 3) ? t3 : t4;
        u.e = __builtin_amdgcn_readlane((int)tv, u.pm & 63); return true;
    }
    __device__ __forceinline__ void a_ready(const Unit&) const {}
    __device__ __forceinline__ void done(const Unit&) const {}
};

template <class Epi, class Sched, bool ALIGN_EPI = false, bool SP2 = false, int F8 = 0>
__device__ __forceinline__ void gemm_phase(PG8_LAS unsigned char* lds, const Gemm g, const Sched& S, const Epi& E, int tid_in) {
    typedef int fr4_ __attribute__((ext_vector_type(4))); typedef int fr8_ __attribute__((ext_vector_type(8)));
    int tid_ = tid_in; asm volatile("" : "+v"(tid_));
    const int tid = tid_, wid = __builtin_amdgcn_readfirstlane(tid >> 6), lane = tid & 63, wr = wid >> 2, wc = wid & 3, fr = lane & 15, fq = lane >> 4;
    const int K = g.K, nt = K / BK;
    unsigned voffA[2], voffB[2];
#pragma unroll
    for (int i = 0; i < 2; ++i) { int R, C; stage_rc(tid * 16 + i * 8192, R, C); const int Rb = Epi::PERM ? ((R & ~31) + perm32(R & 31)) : R;
        voffA[i] = (unsigned)(R * K + C) * 2u; voffB[i] = (unsigned)(Rb * K + C) * 2u; }
    const size_t kstep = (size_t)(BK * 2);
    const size_t hstep = (size_t)HALF * K * 2;
    const size_t tstep = 2 * hstep;
    const unsigned ldsw = (unsigned)wid * 1024u;
    const int aoff = lds_byte(wr * 64 + fr, fq * 8), boff = lds_byte(wc * 32 + fr, fq * 8);
#define PG8_SA(b, h) (((b) * 2 + (h)) * HTB)
#define PG8_SB(b, h) ((4 + (b) * 2 + (h)) * HTB)
#define PG8_STAGE(bufoff, gbase, voff) do { _Pragma("unroll") for (int _i = 0; _i < 2; ++_i) \
        __builtin_amdgcn_global_load_lds((const unsigned*)((const char*)(gbase) + (voff)[_i]), (PG8_LAS unsigned*)(lds + (bufoff) + ldsw + _i * 8192), 16, 0, 0); } while (0)
#define PG8_LDA(dst, b, h) do { _Pragma("unroll") for (int m = 0; m < 4; ++m) { const fr4_ lo_ = *(const PG8_LAS fr4_*)(lds + PG8_SA(b, h) + aoff + m * 2048), hi_ = *(const PG8_LAS fr4_*)(lds + PG8_SA(b, h) + aoff + m * 2048 + 1024); \
        dst[m] = __builtin_shufflevector(lo_, hi_, 0, 1, 2, 3, 4, 5, 6, 7); } } while (0)
#define PG8_LDB(dst, b, h) do { _Pragma("unroll") for (int n = 0; n < 2; ++n) { const fr4_ lo_ = *(const PG8_LAS fr4_*)(lds + PG8_SB(b, h) + boff + n * 2048), hi_ = *(const PG8_LAS fr4_*)(lds + PG8_SB(b, h) + boff + n * 2048 + 1024); \
        dst[n] = __builtin_shufflevector(lo_, hi_, 0, 1, 2, 3, 4, 5, 6, 7); } } while (0)
#define PG8_MMA1(ACC, b4_, a4_) do { \
            if constexpr (F8 == 1) { typedef long l2_ __attribute__((ext_vector_type(2))); const l2_ b_ = __builtin_bit_cast(l2_, b4_), a_ = __builtin_bit_cast(l2_, a4_); \
                ACC = __builtin_amdgcn_mfma_f32_16x16x32_fp8_fp8(b_[0], a_[0], ACC, 0, 0, 0); ACC = __builtin_amdgcn_mfma_f32_16x16x32_fp8_fp8(b_[1], a_[1], ACC, 0, 0, 0); } \
            else ACC = __builtin_amdgcn_mfma_f32_16x16x32_bf16(__builtin_bit_cast(bf16x8, b4_), __builtin_bit_cast(bf16x8, a4_), ACC, 0, 0, 0); } while (0)
#define PG8_MMA(ai, bj, At, Bt) do { __builtin_amdgcn_s_setprio(1); \
      _Pragma("unroll") for (int m = 0; m < 4; ++m) _Pragma("unroll") for (int n = 0; n < 2; ++n) { \
        if constexpr (F8 == 2) asm volatile("v_mfma_scale_f32_16x16x128_f8f6f4 %0, %1, %2, %0, %3, %3 op_sel_hi:[0,0,0]" : "+v"(acc[ai][bj][m][n]) : "v"(Bt[n]), "v"(At[m]), "v"(mxscale_));     \
        else { const fr4_ b0_ = __builtin_shufflevector(Bt[n], Bt[n], 0, 1, 2, 3), a0_ = __builtin_shufflevector(At[m], At[m], 0, 1, 2, 3); PG8_MMA1(acc[ai][bj][m][n], b0_, a0_); \
               const fr4_ b1_ = __builtin_shufflevector(Bt[n], Bt[n], 4, 5, 6, 7), a1_ = __builtin_shufflevector(At[m], At[m], 4, 5, 6, 7); PG8_MMA1(acc[ai][bj][m][n], b1_, a1_); } } \
      __builtin_amdgcn_s_setprio(0); } while (0)
#define PG8_WAIT_V(n) asm volatile("s_waitcnt vmcnt(" #n ")" ::: "memory")
#define PG8_WAIT_L(n) asm volatile("s_waitcnt lgkmcnt(" #n ")" ::: "memory")
#define PG8_BAR __builtin_amdgcn_s_barrier()
#define PG8_SCHED __builtin_amdgcn_sched_barrier(0)
    int mxscale_ = 0x7F7F7F7F; asm volatile("" : "+v"(mxscale_));
    Unit cur, nxt; int ui = 0;
    if (!S.next(0, cur)) return;
    f32x4 acc[2][2][4][2];
#pragma unroll
    for (int a = 0; a < 2; ++a)
#pragma unroll
        for (int b = 0; b < 2; ++b)
#pragma unroll
            for (int m = 0; m < 4; ++m)
#pragma unroll
                for (int n = 0; n < 2; ++n) acc[a][b][m][n] = (f32x4){0.f, 0.f, 0.f, 0.f};
    fr8_ At[4], B0[2], B1[2];
    const char* cA = (const char*)g.A + (size_t)cur.pm * tstep; const char* cB = (const char*)g.Bt + (size_t)cur.e * g.bes + (size_t)cur.pn * tstep;
    S.a_ready(cur);
    if constexpr (SP2) {
        PG8_STAGE(PG8_SB(0, 0), cB, voffB); PG8_STAGE(PG8_SB(0, 1), cB + hstep, voffB); PG8_STAGE(PG8_SA(0, 0), cA, voffA); PG8_STAGE(PG8_SA(0, 1), cA + hstep, voffA);
        if (wr == 1) PG8_BAR;
        PG8_WAIT_V(2); PG8_BAR;
        PG8_STAGE(PG8_SB(1, 0), cB + kstep, voffB); PG8_STAGE(PG8_SA(1, 0), cA + kstep, voffA); PG8_STAGE(PG8_SB(1, 1), cB + hstep + kstep, voffB);
        PG8_WAIT_V(6); PG8_BAR;
    } else {
        PG8_STAGE(PG8_SB(0, 0), cB, voffB); PG8_STAGE(PG8_SA(0, 0), cA, voffA); PG8_STAGE(PG8_SB(0, 1), cB + hstep, voffB); PG8_STAGE(PG8_SA(0, 1), cA + hstep, voffA);
        if (wr == 1) PG8_BAR;
        PG8_WAIT_V(4); PG8_BAR;
        PG8_STAGE(PG8_SB(1, 0), cB + kstep, voffB); PG8_STAGE(PG8_SA(1, 0), cA + kstep, voffA); PG8_STAGE(PG8_SB(1, 1), cB + hstep + kstep, voffB);
        PG8_WAIT_V(6); PG8_BAR;
    }
    for (;;) {
        const bool has_next = S.next(ui + 1, nxt);
        const char* nA = has_next ? (const char*)g.A + (size_t)nxt.pm * tstep : cA; const char* nB = has_next ? (const char*)g.Bt + (size_t)nxt.e * g.bes + (size_t)nxt.pn * tstep : cB;
#pragma unroll 1
        for (int t = 0; t < nt; t += 2) {
            const bool last = (t == nt - 2);
            const char* a1 = cA + (size_t)(t + 1) * kstep;
            const char* a2 = last ? nA : cA + (size_t)(t + 2) * kstep; const char* b2 = last ? nB : cB + (size_t)(t + 2) * kstep;
            const char* a3 = a2 + kstep; const char* b3 = b2 + kstep;
            if (last && has_next) S.a_ready(nxt);
            if constexpr (SP2) {
            PG8_LDB(B0, 0, 0); PG8_LDB(B1, 0, 1); PG8_SCHED; PG8_LDA(At, 0, 0); PG8_STAGE(PG8_SA(1, 1), a1 + hstep, voffA);
            PG8_WAIT_V(8); PG8_WAIT_L(0); PG8_BAR; PG8_MMA(0, 0, At, B0); PG8_MMA(0, 1, At, B1); PG8_BAR; PG8_SCHED;
            PG8_LDA(At, 0, 1); PG8_STAGE(PG8_SB(0, 0), b2, voffB); PG8_STAGE(PG8_SB(0, 1), b2 + hstep, voffB); PG8_STAGE(PG8_SA(0, 0), a2, voffA);
            PG8_WAIT_V(8); PG8_WAIT_L(0); PG8_BAR; PG8_MMA(1, 0, At, B0); PG8_MMA(1, 1, At, B1); PG8_BAR; PG8_SCHED;
            PG8_LDB(B0, 1, 0); PG8_LDB(B1, 1, 1); PG8_SCHED; PG8_LDA(At, 1, 0); PG8_STAGE(PG8_SA(0, 1), a2 + hstep, voffA);
            PG8_WAIT_V(8); PG8_WAIT_L(0); PG8_BAR; PG8_MMA(0, 0, At, B0); PG8_MMA(0, 1, At, B1); PG8_BAR; PG8_SCHED;
            PG8_LDA(At, 1, 1); PG8_STAGE(PG8_SB(1, 0), b3, voffB); PG8_STAGE(PG8_SB(1, 1), b3 + hstep, voffB); PG8_STAGE(PG8_SA(1, 0), a3, voffA);
            PG8_WAIT_V(8); PG8_WAIT_L(0); PG8_BAR; PG8_MMA(1, 0, At, B0); PG8_MMA(1, 1, At, B1); PG8_BAR; PG8_SCHED;
            } else {
            PG8_LDB(B0, 0, 0); PG8_SCHED; PG8_LDA(At, 0, 0); PG8_STAGE(PG8_SA(1, 1), a1 + hstep, voffA);
            PG8_WAIT_L(8); PG8_BAR; PG8_WAIT_L(0); PG8_MMA(0, 0, At, B0); PG8_BAR; PG8_SCHED;
            PG8_LDB(B1, 0, 1); PG8_STAGE(PG8_SB(0, 0), b2, voffB);
            PG8_BAR; PG8_WAIT_L(0); PG8_MMA(0, 1, At, B1); PG8_BAR;
            PG8_LDA(At, 0, 1); PG8_STAGE(PG8_SA(0, 0), a2, voffA);
            PG8_BAR; PG8_WAIT_L(0); PG8_MMA(1, 0, At, B0); PG8_BAR; PG8_SCHED;
            PG8_STAGE(PG8_SB(0, 1), b2 + hstep, voffB);
            PG8_WAIT_V(6); PG8_BAR; PG8_MMA(1, 1, At, B1); PG8_BAR;
            PG8_LDB(B0, 1, 0); PG8_SCHED; PG8_LDA(At, 1, 0); PG8_STAGE(PG8_SA(0, 1), a2 + hstep, voffA);
            PG8_WAIT_L(8); PG8_BAR; PG8_WAIT_L(0); PG8_MMA(0, 0, At, B0); PG8_BAR; PG8_SCHED;
            PG8_LDB(B1, 1, 1); PG8_STAGE(PG8_SB(1, 0), b3, voffB);
            PG8_BAR; PG8_WAIT_L(0); PG8_MMA(0, 1, At, B1); PG8_BAR;
            PG8_LDA(At, 1, 1); PG8_STAGE(PG8_SA(1, 0), a3, voffA);
            PG8_BAR; PG8_WAIT_L(0); PG8_MMA(1, 0, At, B0); PG8_BAR; PG8_SCHED;
            PG8_STAGE(PG8_SB(1, 1), b3 + hstep, voffB);
            PG8_WAIT_V(6); PG8_BAR; PG8_MMA(1, 1, At, B1); PG8_BAR;
            }
        }
        if constexpr (F8 == 2) asm volatile("s_nop 15\n\ts_nop 15" ::: "memory");
        if constexpr (ALIGN_EPI) { if (wr == 0) PG8_BAR; }
        if constexpr (!Epi::AFTER_DRAIN) { E(acc, cur, wr, wc, fr, fq); S.done(cur); }
        if (!has_next) break;
#pragma unroll
        for (int a = 0; a < 2; ++a)
#pragma unroll
            for (int b = 0; b < 2; ++b)
#pragma unroll
                for (int m = 0; m < 4; ++m)
#pragma unroll
                    for (int n = 0; n < 2; ++n) acc[a][b][m][n] = (f32x4){0.f, 0.f, 0.f, 0.f};
        cur = nxt; cA = nA; cB = nB; ++ui;
        if constexpr (ALIGN_EPI) { if (wr == 1) PG8_BAR; }
    }
    PG8_WAIT_V(0);
    if constexpr (!ALIGN_EPI) { if (wr == 0) PG8_BAR; }
    PG8_BAR;
    if constexpr (Epi::AFTER_DRAIN) { E.fused(acc, cur, wr, wc, fr, fq, lds, wid, lane); S.done(cur); }
#undef PG8_SA
#undef PG8_SB
#undef PG8_STAGE
#undef PG8_LDA
#undef PG8_LDB
#undef PG8_MMA
#undef PG8_MMA1
#undef PG8_WAIT_V
#undef PG8_WAIT_L
#undef PG8_BAR
#undef PG8_SCHED
}
}

#define GAS __attribute__((address_space(1)))
#define LAS __attribute__((address_space(3)))
#define RLX_AGENT __ATOMIC_RELAXED, __HIP_MEMORY_SCOPE_AGENT
#define XB_TMO      128
#define XB_XCNT(j)  (256  + 64 * (j))
#define XB_XSUB(j)  (1280 + 64 * (j))
#define XB_XGEN(j)  (2304 + 64 * (j))
#define XB_TOP      3328
#define XB_TOPGEN   3392
#define XCD_BAR_WORDS 3456
#define XB_SPIN_CAP (1u << 18)

__device__ __forceinline__ unsigned xb_ld(unsigned* p)              { return __hip_atomic_load(p, __ATOMIC_RELAXED, __HIP_MEMORY_SCOPE_AGENT); }
__device__ __forceinline__ unsigned xb_add(unsigned* p, unsigned v) { return __hip_atomic_fetch_add(p, v, __ATOMIC_RELAXED, __HIP_MEMORY_SCOPE_AGENT); }
__device__ __forceinline__ unsigned xb_xcc_id() { return (unsigned)__builtin_amdgcn_s_getreg((3 << 11) | 20) & 0xFu; }
#define XB_SPIN(cond, bar) do { unsigned _sp = 0; while (cond) { __builtin_amdgcn_s_sleep(1); \
    if ((++_sp & 255u) == 0u) { if (xb_ld(&(bar)[XB_TMO])) break; if (_sp > XB_SPIN_CAP) { atomicAdd(&(bar)[XB_TMO], 1u); break; } } } } while (0)

struct XcdBarrier {
    unsigned* bar; unsigned x;
    volatile LAS unsigned* st;
};

__device__ __forceinline__ XcdBarrier xcd_barrier_post(unsigned* bar, volatile LAS unsigned* st) {
    XcdBarrier b; b.bar = bar; b.x = xb_xcc_id(); b.st = st;
    if (threadIdx.x == 0) (void)xb_add(&bar[XB_XCNT(b.x)], 1u);
    return b;
}
__device__ __forceinline__ void xcd_barrier_complete(unsigned* bar, unsigned x, unsigned& nloc, unsigned& nx) {
    const unsigned G = gridDim.x * gridDim.y * gridDim.z;
    unsigned sum, cnt, mine, sp = 0u;
    for (;;) {
        sum = 0u; cnt = 0u; mine = 0u;
#pragma unroll
        for (unsigned j = 0; j < 16; ++j) { const unsigned c = xb_ld(&bar[XB_XCNT(j)]); sum += c; cnt += (c > 0u) ? 1u : 0u; mine = (j == x) ? c : mine; }
        if (sum == G) break;
        __builtin_amdgcn_s_sleep(1);
        if ((++sp & 255u) == 0u) { if (xb_ld(&bar[XB_TMO])) break; if (sp > XB_SPIN_CAP) { atomicAdd(&bar[XB_TMO], 1u); break; } }
    }
    nloc = mine > 0u ? mine : 1u; nx = cnt > 0u ? cnt : 1u;
}

__device__ __forceinline__ void xcd_barrier(const XcdBarrier& b) {
    asm volatile("s_waitcnt vmcnt(0)" ::: "memory");
    __syncthreads();
    if (threadIdx.x == 0) {
        unsigned* bar = b.bar;
        __builtin_amdgcn_s_waitcnt(0);
        unsigned nloc = b.st[0], nx = b.st[1];
        if (nloc == 0u) { xcd_barrier_complete(bar, b.x, nloc, nx); b.st[0] = nloc; b.st[1] = nx; }
        const unsigned old = xb_add(&bar[XB_XSUB(b.x)], 1u);
        const unsigned gen = old / nloc;
        if (old + 1u == (gen + 1u) * nloc) {
            __builtin_amdgcn_fence(__ATOMIC_RELEASE, "agent");
            asm volatile("s_waitcnt vmcnt(0)" ::: "memory");
            const unsigned og = xb_add(&bar[XB_TOP], 1u);
            const unsigned tg = og / nx;
            if (og + 1u == (tg + 1u) * nx) xb_add(&bar[XB_TOPGEN], 1u);
            else XB_SPIN(xb_ld(&bar[XB_TOPGEN]) == tg, bar);
            __builtin_amdgcn_fence(__ATOMIC_ACQUIRE, "agent");
            xb_add(&bar[XB_XGEN(b.x)], 1u);
            asm volatile("s_waitcnt vmcnt(0)" ::: "memory");
        } else {
            XB_SPIN(xb_ld(&bar[XB_XGEN(b.x)]) == gen, bar);
            __builtin_amdgcn_fence(__ATOMIC_ACQUIRE, "agent");
            asm volatile("s_waitcnt vmcnt(0)" ::: "memory");
        }
    }
    __syncthreads();
}


namespace att {
using bf16x8 = __attribute__((ext_vector_type(8))) short;
using s16x4  = __attribute__((ext_vector_type(4))) short;
using f32x16 = __attribute__((ext_vector_type(16))) float;
using u32x4  = __attribute__((ext_vector_type(4))) unsigned;
typedef unsigned short bf16_t;
constexpr int NW = 8, QBLK = 32, KVBLK = 64, DV = 64;
constexpr float THR = 8.f;
#define ATT_SBAR() __builtin_amdgcn_sched_barrier(0)
__device__ __forceinline__ int crow(int r, int hi) { return (r & 3) + 8 * (r >> 2) + 4 * hi; }
__device__ __forceinline__ unsigned cvtpk(float lo, float hi) { unsigned r; asm volatile("v_cvt_pk_bf16_f32 %0, %1, %2" : "=v"(r) : "v"(lo), "v"(hi)); return r; }
template <int DK> __device__ __forceinline__ int kswz(int row, int chunk) {
    if (DK == 64) return row * 128 + ((chunk ^ ((row >> 1) & 7)) << 4);
    else          return row * 192 + ((chunk ^ ((row >> 2) & 3)) << 4);
}
__device__ __forceinline__ int v_st(int k, int c) { const int kk = (k & ~0xC) | ((k & 4) << 1) | ((k & 8) >> 1); return ((kk >> 3) * 2 + (c >> 5)) * 512 + ((kk & 7) * 32 + (c & 31)) * 2; }
__device__ __forceinline__ int v_rd_base(int lane) { return ((lane & 3) << 3) | (((lane >> 2) & 3) << 6) | (((lane >> 4) & 1) << 5) | (((lane >> 5) & 1) << 8); }
constexpr int v_rd_off(int d0, int ks, int half) { return d0 * 512 + ks * 2048 + half * 1024; }
template <int OFF> __device__ __forceinline__ s16x4 tr_read(int vb) { s16x4 r; asm volatile("ds_read_b64_tr_b16 %0, %1 offset:%2" : "=&v"(r) : "v"(vb), "i"(OFF) : "memory"); return r; }
template <int D0> __device__ __forceinline__ void pv_one(f32x16& od, int vb, bf16x8 pa0, bf16x8 pa1, bf16x8 pa2, bf16x8 pa3) {
    const s16x4 l0 = tr_read<v_rd_off(D0, 0, 0)>(vb), h0 = tr_read<v_rd_off(D0, 0, 1)>(vb), l1 = tr_read<v_rd_off(D0, 1, 0)>(vb), h1 = tr_read<v_rd_off(D0, 1, 1)>(vb);
    const s16x4 l2 = tr_read<v_rd_off(D0, 2, 0)>(vb), h2 = tr_read<v_rd_off(D0, 2, 1)>(vb), l3 = tr_read<v_rd_off(D0, 3, 0)>(vb), h3 = tr_read<v_rd_off(D0, 3, 1)>(vb);
    asm volatile("s_waitcnt lgkmcnt(0)" ::: "memory"); ATT_SBAR();
#define ATT_PK(L, H) (bf16x8){L[0], L[1], L[2], L[3], H[0], H[1], H[2], H[3]}
    od = __builtin_amdgcn_mfma_f32_32x32x16_bf16(pa0, ATT_PK(l0, h0), od, 0, 0, 0);
    od = __builtin_amdgcn_mfma_f32_32x32x16_bf16(pa1, ATT_PK(l1, h1), od, 0, 0, 0);
    od = __builtin_amdgcn_mfma_f32_32x32x16_bf16(pa2, ATT_PK(l2, h2), od, 0, 0, 0);
    od = __builtin_amdgcn_mfma_f32_32x32x16_bf16(pa3, ATT_PK(l3, h3), od, 0, 0, 0);
#undef ATT_PK
}
__device__ __forceinline__ void pv_d0(f32x16* o, int vb, bf16x8 pa0, bf16x8 pa1, bf16x8 pa2, bf16x8 pa3) { pv_one<0>(o[0], vb, pa0, pa1, pa2, pa3); pv_one<1>(o[1], vb, pa0, pa1, pa2, pa3); }
#define ATT_MX3(a, b, c) __builtin_fmaxf(__builtin_fmaxf((a), (b)), (c))
__device__ __forceinline__ void partialSM(f32x16& p0, f32x16& p1, float& mhat, f32x16& negm, float& alpha, bool first) {
    float a = ATT_MX3(p0[0], p0[1], p1[0]), b = ATT_MX3(p0[2], p0[3], p1[1]); a = ATT_MX3(a, p1[2], p1[3]);
#pragma unroll
    for (int r = 4; r < 16; r += 4) { a = ATT_MX3(a, p0[r], p0[r + 1]); b = ATT_MX3(b, p0[r + 2], p0[r + 3]); a = ATT_MX3(a, p1[r], p1[r + 1]); b = ATT_MX3(b, p1[r + 2], p1[r + 3]); }
    float pmax = fmaxf(a, b);
    { auto rr = __builtin_amdgcn_permlane32_swap(__float_as_uint(pmax), __float_as_uint(pmax), false, false); pmax = fmaxf(__uint_as_float(rr[0]), __uint_as_float(rr[1])); }
    alpha = 1.f;
    if (__builtin_expect(first || __any(pmax > THR), 0)) { const float dl = first ? pmax : fmaxf(pmax, 0.f); mhat += dl;
#pragma unroll
        for (int r = 0; r < 16; ++r) { p0[r] -= dl; p1[r] -= dl; }
#pragma unroll
        for (int r = 0; r < 16; ++r) negm[r] = -mhat;
        alpha = first ? 1.f : __builtin_amdgcn_exp2f(-dl); }
#pragma unroll
    for (int r = 0; r < 16; ++r) p0[r] = __builtin_amdgcn_exp2f(p0[r]);
}
__device__ __forceinline__ void finishSM(f32x16& p0, f32x16& p1, bf16x8& pa0, bf16x8& pa1, bf16x8& pa2, bf16x8& pa3) {
#pragma unroll
    for (int r = 0; r < 16; ++r) p1[r] = __builtin_amdgcn_exp2f(p1[r]);
#define ATT_PK4(P, BASE, OUT) do { unsigned a0 = cvtpk(P[BASE + 0], P[BASE + 1]), a1 = cvtpk(P[BASE + 2], P[BASE + 3]);   \
    unsigned b0 = cvtpk(P[BASE + 4], P[BASE + 5]), b1 = cvtpk(P[BASE + 6], P[BASE + 7]);                              \
    auto r0 = __builtin_amdgcn_permlane32_swap(a0, b0, false, false); auto r1 = __builtin_amdgcn_permlane32_swap(a1, b1, false, false); \
    u32x4 w = {r0[0], r1[0], r0[1], r1[1]}; OUT = *reinterpret_cast<bf16x8*>(&w); } while (0)
    ATT_PK4(p0, 0, pa0); ATT_PK4(p0, 8, pa1); ATT_PK4(p1, 0, pa2); ATT_PK4(p1, 8, pa3);
#undef ATT_PK4
}
__device__ __forceinline__ void lsum(f32x16& lacc, bf16x8 pa0, bf16x8 pa1, bf16x8 pa2, bf16x8 pa3) {
    const bf16x8 ones = {0x3F80, 0x3F80, 0x3F80, 0x3F80, 0x3F80, 0x3F80, 0x3F80, 0x3F80};
    lacc = __builtin_amdgcn_mfma_f32_32x32x16_bf16(pa0, ones, lacc, 0, 0, 0); lacc = __builtin_amdgcn_mfma_f32_32x32x16_bf16(pa1, ones, lacc, 0, 0, 0);
    lacc = __builtin_amdgcn_mfma_f32_32x32x16_bf16(pa2, ones, lacc, 0, 0, 0); lacc = __builtin_amdgcn_mfma_f32_32x32x16_bf16(pa3, ones, lacc, 0, 0, 0);
}
template <int DK> __device__ __forceinline__ void qkt(f32x16& p0, f32x16& p1, const char* Ks, const bf16x8* qr, const f32x16& negm, int r32, int hi) {
#pragma unroll
    for (int d0 = 0; d0 < DK / 16; ++d0) {
        const bf16x8 b0 = *reinterpret_cast<const bf16x8*>(Ks + kswz<DK>(r32, 2 * d0 + hi));
        const bf16x8 b1 = *reinterpret_cast<const bf16x8*>(Ks + kswz<DK>(32 + r32, 2 * d0 + hi));
        if (d0 == 0) { p0 = __builtin_amdgcn_mfma_f32_32x32x16_bf16(b0, qr[0], negm, 0, 0, 0); p1 = __builtin_amdgcn_mfma_f32_32x32x16_bf16(b1, qr[0], negm, 0, 0, 0); }
        else { p0 = __builtin_amdgcn_mfma_f32_32x32x16_bf16(b0, qr[d0], p0, 0, 0, 0); p1 = __builtin_amdgcn_mfma_f32_32x32x16_bf16(b1, qr[d0], p1, 0, 0, 0); } }
}
template <int DK> struct Lds { static constexpr int SHM_V = KVBLK * DV * 2, SHM_K = KVBLK * DK * 2, BYTES = 2 * SHM_V + 2 * SHM_K + NW * 64 * 4; };

template <int DK, int LDQ, int LDK, int LDV, int LDO>
__device__ __forceinline__ void attn_unit(const bf16_t* __restrict__ Qb, const bf16_t* __restrict__ Kh, const bf16_t* __restrict__ Vh, bf16_t* __restrict__ Ob, int nkeys, char* lds, int tid_in) {
    constexpr int SHM_V = Lds<DK>::SHM_V, SHM_K = Lds<DK>::SHM_K, NQD = DK / 16, KCH = DK / 8;
    int tid_ = tid_in; asm volatile("" : "+v"(tid_));
    const int tid = tid_, wid = tid >> 6, lane = tid & 63, r32 = lane & 31, hi = lane >> 5;
    char* V_lds = lds; char* K_lds = lds + 2 * SHM_V;
    float* al_l = (float*)(lds + 2 * SHM_V + 2 * SHM_K) + wid * 64;
    __syncthreads();
    float mhat = 0.f; f32x16 o[2] = {}; f32x16 lacc = {}; f32x16 negm = {}; bf16x8 qr[NQD];
    typedef const __attribute__((address_space(1))) bf16x8* gptr8;
    const bf16_t* Qw = Qb + (long)(wid * QBLK + r32) * LDQ + hi * 8;
#pragma unroll
    for (int d0 = 0; d0 < NQD; ++d0) qr[d0] = *(gptr8)(Qw + d0 * 16);
    const int vr = tid >> 3, vc = (tid & 7) * 8, vst = v_st(vr, vc);
    const int kp0 = tid, kr0 = kp0 / KCH, kc0 = kp0 % KCH, kst0 = kswz<DK>(kr0, kc0);
    const bool k2 = (DK == 96) && (tid < 256);
    const int kp1 = k2 ? tid + 512 : tid, kr1 = kp1 / KCH, kc1 = kp1 % KCH, kst1 = kswz<DK>(kr1, kc1);
    const int vb0 = (int)(uintptr_t)V_lds + v_rd_base(lane);
    struct { bf16x8 vs, ks0, ks1; } sr_[2];
#define ATT_SLOAD(i, k0) do { sr_[i].vs = *(gptr8)(&Vh[(long)((k0) + vr) * LDV + vc]); \
    sr_[i].ks0 = *(gptr8)(&Kh[(long)((k0) + kr0) * LDK + kc0 * 8]); \
    if (DK == 96) sr_[i].ks1 = *(gptr8)(&Kh[(long)((k0) + kr1) * LDK + kc1 * 8]); } while (0)
#define ATT_SWRITE(b, i) do { *(bf16x8*)(V_lds + (b) * SHM_V + vst) = sr_[i].vs; *(bf16x8*)(K_lds + (b) * SHM_K + kst0) = sr_[i].ks0; \
    if (DK == 96) { if (k2) *(bf16x8*)(K_lds + (b) * SHM_K + kst1) = sr_[i].ks1; } } while (0)
#define ATT_SWAIT() do { if (DK == 96) asm volatile("s_waitcnt vmcnt(3)" ::: "memory"); else asm volatile("s_waitcnt vmcnt(2)" ::: "memory"); } while (0)
#define ATT_RESC(a) do { if (__any((a) < 1.f)) { if (hi == 0) al_l[r32] = (a); asm volatile("s_waitcnt lgkmcnt(0)" ::: "memory"); \
    _Pragma("unroll") for (int r = 0; r < 16; ++r) { const float f_ = al_l[crow(r, hi)]; o[0][r] *= f_; o[1][r] *= f_; lacc[r] *= f_; } } } while (0)
    f32x16 pA0, pA1, pB0, pB1; float alA, alB; bf16x8 pa0, pa1, pa2, pa3; const int NT = nkeys / KVBLK;
    constexpr int SE = 0, SO = 1;
    ATT_SLOAD(SE, 0); asm volatile("s_waitcnt vmcnt(0)" ::: "memory"); ATT_SWRITE(0, SE); __syncthreads();
    qkt<DK>(pA0, pA1, K_lds, qr, negm, r32, hi); partialSM(pA0, pA1, mhat, negm, alA, true);
    ATT_SLOAD(SO, KVBLK); if (2 < NT) ATT_SLOAD(SE, 2 * KVBLK);
    if (2 < NT) ATT_SWAIT(); else asm volatile("s_waitcnt vmcnt(0)" ::: "memory");
    ATT_SWRITE(1, SO); __syncthreads();
    for (int j = 1; j + 1 < NT; j += 2) {
        ATT_SBAR(); qkt<DK>(pB0, pB1, K_lds + SHM_K, qr, negm, r32, hi);
        finishSM(pA0, pA1, pa0, pa1, pa2, pa3); ATT_SBAR();
        ATT_SLOAD(SO, (j + 2) * KVBLK); ATT_SBAR();
        pv_d0(o, vb0, pa0, pa1, pa2, pa3); lsum(lacc, pa0, pa1, pa2, pa3); partialSM(pB0, pB1, mhat, negm, alB, false);
        __syncthreads(); ATT_SWAIT(); ATT_SWRITE(0, SE);
        ATT_RESC(alB); __syncthreads();
        ATT_SBAR(); qkt<DK>(pA0, pA1, K_lds, qr, negm, r32, hi);
        finishSM(pB0, pB1, pa0, pa1, pa2, pa3); ATT_SBAR();
        if (j + 3 < NT) ATT_SLOAD(SE, (j + 3) * KVBLK); ATT_SBAR();
        pv_d0(o, vb0 + SHM_V, pa0, pa1, pa2, pa3); lsum(lacc, pa0, pa1, pa2, pa3); partialSM(pA0, pA1, mhat, negm, alA, false);
        __syncthreads(); if (j + 3 < NT) ATT_SWAIT(); else asm volatile("s_waitcnt vmcnt(0)" ::: "memory");
        ATT_SWRITE(1, SO);
        ATT_RESC(alA); __syncthreads();
    }
    ATT_SBAR(); qkt<DK>(pB0, pB1, K_lds + SHM_K, qr, negm, r32, hi);
    finishSM(pA0, pA1, pa0, pa1, pa2, pa3); ATT_SBAR();
    pv_d0(o, vb0, pa0, pa1, pa2, pa3); lsum(lacc, pa0, pa1, pa2, pa3); partialSM(pB0, pB1, mhat, negm, alB, false);
    __syncthreads(); ATT_RESC(alB);
    finishSM(pB0, pB1, pa0, pa1, pa2, pa3); ATT_SBAR();
    pv_d0(o, vb0 + SHM_V, pa0, pa1, pa2, pa3); lsum(lacc, pa0, pa1, pa2, pa3);
    __attribute__((address_space(1))) bf16_t* Ow = (__attribute__((address_space(1))) bf16_t*)(Ob + (long)(wid * QBLK) * LDO);
#pragma unroll
    for (int r = 0; r < 16; ++r) { const int orow = crow(r, hi); const float rl = __builtin_amdgcn_rcpf(lacc[r]);
#pragma unroll
        for (int d0 = 0; d0 < 2; ++d0) { const unsigned w = cvtpk(o[d0][r] * rl, 0.f); Ow[(long)orow * LDO + d0 * 32 + r32] = (bf16_t)(w & 0xffffu); } }
#undef ATT_SLOAD
#undef ATT_SWRITE
#undef ATT_SWAIT
#undef ATT_RESC
}

typedef __attribute__((address_space(3))) const char* lcp;
typedef short v4i16_t __attribute__((ext_vector_type(4)));
__device__ __forceinline__ unsigned cvtpk_b(float lo, float hi) { typedef float f2 __attribute__((ext_vector_type(2))); typedef __bf16 b2 __attribute__((ext_vector_type(2)));
    f2 v = {lo, hi}; b2 b = __builtin_convertvector(v, b2); return __builtin_bit_cast(unsigned, b); }
__device__ __forceinline__ int v3_st(int k, int c) { return (c >> 5) * 4096 + k * 64 + (c & 31) * 2; }
__device__ __forceinline__ int v3_rd_base(int lane) { return (4 * (lane >> 5) + ((lane & 15) >> 2)) * 64 + ((lane >> 4) & 1) * 32 + (lane & 3) * 8; }
constexpr int v3_rd_off(int d0, int ks) { return d0 * 4096 + ks * 1024; }
__device__ __forceinline__ bf16x8 vfrag3(lcp p) {
    const s16x4 l = __builtin_bit_cast(s16x4, __builtin_amdgcn_ds_read_tr16_b64_v4i16((__attribute__((address_space(3))) v4i16_t*)p));
    const s16x4 h = __builtin_bit_cast(s16x4, __builtin_amdgcn_ds_read_tr16_b64_v4i16((__attribute__((address_space(3))) v4i16_t*)(p + 512)));
    return (bf16x8){l[0], l[1], l[2], l[3], h[0], h[1], h[2], h[3]}; }
__device__ __forceinline__ bf16x8 vfrag(lcp p) {
    const s16x4 l = __builtin_bit_cast(s16x4, __builtin_amdgcn_ds_read_tr16_b64_v4i16((__attribute__((address_space(3))) v4i16_t*)p));
    const s16x4 h = __builtin_bit_cast(s16x4, __builtin_amdgcn_ds_read_tr16_b64_v4i16((__attribute__((address_space(3))) v4i16_t*)(p + 1024)));
    return (bf16x8){l[0], l[1], l[2], l[3], h[0], h[1], h[2], h[3]}; }
template <int DK> struct Lds3 { static constexpr int NSL = 6, SHM_V = KVBLK * DV * 2, SHM_K = KVBLK * DK * 2, OFF_K = NSL * SHM_V, OFF_AL = OFF_K + NSL * SHM_K, BYTES = OFF_AL + NW * 64 * 4; };
template <int DK, int LDQ, int LDK, int LDV, int LDO>
__device__ __forceinline__ void attn_unit3(const bf16_t* __restrict__ Qb, const bf16_t* __restrict__ Kh, const bf16_t* __restrict__ Vh, bf16_t* __restrict__ Ob, int nkeys, __attribute__((address_space(3))) char* lds, int tid_in) {
    constexpr int SHM_V = Lds3<DK>::SHM_V, SHM_K = Lds3<DK>::SHM_K, NQD = DK / 16, KCH = DK / 8;
    int tid_ = tid_in; asm volatile("" : "+v"(tid_));
    const int tid = tid_, wid = tid >> 6, lane = tid & 63, r32 = lane & 31, hi = lane >> 5;
    typedef __attribute__((address_space(3))) char* lp; typedef __attribute__((address_space(3))) bf16x8* lp8;
    const lp V_lds = lds; const lp K_lds = lds + Lds3<DK>::OFF_K;
    __attribute__((address_space(3))) float* al_l = (__attribute__((address_space(3))) float*)(lds + Lds3<DK>::OFF_AL) + wid * 64;
    typedef const __attribute__((address_space(1))) bf16x8* gptr8;
    float mhat = 0.f; f32x16 o0 = {}, o1 = {}, lacc = {}, negm = {}; bf16x8 qr[NQD];
    const bf16_t* Qw = Qb + (long)(wid * QBLK + r32) * LDQ + hi * 8;
#pragma unroll
    for (int d0 = 0; d0 < NQD; ++d0) qr[d0] = *(gptr8)(Qw + d0 * 16);
    const int vr = tid >> 3, vc = (tid & 7) * 8, vst = v3_st(vr, vc);
    const int kp0 = tid, kr0 = kp0 / KCH, kc0 = kp0 % KCH, kst0 = kswz<DK>(kr0, kc0);
    const bool k2 = (DK == 96) && (tid < 256);
    const int kp1 = k2 ? tid + 512 : tid, kr1 = kp1 / KCH, kc1 = kp1 % KCH, kst1 = kswz<DK>(kr1, kc1);
    const int vrd = v3_rd_base(lane);
    const int kq0 = kswz<DK>(r32, hi), kq1 = kswz<DK>(32 + r32, hi);
    bf16x8 sv[2], sk0[2], sk1[2];
#define A3_SLOAD(i, k0) do { sv[i] = *(gptr8)(&Vh[(long)((k0) + vr) * LDV + vc]); sk0[i] = *(gptr8)(&Kh[(long)((k0) + kr0) * LDK + kc0 * 8]); \
    if (DK == 96) sk1[i] = *(gptr8)(&Kh[(long)((k0) + kr1) * LDK + kc1 * 8]); } while (0)
#define A3_SWRITE(i, so) do { *(lp8)(V_lds + (so) * SHM_V + vst) = sv[i]; *(lp8)(K_lds + (so) * SHM_K + kst0) = sk0[i]; if (DK == 96) { if (k2) *(lp8)(K_lds + (so) * SHM_K + kst1) = sk1[i]; } } while (0)
#define A3_QKT(P0, P1, so) do { const lp kb_ = K_lds + (so) * SHM_K; \
    _Pragma("unroll") for (int d0 = 0; d0 < NQD; ++d0) { const bf16x8 b0_ = *(lp8)(kb_ + kswz<DK>(r32, 2 * d0 + hi)), b1_ = *(lp8)(kb_ + kswz<DK>(32 + r32, 2 * d0 + hi)); \
        if (d0 == 0) { P0 = __builtin_amdgcn_mfma_f32_32x32x16_bf16(b0_, qr[0], negm, 0, 0, 0); P1 = __builtin_amdgcn_mfma_f32_32x32x16_bf16(b1_, qr[0], negm, 0, 0, 0); } \
        else { P0 = __builtin_amdgcn_mfma_f32_32x32x16_bf16(b0_, qr[d0], P0, 0, 0, 0); P1 = __builtin_amdgcn_mfma_f32_32x32x16_bf16(b1_, qr[d0], P1, 0, 0, 0); } } } while (0)
#define A3_PK4(P, BASE, OUT) do { const u32x4 w_ = {cvtpk_b(P[BASE + 0], P[BASE + 1]), cvtpk_b(P[BASE + 2], P[BASE + 3]), cvtpk_b(P[BASE + 4], P[BASE + 5]), cvtpk_b(P[BASE + 6], P[BASE + 7])}; OUT = __builtin_bit_cast(bf16x8, w_); } while (0)
#define A3_ROWMAX(P0, P1, OUT) do { float a_ = ATT_MX3(P0[0], P0[1], P1[0]), b_ = ATT_MX3(P0[2], P0[3], P1[1]); a_ = ATT_MX3(a_, P1[2], P1[3]); \
    _Pragma("unroll") for (int r = 4; r < 16; r += 4) { a_ = ATT_MX3(a_, P0[r], P0[r + 1]); b_ = ATT_MX3(b_, P0[r + 2], P0[r + 3]); a_ = ATT_MX3(a_, P1[r], P1[r + 1]); b_ = ATT_MX3(b_, P1[r + 2], P1[r + 3]); } \
    float m_ = fmaxf(a_, b_); const auto rr_ = __builtin_amdgcn_permlane32_swap(__float_as_uint(m_), __float_as_uint(m_), false, false); OUT = fmaxf(__uint_as_float(rr_[0]), __uint_as_float(rr_[1])); } while (0)
#define A3_DECIDE(P0, P1, PMAX, FIRST, ALPHA) do { ALPHA = 1.f; if (__builtin_expect((FIRST) || __any(PMAX > THR), 0)) { const float dl_ = (FIRST) ? PMAX : fmaxf(PMAX, 0.f); mhat += dl_; const float nm_ = -mhat; \
    _Pragma("unroll") for (int r = 0; r < 16; ++r) { asm volatile("v_sub_f32_e32 %0, %0, %1" : "+v"(P0[r]) : "v"(dl_)); asm volatile("v_sub_f32_e32 %0, %0, %1" : "+v"(P1[r]) : "v"(dl_)); } \
    _Pragma("unroll") for (int r = 0; r < 16; ++r) asm volatile("v_mov_b32_e32 %0, %1" : "+v"(negm[r]) : "v"(nm_)); \
    ALPHA = (FIRST) ? 1.f : __builtin_amdgcn_exp2f(-dl_); } } while (0)
#define A3_EXP(P) do { _Pragma("unroll") for (int r = 0; r < 16; ++r) P[r] = __builtin_amdgcn_exp2f(P[r]); } while (0)
#define A3_RESC(a) do { if (__any((a) < 1.f)) { if (hi == 0) al_l[r32] = (a); \
    _Pragma("unroll") for (int r = 0; r < 16; ++r) { const float f_ = al_l[crow(r, hi)]; o0[r] *= f_; o1[r] *= f_; lacc[r] *= f_; } } } while (0)
    bf16x8 ones = {0x3F80, 0x3F80, 0x3F80, 0x3F80, 0x3F80, 0x3F80, 0x3F80, 0x3F80}; asm volatile("" : "+v"(ones));
#define A3_SB() __builtin_amdgcn_sched_barrier(0)
#define A3_KPF(d0, so) do { if (PREF && (d0) < NQD) { const lp kb_ = K_lds + (so) * SHM_K; kf_[2 * (d0)] = *(lp8)(kb_ + kswz<DK>(r32, 2 * (d0) + hi)); kf_[2 * (d0) + 1] = *(lp8)(kb_ + kswz<DK>(32 + r32, 2 * (d0) + hi)); } } while (0)
#define slot6(t) ((r0_ + ((t) - (s))) >= 6 ? (r0_ + ((t) - (s))) - 6 : (r0_ + ((t) - (s))))
#define A3_EX4(P, B) do { P[B] = __builtin_amdgcn_exp2f(P[B]); P[B + 1] = __builtin_amdgcn_exp2f(P[B + 1]); P[B + 2] = __builtin_amdgcn_exp2f(P[B + 2]); P[B + 3] = __builtin_amdgcn_exp2f(P[B + 3]); asm volatile("" : "+v"(P)); } while (0)
#define A3_MX4(P0, P1, B) do { mxa_ = ATT_MX3(mxa_, P0[B], P0[B + 1]); mxb_ = ATT_MX3(mxb_, P0[B + 2], P0[B + 3]); mxa_ = ATT_MX3(mxa_, P1[B], P1[B + 1]); mxb_ = ATT_MX3(mxb_, P1[B + 2], P1[B + 3]); } while (0)
#define A3_GAP1(g, P0, P1) do { \
    if (NQD == 4) { if ((g) == 0) A3_PK4(P0, 0, pa0); else if ((g) == 1) A3_PK4(P0, 8, pa1); else if ((g) == 2) A3_EX4(P1, 0); else if ((g) == 3) A3_EX4(P1, 4); else if ((g) == 4) A3_EX4(P1, 8); else if ((g) == 5) A3_EX4(P1, 12); \
                    else if ((g) == 6) A3_PK4(P1, 0, pa2); else A3_PK4(P1, 8, pa3); } \
    else { if ((g) == 0) A3_PK4(P0, 0, pa0); else if ((g) == 2) A3_PK4(P0, 8, pa1); else if ((g) == 3) A3_EX4(P1, 0); else if ((g) == 4) A3_EX4(P1, 4); else if ((g) == 5) A3_EX4(P1, 8); else if ((g) == 6) A3_EX4(P1, 12); \
           else if ((g) == 8) A3_PK4(P1, 0, pa2); else if ((g) == 10) A3_PK4(P1, 8, pa3); } } while (0)
#define A3_STEP(EVEN, s, P0, P1, N0, N1, sv_, sk_, skn_) do { float pmax_, alpha_; bf16x8 pa0, pa1, pa2, pa3; bf16x8 vf_[4]; \
    if (EVEN) { __syncthreads();        \
        if ((s) + 4 < NT) { A3_SWRITE(0, slot6((s) + 4)); A3_SWRITE(1, slot6((s) + 5)); } \
        if ((s) + 6 < NT) { A3_SLOAD(0, ((s) + 6) * KVBLK); A3_SLOAD(1, ((s) + 7) * KVBLK); } } \
    if (!PREF) { const lp kb_ = K_lds + (sk_) * SHM_K; \
      _Pragma("unroll") for (int d0 = 0; d0 < NQD; ++d0) { kf_[2 * d0] = *(lp8)(kb_ + kswz<DK>(r32, 2 * d0 + hi)); kf_[2 * d0 + 1] = *(lp8)(kb_ + kswz<DK>(32 + r32, 2 * d0 + hi)); } } \
    A3_SB(); \
    const lcp vp_ = (lcp)(V_lds + (sv_) * SHM_V + vrd); \
      \
    _Pragma("unroll") for (int d0 = 0; d0 < NQD; ++d0) { \
        if (d0 == 0) N0 = __builtin_amdgcn_mfma_f32_32x32x16_bf16(kf_[0], qr[0], negm, 0, 0, 0); else N0 = __builtin_amdgcn_mfma_f32_32x32x16_bf16(kf_[2 * d0], qr[d0], N0, 0, 0, 0); \
        A3_GAP1(2 * d0, P0, P1); A3_SB(); \
        if (d0 == 0) N1 = __builtin_amdgcn_mfma_f32_32x32x16_bf16(kf_[1], qr[0], negm, 0, 0, 0); else N1 = __builtin_amdgcn_mfma_f32_32x32x16_bf16(kf_[2 * d0 + 1], qr[d0], N1, 0, 0, 0); \
        if (d0 == NQD - 1) { vf_[0] = vfrag3(vp_ + v3_rd_off(0, 0)); vf_[1] = vfrag3(vp_ + v3_rd_off(0, 1)); vf_[2] = vfrag3(vp_ + v3_rd_off(0, 2)); vf_[3] = vfrag3(vp_ + v3_rd_off(0, 3)); } \
        A3_GAP1(2 * d0 + 1, P0, P1); A3_SB(); } \
      \
    { float mxa_ = ATT_MX3(N0[0], N0[1], N1[0]), mxb_ = ATT_MX3(N0[2], N0[3], N1[1]); \
      o0 = __builtin_amdgcn_mfma_f32_32x32x16_bf16(pa0, vf_[0], o0, 0, 0, 0); mxa_ = ATT_MX3(mxa_, N1[2], N1[3]); A3_MX4(N0, N1, 4); A3_SB(); \
      o0 = __builtin_amdgcn_mfma_f32_32x32x16_bf16(pa1, vf_[1], o0, 0, 0, 0); A3_MX4(N0, N1, 8); A3_SB(); \
      o0 = __builtin_amdgcn_mfma_f32_32x32x16_bf16(pa2, vf_[2], o0, 0, 0, 0); A3_MX4(N0, N1, 12); A3_SB(); \
      o0 = __builtin_amdgcn_mfma_f32_32x32x16_bf16(pa3, vf_[3], o0, 0, 0, 0); \
      vf_[0] = vfrag3(vp_ + v3_rd_off(1, 0)); vf_[1] = vfrag3(vp_ + v3_rd_off(1, 1)); vf_[2] = vfrag3(vp_ + v3_rd_off(1, 2)); vf_[3] = vfrag3(vp_ + v3_rd_off(1, 3)); \
      { float m_ = fmaxf(mxa_, mxb_); const auto rr_ = __builtin_amdgcn_permlane32_swap(__float_as_uint(m_), __float_as_uint(m_), false, false); pmax_ = fmaxf(__uint_as_float(rr_[0]), __uint_as_float(rr_[1])); } \
      A3_SB(); } \
    A3_DECIDE(N0, N1, pmax_, false, alpha_); \
    A3_SB(); \
      \
    lacc = __builtin_amdgcn_mfma_f32_32x32x16_bf16(pa0, ones, lacc, 0, 0, 0); A3_KPF(0, skn_); N0[0] = __builtin_amdgcn_exp2f(N0[0]); N0[1] = __builtin_amdgcn_exp2f(N0[1]); asm volatile("" : "+v"(N0)); A3_SB(); \
    lacc = __builtin_amdgcn_mfma_f32_32x32x16_bf16(pa1, ones, lacc, 0, 0, 0); A3_KPF(1, skn_); N0[2] = __builtin_amdgcn_exp2f(N0[2]); N0[3] = __builtin_amdgcn_exp2f(N0[3]); asm volatile("" : "+v"(N0)); A3_SB(); \
    lacc = __builtin_amdgcn_mfma_f32_32x32x16_bf16(pa2, ones, lacc, 0, 0, 0); A3_KPF(2, skn_); N0[4] = __builtin_amdgcn_exp2f(N0[4]); N0[5] = __builtin_amdgcn_exp2f(N0[5]); asm volatile("" : "+v"(N0)); A3_SB(); \
    lacc = __builtin_amdgcn_mfma_f32_32x32x16_bf16(pa3, ones, lacc, 0, 0, 0); A3_KPF(3, skn_); N0[6] = __builtin_amdgcn_exp2f(N0[6]); N0[7] = __builtin_amdgcn_exp2f(N0[7]); asm volatile("" : "+v"(N0)); A3_SB(); \
    o1 = __builtin_amdgcn_mfma_f32_32x32x16_bf16(pa0, vf_[0], o1, 0, 0, 0); N0[8] = __builtin_amdgcn_exp2f(N0[8]); N0[9] = __builtin_amdgcn_exp2f(N0[9]); asm volatile("" : "+v"(N0)); A3_SB(); \
    o1 = __builtin_amdgcn_mfma_f32_32x32x16_bf16(pa1, vf_[1], o1, 0, 0, 0); N0[10] = __builtin_amdgcn_exp2f(N0[10]); N0[11] = __builtin_amdgcn_exp2f(N0[11]); asm volatile("" : "+v"(N0)); A3_SB(); \
    o1 = __builtin_amdgcn_mfma_f32_32x32x16_bf16(pa2, vf_[2], o1, 0, 0, 0); N0[12] = __builtin_amdgcn_exp2f(N0[12]); N0[13] = __builtin_amdgcn_exp2f(N0[13]); asm volatile("" : "+v"(N0)); A3_SB(); \
    o1 = __builtin_amdgcn_mfma_f32_32x32x16_bf16(pa3, vf_[3], o1, 0, 0, 0); N0[14] = __builtin_amdgcn_exp2f(N0[14]); N0[15] = __builtin_amdgcn_exp2f(N0[15]); asm volatile("" : "+v"(N0)); A3_SB(); \
    if ((s) + 1 < NT) A3_RESC(alpha_); } while (0)
    const int NT = nkeys / KVBLK;
    constexpr bool PREF = true;
    bf16x8 kf_[2 * NQD];
    f32x16 pA0, pA1, pB0, pB1;
    __syncthreads();
    A3_SLOAD(0, 0); A3_SLOAD(1, KVBLK); A3_SWRITE(0, 0); A3_SWRITE(1, 1); A3_SLOAD(0, 2 * KVBLK); A3_SLOAD(1, 3 * KVBLK); A3_SWRITE(0, 2); A3_SWRITE(1, 3);
    if (4 < NT) { A3_SLOAD(0, 4 * KVBLK); A3_SLOAD(1, 5 * KVBLK); }
    __syncthreads();
    { float pmax_, alpha_; A3_QKT(pA0, pA1, 0); A3_ROWMAX(pA0, pA1, pmax_); A3_DECIDE(pA0, pA1, pmax_, true, alpha_); A3_EXP(pA0); (void)alpha_; }
    if (PREF) {
#pragma unroll
        for (int d0 = 0; d0 < NQD; ++d0) A3_KPF(d0, 1); }
    int r0_ = 0;
    for (int s = 0; s < NT; s += 2) {
        A3_STEP(true, s, pA0, pA1, pB0, pB1, r0_, r0_ + 1, (r0_ == 4 ? 0 : r0_ + 2));
        A3_STEP(false, s + 1, pB0, pB1, pA0, pA1, r0_ + 1, (r0_ == 4 ? 0 : r0_ + 2), (r0_ >= 3 ? r0_ - 3 : r0_ + 3));
        r0_ = (r0_ == 4) ? 0 : r0_ + 2;
    }
    __attribute__((address_space(1))) bf16_t* Ow = (__attribute__((address_space(1))) bf16_t*)(Ob + (long)(wid * QBLK) * LDO);
#pragma unroll
    for (int r = 0; r < 16; ++r) { const int orow = crow(r, hi); const float rl = __builtin_amdgcn_rcpf(lacc[r]);
        Ow[(long)orow * LDO + r32] = (bf16_t)(cvtpk_b(o0[r] * rl, 0.f) & 0xffffu); Ow[(long)orow * LDO + 32 + r32] = (bf16_t)(cvtpk_b(o1[r] * rl, 0.f) & 0xffffu); }
#undef A3_SLOAD
#undef A3_SWRITE
#undef A3_QKT
#undef A3_PK4
#undef A3_ROWMAX
#undef A3_DECIDE
#undef A3_EXP
#undef A3_RESC
#undef A3_STEP
#undef A3_SB
#undef A3_KPF
#undef slot6
#undef A3_EX4
#undef A3_MX4
#undef A3_GAP1
}
__device__ __forceinline__ unsigned pk4f8(float a, float b, float c, float d) { int w = 0; w = __builtin_amdgcn_cvt_pk_fp8_f32(a, b, w, false); w = __builtin_amdgcn_cvt_pk_fp8_f32(c, d, w, true); return (unsigned)w; }
template <int DK> struct Lds4 { static constexpr int NSL = 6, SHM_V = KVBLK * DV  , SHM_K = KVBLK * DK * 2, OFF_K = NSL * SHM_V, OFF_AL = OFF_K + NSL * SHM_K, BYTES = OFF_AL + NW * 64 * 4; };
template <int DK, int LDQ, int LDK, int LDO, bool QK8>
__device__ __forceinline__ void attn_unit4(const bf16_t* __restrict__ Qb, const bf16_t* __restrict__ Kh, const unsigned char* __restrict__ VT, bf16_t* __restrict__ Ob, int nkeys, __attribute__((address_space(3))) char* lds, int tid_in) {
    static_assert(QK8, "the tile step is written for e4m3 Q/K");
    constexpr int KRB = (DK == 64) ? 64 : 128, KPC = KRB / 16;
    constexpr int SHM_V = Lds4<DK>::SHM_V, SHM_K = Lds4<DK>::SHM_K, NQD = DK / 16, KCH = DK / 8;
    int tid_ = tid_in; asm volatile("" : "+v"(tid_));
    const int tid = tid_, wid = tid >> 6, lane = tid & 63, r32 = lane & 31, hi = lane >> 5;
    typedef __attribute__((address_space(3))) char* lp; typedef __attribute__((address_space(3))) bf16x8* lp8;
    const lp V_lds = lds; const lp K_lds = lds + Lds4<DK>::OFF_K;
    typedef const __attribute__((address_space(1))) bf16x8* gptr8;
    float mhat = 0.f; f32x16 o0 = {}, o1 = {}, negm = {}; typedef float f4v_ __attribute__((ext_vector_type(4))); f4v_ lacc = {}; bf16x8 qr[NQD];
    typedef int i8v __attribute__((ext_vector_type(8))); typedef int i4v __attribute__((ext_vector_type(4)));
    constexpr bool LSUMV = (DK == 96) && !QK8;
    float lsum_ = 0.f;
    i8v q8 = {};
    i8v q8b = {};
    if (QK8) { const unsigned char* Q8 = (const unsigned char*)Qb + (long)(wid * QBLK + r32) * LDQ + hi * 32; const i4v a_ = *(const __attribute__((address_space(1))) i4v*)Q8, b_ = *(const __attribute__((address_space(1))) i4v*)(Q8 + 16);
        q8 = __builtin_shufflevector(a_, b_, 0, 1, 2, 3, 4, 5, 6, 7);
        if (DK == 96) { const i4v c_ = *(const __attribute__((address_space(1))) i4v*)(Q8 + 64), d_ = *(const __attribute__((address_space(1))) i4v*)(Q8 + 80); q8b = __builtin_shufflevector(c_, d_, 0, 1, 2, 3, 4, 5, 6, 7); } }
    else { const bf16_t* Qw = Qb + (long)(wid * QBLK + r32) * LDQ + hi * 8;
#pragma unroll
        for (int d0 = 0; d0 < NQD; ++d0) qr[d0] = *(gptr8)(Qw + d0 * 16); }
    const int vpc = (tid & 255) * 16;
    const int kp0 = QK8 ? (DK == 64 ? (tid & 255) : tid) : tid, kr0 = QK8 ? kp0 / KPC : kp0 / KCH, kc0 = QK8 ? kp0 % KPC : kp0 % KCH;
    const int kst0 = QK8 ? kr0 * KRB + ((kc0 ^ (DK == 64 ? ((kr0 >> 2) & 3) : ((kr0 >> 1) & 7))) << 4) : kswz<DK>(kr0, kc0);
    const bool k2 = (DK == 96) && !QK8 && (tid < 256);
    const unsigned vpcu_ = (unsigned)vpc, koff_ = (unsigned)(kr0 * LDK + kc0 * 16);
    const __amdgpu_buffer_rsrc_t rsV_ = __builtin_amdgcn_make_buffer_rsrc((void*)VT, 0, 0x7fffffff, 0x27000), rsK_ = __builtin_amdgcn_make_buffer_rsrc((void*)Kh, 0, 0x7fffffff, 0x27000);
    const int kp1 = k2 ? tid + 512 : tid, kr1 = kp1 / KCH, kc1 = kp1 % KCH, kst1 = kswz<DK>(kr1, kc1);
    const int vrow = lane & 31, vsw = (vrow >> 2) & 3;
    const int vrd = vrow * 64 + (((2 * hi) ^ vsw) << 4), vrd2 = vrow * 64 + (((2 * hi + 1) ^ vsw) << 4);
    const int ksz_ = (DK == 64) ? ((r32 >> 2) & 3) : ((r32 >> 1) & 7);
    const int kq0 = r32 * KRB + (((2 * hi) ^ ksz_) << 4), kq1 = r32 * KRB + (((2 * hi + 1) ^ ksz_) << 4);
    const int kq2 = r32 * KRB + (((4 + 2 * hi) ^ ksz_) << 4), kq3 = r32 * KRB + (((5 + 2 * hi) ^ ksz_) << 4);
    i8v kq_[4];
    bf16x8 sv[2], sk0[2], sk1[2];
#define A3_SLOAD(i, k0) do {   \
    sv[i] = __builtin_bit_cast(bf16x8, __builtin_amdgcn_raw_buffer_load_b128(rsV_, vpcu_, (int)(((k0) / KVBLK) * 4096), 0)); \
    if (QK8) sk0[i] = __builtin_bit_cast(bf16x8, __builtin_amdgcn_raw_buffer_load_b128(rsK_, koff_, (int)((k0) * LDK), 0)); else sk0[i] = *(gptr8)(&Kh[(long)((k0) + kr0) * LDK + kc0 * 8]); \
    if (DK == 96 && !QK8) sk1[i] = *(gptr8)(&Kh[(long)((k0) + kr1) * LDK + kc1 * 8]); } while (0)
#define A3_SWRITE(i, so) do { if (tid < 256) *(lp8)(V_lds + (so) * SHM_V + vpc) = sv[i]; if (!QK8 || DK == 96 || tid < 256) *(lp8)(K_lds + (so) * SHM_K + kst0) = sk0[i]; if (DK == 96 && !QK8) { if (k2) *(lp8)(K_lds + (so) * SHM_K + kst1) = sk1[i]; } } while (0)
#define A3_MXQ(OUT, A8) asm volatile("v_mfma_scale_f32_32x32x64_f8f6f4 %0, %1, %2, %3, %4, %4 op_sel_hi:[0,0,0]" : "=&v"(OUT) : "v"(A8), "v"(q8), "v"(negm), "v"(mxs_))
#define A3_KLD8(so) do { const lp kb_ = K_lds + (so) * SHM_K; const i4v a_ = *(__attribute__((address_space(3))) i4v*)(kb_ + kq0), b_ = *(__attribute__((address_space(3))) i4v*)(kb_ + kq1), c_ = *(__attribute__((address_space(3))) i4v*)(kb_ + 32 * KRB + kq0), d_ = *(__attribute__((address_space(3))) i4v*)(kb_ + 32 * KRB + kq1); \
    kq_[0] = __builtin_shufflevector(a_, b_, 0, 1, 2, 3, 4, 5, 6, 7); kq_[1] = __builtin_shufflevector(c_, d_, 0, 1, 2, 3, 4, 5, 6, 7); \
    if (DK == 96) { const i4v e_ = *(__attribute__((address_space(3))) i4v*)(kb_ + kq2), f_ = *(__attribute__((address_space(3))) i4v*)(kb_ + kq3), g_ = *(__attribute__((address_space(3))) i4v*)(kb_ + 32 * KRB + kq2), h_ = *(__attribute__((address_space(3))) i4v*)(kb_ + 32 * KRB + kq3); \
        kq_[2] = __builtin_shufflevector(e_, f_, 0, 1, 2, 3, 4, 5, 6, 7); kq_[3] = __builtin_shufflevector(g_, h_, 0, 1, 2, 3, 4, 5, 6, 7); } } while (0)
#define A3_MXQ2(ACC, A8) asm volatile("v_mfma_scale_f32_32x32x64_f8f6f4 %0, %1, %2, %0, %3, %3 op_sel_hi:[0,0,0]" : "+v"(ACC) : "v"(A8), "v"(q8b), "v"(mxs_))
#define A3_QKT(P0, P1, so) do { if (QK8) { A3_KLD8(so); A3_MXQ(P0, kq_[0]); A3_MXQ(P1, kq_[1]); if (DK == 96) { asm volatile("s_nop 15\n\ts_nop 15" : "+v"(P0), "+v"(P1)); A3_MXQ2(P0, kq_[2]); A3_MXQ2(P1, kq_[3]); }     asm volatile("s_nop 15\n\ts_nop 15\n\ts_nop 15" : "+v"(P0), "+v"(P1)); } else { const lp kb_ = K_lds + (so) * SHM_K; \
    _Pragma("unroll") for (int d0 = 0; d0 < NQD; ++d0) { const bf16x8 b0_ = *(lp8)(kb_ + kswz<DK>(r32, 2 * d0 + hi)), b1_ = *(lp8)(kb_ + kswz<DK>(32 + r32, 2 * d0 + hi)); \
        if (d0 == 0) { P0 = __builtin_amdgcn_mfma_f32_32x32x16_bf16(b0_, qr[0], negm, 0, 0, 0); P1 = __builtin_amdgcn_mfma_f32_32x32x16_bf16(b1_, qr[0], negm, 0, 0, 0); } \
        else { P0 = __builtin_amdgcn_mfma_f32_32x32x16_bf16(b0_, qr[d0], P0, 0, 0, 0); P1 = __builtin_amdgcn_mfma_f32_32x32x16_bf16(b1_, qr[d0], P1, 0, 0, 0); } } } } while (0)
#define A3_PK4(P, BASE, IDX) do { p8_[IDX] = __builtin_amdgcn_cvt_pk_fp8_f32(P[BASE + 0], P[BASE + 1], p8_[IDX], false); p8_[IDX] = __builtin_amdgcn_cvt_pk_fp8_f32(P[BASE + 2], P[BASE + 3], p8_[IDX], true); \
    p8_[IDX + 1] = __builtin_amdgcn_cvt_pk_fp8_f32(P[BASE + 4], P[BASE + 5], p8_[IDX + 1], false); p8_[IDX + 1] = __builtin_amdgcn_cvt_pk_fp8_f32(P[BASE + 6], P[BASE + 7], p8_[IDX + 1], true); } while (0)
#define A3_ROWMAX(P0, P1, OUT) do { float a_ = ATT_MX3(P0[0], P0[1], P1[0]), b_ = ATT_MX3(P0[2], P0[3], P1[1]); a_ = ATT_MX3(a_, P1[2], P1[3]); \
    _Pragma("unroll") for (int r = 4; r < 16; r += 4) { a_ = ATT_MX3(a_, P0[r], P0[r + 1]); b_ = ATT_MX3(b_, P0[r + 2], P0[r + 3]); a_ = ATT_MX3(a_, P1[r], P1[r + 1]); b_ = ATT_MX3(b_, P1[r + 2], P1[r + 3]); } \
    float m_ = fmaxf(a_, b_); const auto rr_ = __builtin_amdgcn_permlane32_swap(__float_as_uint(m_), __float_as_uint(m_), false, false); OUT = fmaxf(__uint_as_float(rr_[0]), __uint_as_float(rr_[1])); } while (0)
#define A3_DECIDE(P0, P1, PMAX, FIRST, ALPHA) do { ALPHA = 1.f; if (__builtin_expect((FIRST) || __any(PMAX > THR), 0)) { const float dl_ = (FIRST) ? PMAX : fmaxf(PMAX, 0.f); mhat += dl_; const float nm_ = -mhat; \
    _Pragma("unroll") for (int r = 0; r < 16; ++r) { asm volatile("v_sub_f32_e32 %0, %0, %1" : "+v"(P0[r]) : "v"(dl_)); asm volatile("v_sub_f32_e32 %0, %0, %1" : "+v"(P1[r]) : "v"(dl_)); } \
    _Pragma("unroll") for (int r = 0; r < 16; ++r) asm volatile("v_mov_b32_e32 %0, %1" : "+v"(negm[r]) : "v"(nm_)); \
    ALPHA = (FIRST) ? 1.f : __builtin_amdgcn_exp2f(-dl_); } } while (0)
#define A3_DECIDE2(P0, P1, MH, ALPHA, RARE, BETWEEN) do { ALPHA = 1.f; RARE = __ballot(MH > THR) != 0ull; BETWEEN; if (__builtin_expect(RARE, 0)) {       \
    const auto rr_ = __builtin_amdgcn_permlane32_swap(__float_as_uint(MH), __float_as_uint(MH), false, false); const float pm_ = fmaxf(__uint_as_float(rr_[0]), __uint_as_float(rr_[1])); \
    const float dl_ = fmaxf(pm_, 0.f); mhat += dl_; const float nm_ = -mhat; \
    _Pragma("unroll") for (int r = 0; r < 16; ++r) { asm volatile("v_sub_f32_e32 %0, %0, %1" : "+v"(P0[r]) : "v"(dl_)); asm volatile("v_sub_f32_e32 %0, %0, %1" : "+v"(P1[r]) : "v"(dl_)); } \
    _Pragma("unroll") for (int r = 0; r < 16; ++r) asm volatile("v_mov_b32_e32 %0, %1" : "+v"(negm[r]) : "v"(nm_)); \
    ALPHA = __builtin_amdgcn_exp2f(-dl_); } } while (0)
#define A3_EXP(P) do { _Pragma("unroll") for (int r = 0; r < 16; ++r) P[r] = __builtin_amdgcn_exp2f(P[r]); } while (0)
#define A3_RESC2(a) do { { const float f_ = (a); asm volatile("s_nop 15\n\ts_nop 15" : "+v"(o0), "+v"(o1)); if (!LSUMV) asm volatile("" : "+v"(lacc)); \
    lsum_ *= f_; _Pragma("unroll") for (int r = 0; r < 16; ++r) { o0[r] *= f_; o1[r] *= f_; } if (!LSUMV) lacc *= f_; } } while (0)
#define A3_RESC(a) do { if (__any((a) < 1.f)) { const float f_ = (a); asm volatile("s_nop 15\n\ts_nop 15" : "+v"(o0), "+v"(o1)); if (!LSUMV) asm volatile("" : "+v"(lacc)); \
    lsum_ *= f_; _Pragma("unroll") for (int r = 0; r < 16; ++r) { o0[r] *= f_; o1[r] *= f_; } if (!LSUMV) lacc *= f_; } } while (0)
    const int onev_ = ((((lane >> 4) ^ lane) & 1) == 0) ? 0x38383838 : 0;
    i8v ones = {onev_, onev_, onev_, onev_, onev_, onev_, onev_, onev_}; asm volatile("" : "+v"(ones));
    int mxs_ = 0x7F7F7F7F; asm volatile("" : "+v"(mxs_));
#define A3_MXL(ACC, A8, B8) asm volatile("v_mfma_scale_f32_16x16x128_f8f6f4 %0, %1, %2, %0, %3, %3 op_sel_hi:[0,0,0]" : "+v"(ACC) : "v"(A8), "v"(B8), "v"(mxs_))
#define A3_MX0(ACC, A8, B8) asm volatile("v_mfma_scale_f32_32x32x64_f8f6f4 %0, %1, %2, %0, %3, %3 op_sel_hi:[0,0,0]" : "+v"(ACC) : "v"(A8), "v"(B8), "v"(mxs_))
#define A3_MX(ACC, A8, B8) asm volatile("s_nop 0\n\tv_mfma_scale_f32_32x32x64_f8f6f4 %0, %1, %2, %0, %3, %3 op_sel_hi:[0,0,0]" : "+v"(ACC) : "v"(A8), "v"(B8), "v"(mxs_))
#define A3_SB() __builtin_amdgcn_sched_barrier(0)
#define A3_KPF(d0, so) do { if (QK8) { if (PREF && (d0) == 0) A3_KLD8(so); } else if (PREF && (d0) < NQD) { const lp kb_ = K_lds + (so) * SHM_K; kf_[2 * (d0)] = *(lp8)(kb_ + kswz<DK>(r32, 2 * (d0) + hi)); kf_[2 * (d0) + 1] = *(lp8)(kb_ + kswz<DK>(32 + r32, 2 * (d0) + hi)); } } while (0)
#define slot6(t) ((r0_ + ((t) - (s))) >= 6 ? (r0_ + ((t) - (s))) - 6 : (r0_ + ((t) - (s))))
#define A3_EX8(P, B) do { _Pragma("unroll") for (int r_ = 0; r_ < 8; ++r_) P[(B) + r_] = __builtin_amdgcn_exp2f(P[(B) + r_]); asm volatile("" : "+v"(P)); } while (0)
#define A3_EX4(P, B) do { P[B] = __builtin_amdgcn_exp2f(P[B]); P[B + 1] = __builtin_amdgcn_exp2f(P[B + 1]); P[B + 2] = __builtin_amdgcn_exp2f(P[B + 2]); P[B + 3] = __builtin_amdgcn_exp2f(P[B + 3]); asm volatile("" : "+v"(P)); } while (0)
#define A3_MX4(P0, P1, B) do { mxa_ = ATT_MX3(mxa_, P0[B], P0[B + 1]); mxb_ = ATT_MX3(mxb_, P0[B + 2], P0[B + 3]); mxa_ = ATT_MX3(mxa_, P1[B], P1[B + 1]); mxb_ = ATT_MX3(mxb_, P1[B + 2], P1[B + 3]); } while (0)
#define A3_GAP1(g, P0, P1) do { \
    if (NQD == 4 || !LSUMV) { if ((g) == 0) A3_PK4(P0, 0, 0); else if ((g) == 1) A3_PK4(P0, 8, 2); else if ((g) == 2) A3_EX4(P1, 0); else if ((g) == 3) A3_EX4(P1, 4); else if ((g) == 4) A3_EX4(P1, 8); else if ((g) == 5) A3_EX4(P1, 12); \
                    else if ((g) == 6) A3_PK4(P1, 0, 4); else if ((g) == 7) A3_PK4(P1, 8, 6); } \
    else { if ((g) == 1) { if (LSUMV) { float s_ = (P0[0] + P0[1]) + (P0[2] + P0[3]); _Pragma("unroll") for (int r = 4; r < 16; r += 4) s_ += (P0[r] + P0[r + 1]) + (P0[r + 2] + P0[r + 3]); lsum_ += s_; } } \
           else if ((g) == 7) { if (LSUMV) lsum_ += ((P1[0] + P1[1]) + (P1[2] + P1[3])) + ((P1[4] + P1[5]) + (P1[6] + P1[7])); } else if ((g) == 9) { if (LSUMV) lsum_ += ((P1[8] + P1[9]) + (P1[10] + P1[11])) + ((P1[12] + P1[13]) + (P1[14] + P1[15])); } \
           else if ((g) == 0) A3_PK4(P0, 0, 0); else if ((g) == 2) A3_PK4(P0, 8, 2); else if ((g) == 3) A3_EX4(P1, 0); else if ((g) == 4) A3_EX4(P1, 4); else if ((g) == 5) A3_EX4(P1, 8); else if ((g) == 6) A3_EX4(P1, 12); \
           else if ((g) == 8) A3_PK4(P1, 0, 4); else if ((g) == 10) A3_PK4(P1, 8, 6); } } while (0)
#define A3_VTLD() do { const i4v a_ = *(__attribute__((address_space(3))) i4v*)(vp_ + vrd), b_ = *(__attribute__((address_space(3))) i4v*)(vp_ + vrd2), c_ = *(__attribute__((address_space(3))) i4v*)(vp_ + 2048 + vrd), d_ = *(__attribute__((address_space(3))) i4v*)(vp_ + 2048 + vrd2); \
    vt0_ = __builtin_shufflevector(a_, b_, 0, 1, 2, 3, 4, 5, 6, 7); vt1_ = __builtin_shufflevector(c_, d_, 0, 1, 2, 3, 4, 5, 6, 7); } while (0)
#define A3_EX2(P, B) do { P[B] = __builtin_amdgcn_exp2f(P[B]); P[(B) + 1] = __builtin_amdgcn_exp2f(P[(B) + 1]); asm volatile("" : "+v"(P)); A3_SB(); } while (0)
#define A3_STEP(EVEN, R0, s, P0, P1, N0, N1, sv_, sk_, skn_) do { float pmax_, alpha_; i8v vt0_, vt1_; \
    if (EVEN) { __syncthreads();        \
        if ((s) + 4 < NT) { A3_SWRITE(0, ((R0) + 4) % 6); A3_SWRITE(1, ((R0) + 5) % 6); }     \
        if ((s) + 6 < NT) { A3_SLOAD(0, ((s) + 6) * KVBLK); A3_SLOAD(1, ((s) + 7) * KVBLK); } } \
    if (!PREF) A3_KLD8(sk_); \
    A3_SB(); \
    const lp vp_ = V_lds + (sv_) * SHM_V; \
      \
    A3_MXQ(N0, kq_[0]); A3_SB(); A3_PK4(P0, 0, 0); A3_EX4(P1, 0); A3_SB(); \
    if (DK == 96) { A3_MXQ(N1, kq_[1]); A3_SB(); A3_VTLD(); } \
    A3_PK4(P0, 8, 2); A3_EX4(P1, 4); A3_SB(); \
    if (DK == 96) { A3_MXQ2(N0, kq_[2]); A3_SB(); } else { A3_MXQ(N1, kq_[1]); A3_SB(); A3_VTLD(); } \
    A3_EX4(P1, 8); A3_PK4(P1, 0, 4); A3_SB(); \
    if (DK == 96) { A3_MXQ2(N1, kq_[3]); A3_SB(); } \
    A3_EX4(P1, 12); A3_PK4(P1, 8, 6); A3_SB(); \
      \
    A3_MX(o0, vt0_, p8_); A3_SB(); \
    { float m0_, m1_, m2_, m3_;       \
      asm("v_max3_f32 %0, %4, %5, %6\n\tv_max3_f32 %1, %7, %8, %9\n\tv_max3_f32 %2, %10, %11, %12\n\tv_max3_f32 %3, %13, %14, %15\n\tv_max3_f32 %0, %0, %16, %17\n\tv_max3_f32 %1, %1, %18, %19" \
          : "=&v"(m0_), "=&v"(m1_), "=&v"(m2_), "=&v"(m3_) : "v"(N0[0]), "v"(N0[1]), "v"(N0[2]), "v"(N0[3]), "v"(N0[4]), "v"(N0[5]), "v"(N0[6]), "v"(N0[7]), "v"(N0[8]), "v"(N0[9]), "v"(N0[10]), "v"(N0[11]), "v"(N0[12]), "v"(N0[13]), "v"(N0[14]), "v"(N0[15])); \
      asm("v_max3_f32 %2, %2, %4, %5\n\tv_max3_f32 %3, %3, %6, %7\n\tv_max3_f32 %0, %0, %8, %9\n\tv_max3_f32 %1, %1, %10, %11\n\tv_max3_f32 %2, %2, %12, %13\n\tv_max3_f32 %3, %3, %14, %15\n\tv_max3_f32 %0, %0, %16, %17\n\tv_max3_f32 %1, %1, %18, %19\n\tv_max3_f32 %0, %0, %2, %3\n\tv_max_f32_e32 %0, %0, %1" \
          : "+v"(m0_), "+v"(m1_), "+v"(m2_), "+v"(m3_) : "v"(N1[0]), "v"(N1[1]), "v"(N1[2]), "v"(N1[3]), "v"(N1[4]), "v"(N1[5]), "v"(N1[6]), "v"(N1[7]), "v"(N1[8]), "v"(N1[9]), "v"(N1[10]), "v"(N1[11]), "v"(N1[12]), "v"(N1[13]), "v"(N1[14]), "v"(N1[15])); \
      pmax_ = m0_; \
      A3_SB(); \
      A3_MX0(o1, vt1_, p8_); A3_SB(); } \
    bool rare_; A3_DECIDE2(N0, N1, pmax_, alpha_, rare_, A3_KPF(0, skn_)); \
    A3_SB(); \
      \
    A3_EX8(N0, 0); A3_SB(); \
    if (!LSUMV) { A3_MXL(lacc, ones, p8_); A3_SB(); } \
    A3_EX8(N0, 8); A3_SB(); \
    if (rare_ && (s) + 1 < NT) A3_RESC2(alpha_); } while (0)
    const int NT = nkeys / KVBLK;
    constexpr bool PREF = true;
    bf16x8 kf_[2 * NQD];
    f32x16 pA0, pA1, pB0, pB1; i8v p8_ = {};
    __syncthreads();
    A3_SLOAD(0, 0); A3_SLOAD(1, KVBLK); A3_SWRITE(0, 0); A3_SWRITE(1, 1); A3_SLOAD(0, 2 * KVBLK); A3_SLOAD(1, 3 * KVBLK); A3_SWRITE(0, 2); A3_SWRITE(1, 3);
    if (4 < NT) { A3_SLOAD(0, 4 * KVBLK); A3_SLOAD(1, 5 * KVBLK); }
    __syncthreads();
    { float pmax_, alpha_; A3_QKT(pA0, pA1, 0); A3_ROWMAX(pA0, pA1, pmax_); A3_DECIDE(pA0, pA1, pmax_, true, alpha_); A3_EXP(pA0); (void)alpha_; }
    if (PREF) {
#pragma unroll
        for (int d0 = 0; d0 < NQD; ++d0) A3_KPF(d0, 1); }
    for (int s = 0; s < NT; s += 6) {
        A3_STEP(true, 0, s, pA0, pA1, pB0, pB1, 0, 1, 2);
        A3_STEP(false, 0, s + 1, pB0, pB1, pA0, pA1, 1, 2, 3);
        if (s + 2 >= NT) break;
        A3_STEP(true, 2, s + 2, pA0, pA1, pB0, pB1, 2, 3, 4);
        A3_STEP(false, 2, s + 3, pB0, pB1, pA0, pA1, 3, 4, 5);
        if (s + 4 >= NT) break;
        A3_STEP(true, 4, s + 4, pA0, pA1, pB0, pB1, 4, 5, 0);
        A3_STEP(false, 4, s + 5, pB0, pB1, pA0, pA1, 5, 0, 1);
    }
    asm volatile("s_nop 15\n\ts_nop 15" : "+v"(o0), "+v"(o1)); if (!LSUMV) asm volatile("" : "+v"(lacc));
    { float lt_ = (r32 & 16) ? lacc[1] : lacc[0];
        if (LSUMV) { const auto rr_ = __builtin_amdgcn_permlane32_swap(__float_as_uint(lsum_), __float_as_uint(lsum_), false, false); lt_ = __uint_as_float(rr_[0]) + __uint_as_float(rr_[1]); }
        const float rl = __builtin_amdgcn_rcpf(lt_);
        __attribute__((address_space(1))) bf16_t* Ow = (__attribute__((address_space(1))) bf16_t*)(Ob + (long)(wid * QBLK + r32) * LDO);
        typedef unsigned u4v_ __attribute__((ext_vector_type(4)));
#pragma unroll
        for (int blk = 0; blk < 2; ++blk)
#pragma unroll
            for (int j = 0; j < 2; ++j) { const int ga = 8 * j, gb = 8 * j + 4;
                const unsigned ax = blk ? cvtpk_b(o1[ga] * rl, o1[ga + 1] * rl) : cvtpk_b(o0[ga] * rl, o0[ga + 1] * rl), ay = blk ? cvtpk_b(o1[ga + 2] * rl, o1[ga + 3] * rl) : cvtpk_b(o0[ga + 2] * rl, o0[ga + 3] * rl);
                const unsigned bx = blk ? cvtpk_b(o1[gb] * rl, o1[gb + 1] * rl) : cvtpk_b(o0[gb] * rl, o0[gb + 1] * rl), by = blk ? cvtpk_b(o1[gb + 2] * rl, o1[gb + 3] * rl) : cvtpk_b(o0[gb + 2] * rl, o0[gb + 3] * rl);
                const auto rx = __builtin_amdgcn_permlane32_swap(ax, bx, false, false), ry = __builtin_amdgcn_permlane32_swap(ay, by, false, false);
                const u4v_ w = {rx[0], ry[0], rx[1], ry[1]};
                *(__attribute__((address_space(1))) u4v_*)(Ow + 32 * blk + 16 * j + 8 * hi) = w; } }
#undef A3_MX
#undef A3_MX0
#undef A3_MXL
#undef A3_MXQ
#undef A3_MXQ2
#undef A3_KLD8
#undef A3_SLOAD
#undef A3_SWRITE
#undef A3_QKT
#undef A3_PK4
#undef A3_ROWMAX
#undef A3_DECIDE
#undef A3_EXP
#undef A3_RESC
#undef A3_RESC2
#undef A3_STEP
#undef A3_SB
#undef A3_KPF
#undef slot6
#undef A3_EX4
#undef A3_EX8
#undef A3_MX4
#undef A3_GAP1
#undef A3_VTLD
#undef A3_DECIDE2
#undef A3_EX2
}
#undef ATT_SBAR
}

constexpr int NWAVES = 8;
constexpr int BATCH = 4, SEQ = 8192, CTXL = 256, D = 1024, ROWS_B = CTXL + SEQ, M = BATCH * ROWS_B, NPAN = M / 256;
constexpr int MLAT = BATCH * SEQ;
constexpr int AB_IN = 1536, CD_IN = 1440, CD_INP = 1536, DFF = 2816, NEXP = 8;
constexpr int MOE_ROWS = 2 * M + NEXP * 256;
constexpr float EPS = 1e-6f;
static_assert(M == 33792 && NPAN == 132 && NPAN == BATCH * pg8::PAN_B, "row layout");

#ifndef HDP_FP8
#define HDP_FP8 14
#endif
constexpr int FP8G2 = (HDP_FP8 & 8) != 0;
constexpr bool FP8F = (HDP_FP8 & 1) != 0, FP8M = (HDP_FP8 & 2) != 0, FP8D = FP8F || (HDP_FP8 & 4) != 0;
#ifndef HDP_MX
#define HDP_MX 2
#endif
constexpr int MXM = HDP_MX;
#ifndef HDP_MOE_SP2
#define HDP_MOE_SP2 0
#endif
constexpr bool MOE_SP2 = HDP_MOE_SP2 != 0;
#ifndef HDP_MOE_ALIGN
#define HDP_MOE_ALIGN 1
#endif
constexpr bool MOE_ALIGN = HDP_MOE_ALIGN != 0;
constexpr float WSC = 64.0f, WSC_INV = 1.0f / 64.0f;
constexpr size_t MiB = 1u << 20;
constexpr size_t WS_CTL = 0, CTL_ZERO_BYTES = 1 * MiB;
constexpr size_t WS_MOD = 1 * MiB;
constexpr size_t WS_TOPK = 2 * MiB;
constexpr size_t WS_TOKSLOT = 3 * MiB;
constexpr size_t WS_CNT = 3 * MiB + 512 * 1024;
constexpr size_t WS_PEXP = 3 * MiB + 768 * 1024;
constexpr size_t WS_ROPE = 4 * MiB;
constexpr size_t WS_WSMALL = 5 * MiB;
constexpr size_t EV_WIN = 0, EV_WS = 3 * MiB, EV_WPOOL = EV_WS + 128 * 1024, EV_WOUT = EV_WPOOL + 128 * 1024, EV_WGU = EV_WOUT + 2 * MiB, EV_WDN = EV_WGU + 11 * MiB, EV_STRIDE = EV_WDN + 5632 * 1024;
constexpr size_t WS_WODD = WS_WSMALL + 2 * EV_STRIDE;
constexpr size_t OD_WCD = 0, OD_WUQ = 3 * MiB, OD_WUKV = OD_WUQ + 576 * 1024, OD_WCDO = OD_WUKV + 512 * 1024, OD_STRIDE = OD_WCDO + 2 * MiB;
constexpr size_t WS_WMOE = (WS_WODD + 2 * OD_STRIDE + MiB - 1) / MiB * MiB;
constexpr size_t MOE_WGU = (size_t)5632 * 1024 * 2, MOE_WDN = (size_t)1024 * 2816 * 2, MOE_WDN_OFF = NEXP * MOE_WGU;
constexpr size_t MOE_WGU8 = (size_t)5632 * 1024, MOE_WDN8 = (size_t)1024 * 2816, MOE_WDN_OFF8 = NEXP * MOE_WGU8;
constexpr size_t WS_XS = WS_WMOE + NEXP * (MOE_WGU + MOE_WDN);
constexpr size_t WS_BIG = WS_XS + (size_t)M * D * 2;
constexpr size_t B_Z = 0;
constexpr size_t B_Y = B_Z + (size_t)M * 1536 * 2;
constexpr size_t B_HB = B_Y + (size_t)M * 1024 * 2;
constexpr size_t B_QC = B_Y + (size_t)M * 1024 * 2;
constexpr size_t B_KC = B_QC + (size_t)M * 512 * 2;
constexpr size_t B_CQN = B_KC + (size_t)M * 128 * 2;
constexpr size_t B_CKVN = B_CQN + (size_t)M * 384 * 2;
constexpr size_t B_QD = B_CKVN + (size_t)M * 256 * 2;
constexpr size_t B_KD = B_QD + (size_t)M * 768 * 2;
constexpr size_t B_VD = B_KD + (size_t)M * 768 * 2;
constexpr size_t B_VT8 = B_VD + (size_t)M * 512 * 2;
constexpr size_t B_QC8 = B_VT8 + (size_t)BATCH * 10 * (ROWS_B / 64) * 4096;
constexpr size_t B_KC8 = B_QC8 + (size_t)M * 512;
constexpr size_t B_ATT_END = B_KC8 + (size_t)M * 128;
constexpr size_t B_HS = 0;
constexpr size_t B_HM = B_HS + (size_t)MOE_ROWS * 1024 * 2;
constexpr size_t B_END = B_HM + (size_t)MOE_ROWS * 2816 * 2;
constexpr size_t B_H = B_END - (size_t)M * 1024 * 2;
static_assert(B_HB + (size_t)M * 2816 * 2 <= B_H && B_ATT_END <= B_H, "H must stay clear of the even-layer / attention buffers");
constexpr size_t WS_END = WS_BIG + B_END;

constexpr int RING_OFF = 0, RING_BYTES = 131072;
constexpr int LDSCTL_OFF = RING_BYTES, MISC_OFF = LDSCTL_OFF + 320;
constexpr int LDS_BYTES = 147456;
static_assert(att::Lds3<96>::BYTES <= RING_BYTES && att::Lds4<96>::BYTES <= RING_BYTES && pg8::STAGE_BYTES <= RING_BYTES, "LDS");

typedef unsigned short bf16;
typedef unsigned v4u __attribute__((ext_vector_type(4)));
typedef unsigned v2u __attribute__((ext_vector_type(2)));
typedef float f32x4 __attribute__((ext_vector_type(4)));
typedef short bf16x8 __attribute__((ext_vector_type(8)));
#define LDS_WAIT() asm volatile("s_waitcnt lgkmcnt(0)" ::: "memory")
#define VM_WAIT() asm volatile("s_waitcnt vmcnt(0)" ::: "memory")
__device__ __forceinline__ unsigned pk2(float lo, float hi) { unsigned r; asm volatile("v_cvt_pk_bf16_f32 %0, %1, %2" : "=v"(r) : "v"(lo), "v"(hi)); return r; }
__device__ __forceinline__ float bf_lo(unsigned w) { return __uint_as_float(w << 16); }
__device__ __forceinline__ float bf_hi(unsigned w) { return __uint_as_float(w & 0xffff0000u); }
__device__ __forceinline__ float bf1(unsigned short h) { return __uint_as_float(((unsigned)h) << 16); }
__device__ __forceinline__ float wave_sum(float v) {
#pragma unroll
    for (int o = 1; o < 64; o <<= 1) v += __shfl_xor(v, o);
    return v;
}
typedef unsigned short xs_t;
__device__ __forceinline__ v2u xs_ld(const xs_t* XS, size_t row, int lane, int q) { return *((const v2u*)(XS + row * D) + lane + 64 * q); }
__device__ __forceinline__ f32x4 xs_cvt(v2u r) { return (f32x4){bf_lo(r.x), bf_hi(r.x), bf_lo(r.y), bf_hi(r.y)}; }
__device__ __forceinline__ void xs_st(xs_t* XS, size_t row, int lane, int q, f32x4 v) { v2u o; o.x = pk2(v[0], v[1]); o.y = pk2(v[2], v[3]); *((v2u*)(XS + row * D) + lane + 64 * q) = o; }

struct Args { const float* in[29]; float* out; unsigned char* ws; int ph_lo, ph_hi; };
enum { I_X = 0, I_C, I_CTX, I_CCTX, I_ADAW, I_ADAB, I_ABWIN, I_AVGAIN, I_AWS, I_ABS, I_BWPOOL, I_BSCALE, I_ABWOUT, I_FFNG, I_FFNU, I_FFND, I_CDWIN, I_CQGAIN, I_CKGAIN, I_DCQGAIN,
       I_DCKVGAIN, I_DWUQ, I_DWUKV, I_CDWOUT, I_ROUTER, I_MOEG, I_MOEU, I_MOED, I_FGAIN };
struct Ctx {
    LAS unsigned char* lds; unsigned char* ldsg;
    int tid, lane, wave, vcu, G, bx;
    GAS unsigned char* ws;
};
__device__ __forceinline__ int modrow_of_row(int row) { const int b = row / ROWS_B; return (row - b * ROWS_B < CTXL) ? 4 : b; }

__device__ __forceinline__ void tr_item(const float* W, int K, int N, bf16* WT, int il, int off, LAS float* scr, int item, int lane) {
    const int nblk = N / 32, kb = item / nblk, nb = item - kb * nblk, k0 = 64 * kb, n0 = 32 * nb;
    float wv[32];
#pragma unroll
    for (int i = 0; i < 32; ++i) wv[i] = W[(size_t)(k0 + 2 * i + (lane >> 5)) * N + n0 + (lane & 31)];
#pragma unroll
    for (int i = 0; i < 32; ++i) scr[(2 * i + (lane >> 5)) * 33 + (lane & 31)] = wv[i];
    LDS_WAIT(); asm volatile("" ::: "memory");
    const int c = lane & 7;
#pragma unroll
    for (int j = 0; j < 4; ++j) { const int n = (lane >> 3) + 8 * j; const LAS float* s = scr + (8 * c) * 33 + n;
        v4u o; o.x = pk2(s[0 * 33], s[1 * 33]); o.y = pk2(s[2 * 33], s[3 * 33]); o.z = pk2(s[4 * 33], s[5 * 33]); o.w = pk2(s[6 * 33], s[7 * 33]);
        const int nn = n0 + n; const int drow = il ? ((nn >> 7) * 256 + (nn & 127) + off) : (nn + off);
        *(v4u*)(WT + (size_t)drow * K + k0 + 8 * c) = o; }
    LDS_WAIT(); asm volatile("" ::: "memory");
}
__device__ __forceinline__ void tr_item8(const float* W, int K, int N, unsigned char* WT, int il, int off, LAS float* scr, int item, int lane) {
    const int nblk = N / 32, kb = item / nblk, nb = item - kb * nblk, k0 = 64 * kb, n0 = 32 * nb;
    float wv[32];
#pragma unroll
    for (int i = 0; i < 32; ++i) wv[i] = W[(size_t)(k0 + 2 * i + (lane >> 5)) * N + n0 + (lane & 31)];
#pragma unroll
    for (int i = 0; i < 32; ++i) scr[(2 * i + (lane >> 5)) * 33 + (lane & 31)] = wv[i];
    LDS_WAIT(); asm volatile("" ::: "memory");
    const int n = lane >> 1, hf = lane & 1; const LAS float* s = scr + (32 * hf) * 33 + n;
    v4u o0, o1;
    o0.x = pg8::pk4_fp8(s[0 * 33] * WSC, s[1 * 33] * WSC, s[2 * 33] * WSC, s[3 * 33] * WSC);     o0.y = pg8::pk4_fp8(s[4 * 33] * WSC, s[5 * 33] * WSC, s[6 * 33] * WSC, s[7 * 33] * WSC);
    o0.z = pg8::pk4_fp8(s[8 * 33] * WSC, s[9 * 33] * WSC, s[10 * 33] * WSC, s[11 * 33] * WSC);   o0.w = pg8::pk4_fp8(s[12 * 33] * WSC, s[13 * 33] * WSC, s[14 * 33] * WSC, s[15 * 33] * WSC);
    o1.x = pg8::pk4_fp8(s[16 * 33] * WSC, s[17 * 33] * WSC, s[18 * 33] * WSC, s[19 * 33] * WSC); o1.y = pg8::pk4_fp8(s[20 * 33] * WSC, s[21 * 33] * WSC, s[22 * 33] * WSC, s[23 * 33] * WSC);
    o1.z = pg8::pk4_fp8(s[24 * 33] * WSC, s[25 * 33] * WSC, s[26 * 33] * WSC, s[27 * 33] * WSC); o1.w = pg8::pk4_fp8(s[28 * 33] * WSC, s[29 * 33] * WSC, s[30 * 33] * WSC, s[31 * 33] * WSC);
    const int nn = n0 + n; const int drow = il ? ((nn >> 7) * 256 + (nn & 127) + off) : (nn + off);
    unsigned char* dst = WT + (size_t)drow * K + k0 + 32 * hf;
    *(v4u*)dst = o0; *(v4u*)(dst + 16) = o1;
    LDS_WAIT(); asm volatile("" ::: "memory");
}
__device__ __forceinline__ void tr8_load(const float* W, int N, int item, int lane, float (&wv)[32]) {
    const int nblk = N / 32, kb = item / nblk, nb = item - kb * nblk, k0 = 64 * kb, n0 = 32 * nb;
#pragma unroll
    for (int i = 0; i < 32; ++i) wv[i] = W[(size_t)(k0 + 2 * i + (lane >> 5)) * N + n0 + (lane & 31)];
}
__device__ __forceinline__ void tr8_store(const float (&wv)[32], int K, int N, unsigned char* WT, int il, int off, LAS float* scr, int item, int lane) {
    const int nblk = N / 32, kb = item / nblk, nb = item - kb * nblk, k0 = 64 * kb, n0 = 32 * nb;
#pragma unroll
    for (int i = 0; i < 32; ++i) scr[(2 * i + (lane >> 5)) * 33 + (lane & 31)] = wv[i];
    LDS_WAIT(); asm volatile("" ::: "memory");
    const int n = lane >> 1, hf = lane & 1; const LAS float* s = scr + (32 * hf) * 33 + n;
    v4u o0, o1;
    o0.x = pg8::pk4_fp8(s[0 * 33] * WSC, s[1 * 33] * WSC, s[2 * 33] * WSC, s[3 * 33] * WSC);     o0.y = pg8::pk4_fp8(s[4 * 33] * WSC, s[5 * 33] * WSC, s[6 * 33] * WSC, s[7 * 33] * WSC);
    o0.z = pg8::pk4_fp8(s[8 * 33] * WSC, s[9 * 33] * WSC, s[10 * 33] * WSC, s[11 * 33] * WSC);   o0.w = pg8::pk4_fp8(s[12 * 33] * WSC, s[13 * 33] * WSC, s[14 * 33] * WSC, s[15 * 33] * WSC);
    o1.x = pg8::pk4_fp8(s[16 * 33] * WSC, s[17 * 33] * WSC, s[18 * 33] * WSC, s[19 * 33] * WSC); o1.y = pg8::pk4_fp8(s[20 * 33] * WSC, s[21 * 33] * WSC, s[22 * 33] * WSC, s[23 * 33] * WSC);
    o1.z = pg8::pk4_fp8(s[24 * 33] * WSC, s[25 * 33] * WSC, s[26 * 33] * WSC, s[27 * 33] * WSC); o1.w = pg8::pk4_fp8(s[28 * 33] * WSC, s[29 * 33] * WSC, s[30 * 33] * WSC, s[31 * 33] * WSC);
    const int nn = n0 + n; const int drow = il ? ((nn >> 7) * 256 + (nn & 127) + off) : (nn + off);
    unsigned char* dst = WT + (size_t)drow * K + k0 + 32 * hf;
    *(v4u*)dst = o0; *(v4u*)(dst + 16) = o1;
    LDS_WAIT(); asm volatile("" ::: "memory");
}
struct MatDesc { const float* W; bf16* WT; int K, N, il, off, f8; };
__device__ __forceinline__ MatDesc small_desc(const Args& a, unsigned char* ws, int m) {
    const int i = m / 13, k = m - i * 13; MatDesc d; d.il = 0; d.off = 0; d.f8 = (((FP8F || (FP8G2 && i == 1)) && (k == 6 || k == 7)) || (FP8D && k == 8)) ? 1 : 0;
    unsigned char* ev = ws + WS_WSMALL + (size_t)i * EV_STRIDE; unsigned char* od = ws + WS_WODD + (size_t)i * OD_STRIDE;
    if (k == 0)       { d.W = a.in[I_ABWIN] + (size_t)i * 1024 * 1536; d.K = 1024; d.N = 1536; d.WT = (bf16*)(ev + EV_WIN); }
    else if (k <= 4)  { d.W = a.in[I_BWPOOL] + (size_t)(i * 4 + k - 1) * 128 * 128; d.K = 128; d.N = 128; d.WT = (bf16*)(ev + EV_WPOOL) + (size_t)(k - 1) * 128 * 128; }
    else if (k == 5)  { d.W = a.in[I_ABWOUT] + (size_t)i * 1024 * 1024; d.K = 1024; d.N = 1024; d.WT = (bf16*)(ev + EV_WOUT); }
    else if (k == 6)  { d.W = a.in[I_FFNG] + (size_t)i * 1024 * DFF; d.K = 1024; d.N = DFF; d.WT = (bf16*)(ev + EV_WGU); d.il = 1; }
    else if (k == 7)  { d.W = a.in[I_FFNU] + (size_t)i * 1024 * DFF; d.K = 1024; d.N = DFF; d.WT = (bf16*)(ev + EV_WGU); d.il = 1; d.off = 128; }
    else if (k == 8)  { d.W = a.in[I_FFND] + (size_t)i * DFF * 1024; d.K = DFF; d.N = 1024; d.WT = (bf16*)(ev + EV_WDN); }
    else if (k == 9)  { d.W = a.in[I_CDWIN] + (size_t)i * 1024 * CD_IN; d.K = 1024; d.N = CD_IN; d.WT = (bf16*)(od + OD_WCD); }
    else if (k == 10) { d.W = a.in[I_DWUQ] + (size_t)i * 384 * 768; d.K = 384; d.N = 768; d.WT = (bf16*)(od + OD_WUQ); }
    else if (k == 11) { d.W = a.in[I_DWUKV] + (size_t)i * 256 * 1024; d.K = 256; d.N = 1024; d.WT = (bf16*)(od + OD_WUKV); }
    else              { d.W = a.in[I_CDWOUT] + (size_t)i * 1024 * 1024; d.K = 1024; d.N = 1024; d.WT = (bf16*)(od + OD_WCDO); }
    return d;
}
__device__ __forceinline__ MatDesc moe_desc(const Args& a, unsigned char* ws, int li, int m) {
    const int e = m / 3, k = m - e * 3; MatDesc d; d.il = 0; d.off = 0; d.f8 = FP8M ? 1 : 0;
    const size_t wgu = FP8M ? MOE_WGU8 : MOE_WGU, wdn = FP8M ? MOE_WDN8 : MOE_WDN, wdo = FP8M ? MOE_WDN_OFF8 : MOE_WDN_OFF;
    if (k == 0)      { d.W = a.in[I_MOEG] + (size_t)(li * NEXP + e) * 1024 * DFF; d.K = 1024; d.N = DFF; d.WT = (bf16*)(ws + WS_WMOE + (size_t)e * wgu); d.il = 1; }
    else if (k == 1) { d.W = a.in[I_MOEU] + (size_t)(li * NEXP + e) * 1024 * DFF; d.K = 1024; d.N = DFF; d.WT = (bf16*)(ws + WS_WMOE + (size_t)e * wgu); d.il = 1; d.off = 128; }
    else             { d.W = a.in[I_MOED] + (size_t)(li * NEXP + e) * DFF * 1024; d.K = DFF; d.N = 1024; d.WT = (bf16*)(ws + WS_WMOE + wdo + (size_t)e * wdn); }
    return d;
}
__device__ __forceinline__ void convert_small(const Ctx& F, const Args& a) {
    LAS float* scr = (LAS float*)(F.lds + RING_OFF + F.wave * 16384);
    const int gw = F.vcu * NWAVES + F.wave, NGW = F.G * NWAVES;
    int it = gw, base = 0;
    for (int m = 0; m < 26; ++m) { const MatDesc d = small_desc(a, (unsigned char*)F.ws, m); const int items = (d.K / 64) * (d.N / 32);
        for (; it < base + items; it += NGW) { if (d.f8) tr_item8(d.W, d.K, d.N, (unsigned char*)d.WT, d.il, d.off, scr, it - base, F.lane); else tr_item(d.W, d.K, d.N, d.WT, d.il, d.off, scr, it - base, F.lane); }
        base += items; }
    const int gt = F.vcu * (NWAVES * 64) + F.tid, NGT = F.G * NWAVES * 64;
    for (int i = gt; i < 2 * 96 * 1024 / 8; i += NGT) { const int l = i / (96 * 128), r = i - l * (96 * 128);
        *(v4u*)(F.ws + WS_WODD + (size_t)l * OD_STRIDE + OD_WCD + (size_t)CD_IN * 1024 * 2 + (size_t)r * 16) = (v4u){0u, 0u, 0u, 0u}; }
    for (int i = gt; i < 2 * 4 * 128 * 128 / 8; i += NGT) { const int l = i / (4 * 128 * 128 / 8), r = i - l * (4 * 128 * 128 / 8);
        const f32x4 x0 = *(const f32x4*)(a.in[I_AWS] + (size_t)i * 8), x1 = *(const f32x4*)(a.in[I_AWS] + (size_t)i * 8 + 4);
        v4u o; o.x = pk2(x0[0], x0[1]); o.y = pk2(x0[2], x0[3]); o.z = pk2(x1[0], x1[1]); o.w = pk2(x1[2], x1[3]);
        *(v4u*)(F.ws + WS_WSMALL + (size_t)l * EV_STRIDE + EV_WS + (size_t)r * 16) = o; }
}
__device__ __forceinline__ void rope_table(const Ctx& F) {
    const int gt = F.vcu * (NWAVES * 64) + F.tid, NGT = F.G * NWAVES * 64; float* T = (float*)(F.ws + WS_ROPE);
    for (int i = gt; i < SEQ * 32; i += NGT) { const int s = i >> 5, k = i & 31, t = k & 15;
        const float ang = (float)((t < 8) ? (s >> 6) : (s & 63)) * __builtin_amdgcn_exp2f(-(float)(t & 7) * (13.287712379549449f / 8.0f));
        T[i] = (k < 16) ? __cosf(ang) : __sinf(ang); }
}
__device__ __forceinline__ void convert_moe(const Ctx& F, const Args& a, int li, int gw, int NGW) {
    LAS float* scr = (LAS float*)(F.lds + RING_OFF + F.wave * 16384);
    int it = gw, base = 0;
    if (FP8M) {
        constexpr int IPM = (1024 / 64) * (DFF / 32), TOTAL = 24 * IPM;
        float wa[32], wb[32];
        if (it < TOTAL) { const MatDesc d = moe_desc(a, (unsigned char*)F.ws, li, it / IPM); tr8_load(d.W, d.N, it % IPM, F.lane, wa); }
        while (it < TOTAL) {
            int nx = it + NGW;
            if (nx < TOTAL) { const MatDesc d = moe_desc(a, (unsigned char*)F.ws, li, nx / IPM); tr8_load(d.W, d.N, nx % IPM, F.lane, wb); }
            { const MatDesc d = moe_desc(a, (unsigned char*)F.ws, li, it / IPM); tr8_store(wa, d.K, d.N, (unsigned char*)d.WT, d.il, d.off, scr, it % IPM, F.lane); }
            it = nx; if (it >= TOTAL) break;
            nx = it + NGW;
            if (nx < TOTAL) { const MatDesc d = moe_desc(a, (unsigned char*)F.ws, li, nx / IPM); tr8_load(d.W, d.N, nx % IPM, F.lane, wa); }
            { const MatDesc d = moe_desc(a, (unsigned char*)F.ws, li, it / IPM); tr8_store(wb, d.K, d.N, (unsigned char*)d.WT, d.il, d.off, scr, it % IPM, F.lane); }
            it = nx; }
        return; }
    for (int m = 0; m < 24; ++m) { const MatDesc d = moe_desc(a, (unsigned char*)F.ws, li, m); const int items = (d.K / 64) * (d.N / 32);
        for (; it < base + items; it += NGW) { if (d.f8) tr_item8(d.W, d.K, d.N, (unsigned char*)d.WT, d.il, d.off, scr, it - base, F.lane); else tr_item(d.W, d.K, d.N, d.WT, d.il, d.off, scr, it - base, F.lane); }
        base += items; }
}
__device__ __forceinline__ void adaln_phase(const Ctx& F, const Args& a) {
    LAS float* sc = (LAS float*)(F.lds + 65536);
    LAS float* red = (LAS float*)(F.lds + 65536 + 20480);
    __syncthreads();
    for (int idx = F.tid; idx < 5 * 1024; idx += NWAVES * 64) { const int r = idx >> 10, k = idx & 1023; const float v = (r < 4) ? a.in[I_C][r * 1024 + k] : a.in[I_CCTX][k];
        sc[idx] = v / (1.0f + __expf(-v)); }
    __syncthreads();
    float* MOD = (float*)(F.ws + WS_MOD);
    for (int task = F.bx; task < 4 * 96; task += F.G) { const int layer = task / 96, n0 = (task - layer * 96) * 64;
        const float* W = a.in[I_ADAW] + (size_t)layer * 1024 * 6144 + n0 + F.lane;
        float a0 = 0.f, a1 = 0.f, a2 = 0.f, a3 = 0.f, a4 = 0.f;
        for (int kb = F.wave * 128; kb < F.wave * 128 + 128; kb += 32) { float wv[32];
#pragma unroll
            for (int i = 0; i < 32; ++i) wv[i] = W[(size_t)(kb + i) * 6144];
#pragma unroll
            for (int i = 0; i < 32; ++i) { const float w = wv[i]; const int k = kb + i;
                a0 += sc[k] * w; a1 += sc[1024 + k] * w; a2 += sc[2048 + k] * w; a3 += sc[3072 + k] * w; a4 += sc[4096 + k] * w; } }
        red[(F.wave * 5 + 0) * 64 + F.lane] = a0; red[(F.wave * 5 + 1) * 64 + F.lane] = a1; red[(F.wave * 5 + 2) * 64 + F.lane] = a2; red[(F.wave * 5 + 3) * 64 + F.lane] = a3; red[(F.wave * 5 + 4) * 64 + F.lane] = a4;
        __syncthreads();
        if (F.wave < 5) { float s = a.in[I_ADAB][layer * 6144 + n0 + F.lane];
#pragma unroll
            for (int w = 0; w < 8; ++w) s += red[(w * 5 + F.wave) * 64 + F.lane];
            MOD[(size_t)(layer * 5 + F.wave) * 6144 + n0 + F.lane] = s; }
        __syncthreads();
    }
}

__device__ __forceinline__ float row_rstd(const f32x4 (&v)[4]) {
    float s = 0.f;
#pragma unroll
    for (int j = 0; j < 4; ++j) s += (v[j][0] * v[j][0] + v[j][1] * v[j][1]) + (v[j][2] * v[j][2] + v[j][3] * v[j][3]);
    return 1.0f / sqrtf(wave_sum(s) * (1.0f / 1024.0f) + EPS);
}
__device__ __forceinline__ void store_mod_row(const f32x4 (&v)[4], float rstd, const float* shift, const float* scale, bf16* hrow, int lane) {
#pragma unroll
    for (int j = 0; j < 4; ++j) { const f32x4 sc = *((const f32x4*)scale + lane + 64 * j), sh = *((const f32x4*)shift + lane + 64 * j);
        const f32x4 h = v[j] * rstd * (sc + 1.0f) + sh; v2u o; o.x = pk2(h[0], h[1]); o.y = pk2(h[2], h[3]);
        *((v2u*)hrow + lane + 64 * j) = o; }
}
__device__ __forceinline__ void store_mod_row8(const f32x4 (&v)[4], float rstd, const float* shift, const float* scale, unsigned char* hrow, int lane) {
#pragma unroll
    for (int j = 0; j < 4; ++j) { const f32x4 sc = *((const f32x4*)scale + lane + 64 * j), sh = *((const f32x4*)shift + lane + 64 * j);
        const f32x4 h = v[j] * rstd * (sc + 1.0f) + sh; *((unsigned*)hrow + lane + 64 * j) = pg8::pk4_fp8(h[0], h[1], h[2], h[3]); }
}
struct ModVec { f32x4 sc[4], sh[4]; };
__device__ __forceinline__ void modvec_load(ModVec& m, const float* shift, const float* scale, int lane) {
#pragma unroll
    for (int j = 0; j < 4; ++j) { m.sc[j] = *((const f32x4*)scale + lane + 64 * j) + 1.0f; m.sh[j] = *((const f32x4*)shift + lane + 64 * j); }
}
__device__ __forceinline__ void store_mod_row_v(const f32x4 (&v)[4], float rstd, const ModVec& m, bf16* hrow, int lane) {
#pragma unroll
    for (int j = 0; j < 4; ++j) { const f32x4 h = v[j] * rstd * m.sc[j] + m.sh[j]; v2u o; o.x = pk2(h[0], h[1]); o.y = pk2(h[2], h[3]); *((v2u*)hrow + lane + 64 * j) = o; }
}
__device__ __forceinline__ void store_mod_row8_v(const f32x4 (&v)[4], float rstd, const ModVec& m, unsigned char* hrow, int lane) {
#pragma unroll
    for (int j = 0; j < 4; ++j) { const f32x4 h = v[j] * rstd * m.sc[j] + m.sh[j]; *((unsigned*)hrow + lane + 64 * j) = pg8::pk4_fp8(h[0], h[1], h[2], h[3]); }
}
__device__ __forceinline__ void nm_phase(const Ctx& F, const Args& a, bool first, const float* modl, int shift_off, int scale_off, bool out8 = false) {
    const int gw = F.vcu * NWAVES + F.wave, NGW = F.G * NWAVES;
    const int rpw = (M + NGW - 1) / NGW, rbeg = gw * rpw, rend = (rbeg + rpw < M) ? rbeg + rpw : M;
    xs_t* XS = (xs_t*)(F.ws + WS_XS); bf16* H = (bf16*)(F.ws + WS_BIG + B_H);
    ModVec mv; int cur_mr = -1;
    if (first) {
        f32x4 nx[4];
#define NM_SRC(row_) ({ const int b_ = (row_) / ROWS_B, j_ = (row_) - b_ * ROWS_B; (j_ < CTXL) ? a.in[I_CTX] + (size_t)(b_ * CTXL + j_) * D : a.in[I_X] + (size_t)(b_ * SEQ + j_ - CTXL) * D; })
        if (rbeg < rend) { const float* s0 = NM_SRC(rbeg);
#pragma unroll
            for (int q = 0; q < 4; ++q) nx[q] = *((const f32x4*)s0 + F.lane + 64 * q); }
        for (int row = rbeg; row < rend; ++row) { const int mr = modrow_of_row(row);
            if (mr != cur_mr) { modvec_load(mv, modl + (size_t)mr * 6144 + shift_off, modl + (size_t)mr * 6144 + scale_off, F.lane); cur_mr = mr; }
            f32x4 v[4];
#pragma unroll
            for (int q = 0; q < 4; ++q) v[q] = nx[q];
            if (row + 1 < rend) { const float* s1 = NM_SRC(row + 1);
#pragma unroll
                for (int q = 0; q < 4; ++q) nx[q] = *((const f32x4*)s1 + F.lane + 64 * q); }
#pragma unroll
            for (int q = 0; q < 4; ++q) xs_st(XS, row, F.lane, q, v[q]);
            const float rstd = row_rstd(v);
            store_mod_row_v(v, rstd, mv, H + (size_t)row * D, F.lane);
        }
#undef NM_SRC
    } else {
        v2u nx[4], ny[4];
        if (rbeg < rend) {
#pragma unroll
            for (int q = 0; q < 4; ++q) nx[q] = xs_ld(XS, rbeg, F.lane, q); }
        if (rbeg + 1 < rend) {
#pragma unroll
            for (int q = 0; q < 4; ++q) ny[q] = xs_ld(XS, rbeg + 1, F.lane, q); }
        for (int row = rbeg; row < rend; ++row) { const int mr = modrow_of_row(row);
            if (mr != cur_mr) { modvec_load(mv, modl + (size_t)mr * 6144 + shift_off, modl + (size_t)mr * 6144 + scale_off, F.lane); cur_mr = mr; }
            f32x4 v[4];
#pragma unroll
            for (int q = 0; q < 4; ++q) { v[q] = xs_cvt(nx[q]); nx[q] = ny[q]; }
            if (row + 2 < rend) {
#pragma unroll
                for (int q = 0; q < 4; ++q) ny[q] = xs_ld(XS, row + 2, F.lane, q); }
            const float rstd = row_rstd(v);
            if (out8) store_mod_row8_v(v, rstd, mv, (unsigned char*)H + (size_t)row * D, F.lane);
            else store_mod_row_v(v, rstd, mv, H + (size_t)row * D, F.lane);
        }
    }
}

#ifndef AB_REP3
#define AB_REP3 1
#endif
#ifndef AB_REP4
#define AB_REP4 1
#endif
#ifndef AB_REP5
#define AB_REP5 1
#endif
__device__ __forceinline__ void abmid_unit(const Ctx& F, int c, int g, const bf16* Z, bf16* Y, const bf16* Wsb, const bf16* WpT, const float* vgain, const float* bsv, const float* pscale, int& cur_g) {
    typedef float f32x4v __attribute__((ext_vector_type(4)));
    const int r0 = c * 128, tid = F.tid, lane = F.lane, wave = F.wave;
    const int b = r0 / ROWS_B, j0 = r0 - b * ROWS_B;
    const int S0 = (j0 < CTXL) ? b * ROWS_B : b * ROWS_B + CTXL, S1 = (j0 < CTXL) ? b * ROWS_B + CTXL : (b + 1) * ROWS_B;
    LAS float* rstd = (LAS float*)F.lds;
    LAS unsigned short* T = (LAS unsigned short*)(F.lds + 1024);
    LAS unsigned short* P = (LAS unsigned short*)(F.lds + 1024 + 144 * 256);
    LAS unsigned char* WSL = F.lds + 1024 + 144 * 256 + 128 * 272;
    __syncthreads();
    const int fr = lane & 15, fq = lane >> 4;
    if (g != cur_g) { cur_g = g;
#pragma unroll
        for (int i = 0; i < 4; ++i) { const int p = tid + i * (NWAVES * 64), row = p >> 4, ch = p & 15;
            *(LAS v4u*)(WSL + row * 272 + ch * 16) = *(const v4u*)(Wsb + (size_t)(g * 128 + row) * 128 + ch * 8); }
    }
    v4u xr[16], xs[5]; unsigned short gv[32]; bf16x8 afp[4]; v2u uur[8]; float biasr[8];
#pragma unroll
    for (int rr = 0; rr < 16; ++rr) xr[rr] = *(const v4u*)(Z + (size_t)(r0 + 16 * wave + rr) * AB_IN + 512 + lane * 8);
#pragma unroll
    for (int i = 0; i < 5; ++i) { const int p = tid + i * (NWAVES * 64), lr = p >> 4, ch = p & 15, R = r0 - 8 + lr; xs[i] = (v4u){0u, 0u, 0u, 0u};
        if (p < 144 * 16 && R >= S0 && R < S1) xs[i] = *(const v4u*)(Z + (size_t)R * AB_IN + 1024 + 128 * g + ch * 8); }
    const int dcol = 128 * g + 16 * wave + fr;
#pragma unroll
    for (int ks = 0; ks < 4; ++ks)
#pragma unroll
        for (int jj = 0; jj < 8; ++jj) gv[ks * 8 + jj] = Z[(size_t)(r0 + 32 * ks + 8 * fq + jj) * AB_IN + 512 + dcol];
#pragma unroll
    for (int pb = 0; pb < 8; ++pb) { uur[pb] = *(const v2u*)(Z + (size_t)(r0 + 16 * pb + fr) * AB_IN + 128 * g + 16 * wave + 4 * fq); biasr[pb] = bsv[g * 128 + 16 * pb + fr]; }
#pragma unroll
    for (int ks = 0; ks < 4; ++ks) afp[ks] = *(const bf16x8*)(WpT + (size_t)(g * 128 + 16 * wave + fr) * 128 + 32 * ks + 8 * fq);
    { float mine = 0.f;
#pragma unroll
        for (int rr = 0; rr < 16; ++rr) { const v4u x = xr[rr];
            float s = bf_lo(x.x) * bf_lo(x.x) + bf_hi(x.x) * bf_hi(x.x) + bf_lo(x.y) * bf_lo(x.y) + bf_hi(x.y) * bf_hi(x.y) + bf_lo(x.z) * bf_lo(x.z) + bf_hi(x.z) * bf_hi(x.z) + bf_lo(x.w) * bf_lo(x.w) + bf_hi(x.w) * bf_hi(x.w);
            s = wave_sum(s); if (lane == rr) mine = s; }
        if (lane < 16) rstd[16 * wave + lane] = 1.0f / sqrtf(mine * (1.0f / 512.0f) + EPS); }
#pragma unroll
    for (int i = 0; i < 5; ++i) { const int p = tid + i * (NWAVES * 64), lr = p >> 4, ch = p & 15;
        if (p < 144 * 16) *(LAS v4u*)((LAS unsigned char*)T + lr * 256 + ch * 16) = xs[i]; }
    __syncthreads();
    for (int rep3_ = 0; rep3_ < AB_REP3; ++rep3_)
    { const int i = tid & 127, rq = tid >> 7, w = 2 << g, half = w >> 1, l0 = 32 * rq;
        float s = 0.f;
        for (int t = 0; t < w; ++t) s += bf1(T[(l0 + 8 - half + t) * 128 + i]);
#pragma unroll 8
        for (int l = l0; l < l0 + 32; ++l) { const int R = r0 + l; int lo = R - half, hi = R - half + w; lo = lo < S0 ? S0 : lo; hi = hi > S1 ? S1 : hi;
            const float mean = s * __builtin_amdgcn_rcpf((float)(hi - lo)); const float pv = mean - bf1(T[(l + 8) * 128 + i]);
            P[l * 136 + i] = (unsigned short)(pk2(pv, 0.f) & 0xffffu);
            s += bf1(T[(l + 8 - half + w) * 128 + i]) - bf1(T[(l + 8 - half) * 128 + i]); } }
    __syncthreads();
    for (int rep4_ = 0; rep4_ < AB_REP4; ++rep4_)
    { const f32x4v psc = *(const f32x4v*)(pscale + 128 * g + 16 * wave + 4 * fq);
#pragma unroll 2
        for (int lb = 0; lb < 8; ++lb) { pg8::f32x4 acc = {0.f, 0.f, 0.f, 0.f};
#pragma unroll
            for (int ks = 0; ks < 4; ++ks) { const bf16x8 bfr = *(const LAS bf16x8*)((LAS unsigned char*)P + (16 * lb + fr) * 272 + (32 * ks + 8 * fq) * 2);
                acc = __builtin_amdgcn_mfma_f32_16x16x32_bf16(afp[ks], bfr, acc, 0, 0, 0); }
            v2u o; o.x = pk2(acc[0] * psc[0], acc[1] * psc[1]); o.y = pk2(acc[2] * psc[2], acc[3] * psc[3]);
            *(v2u*)(Y + (size_t)(r0 + 16 * lb + fr) * 1024 + 512 + 128 * g + 16 * wave + 4 * fq) = o; } }
    for (int rep5_ = 0; rep5_ < AB_REP5; ++rep5_)
    { bf16x8 af[4]; const float gn = vgain[dcol];
#pragma unroll
        for (int ks = 0; ks < 4; ++ks) { float t[8];
#pragma unroll
            for (int jj = 0; jj < 8; ++jj) { const int q = 32 * ks + 8 * fq + jj; t[jj] = bf1(gv[ks * 8 + jj]) * rstd[q] * gn; }
            v4u w; w.x = pk2(t[0], t[1]); w.y = pk2(t[2], t[3]); w.z = pk2(t[4], t[5]); w.w = pk2(t[6], t[7]); af[ks] = __builtin_bit_cast(bf16x8, w); }
#pragma unroll
        for (int pb = 0; pb < 8; ++pb) { pg8::f32x4 acc = {0.f, 0.f, 0.f, 0.f};
#pragma unroll
            for (int ks = 0; ks < 4; ++ks) { const bf16x8 bfr = *(const LAS bf16x8*)(WSL + (16 * pb + fr) * 272 + (32 * ks + 8 * fq) * 2);
                acc = __builtin_amdgcn_mfma_f32_16x16x32_bf16(af[ks], bfr, acc, 0, 0, 0); }
            const int prow = 16 * pb + fr; const float bias = biasr[pb];
            const v2u uu = uur[pb];
            v2u o; o.x = pk2(bf_lo(uu.x) * (acc[0] + bias), bf_hi(uu.x) * (acc[1] + bias)); o.y = pk2(bf_lo(uu.y) * (acc[2] + bias), bf_hi(uu.y) * (acc[3] + bias));
            *(v2u*)(Y + (size_t)(r0 + prow) * 1024 + 128 * g + 16 * wave + 4 * fq) = o; } }
}

__device__ __forceinline__ void unpack8(const v4u x, float (&f)[8]) { f[0] = bf_lo(x.x); f[1] = bf_hi(x.x); f[2] = bf_lo(x.y); f[3] = bf_hi(x.y); f[4] = bf_lo(x.z); f[5] = bf_hi(x.z); f[6] = bf_lo(x.w); f[7] = bf_hi(x.w); }
__device__ __forceinline__ v4u pack8(const float (&f)[8]) { v4u o; o.x = pk2(f[0], f[1]); o.y = pk2(f[2], f[3]); o.z = pk2(f[4], f[5]); o.w = pk2(f[6], f[7]); return o; }
__device__ __forceinline__ void head_norm_rope(float (&f)[8], int sub, const float (&gain)[8], bool rope, float grow, float gcol, float oscale) {
    float s = 0.f;
#pragma unroll
    for (int j = 0; j < 8; ++j) s += f[j] * f[j];
    s += __shfl_xor(s, 1); s += __shfl_xor(s, 2); s += __shfl_xor(s, 4);
    const float r = 1.0f / sqrtf(s * (1.0f / 64.0f) + EPS);
#pragma unroll
    for (int j = 0; j < 8; ++j) f[j] = f[j] * r * gain[j];
    float o[8];
#pragma unroll
    for (int j = 0; j < 8; ++j) o[j] = __shfl_xor(f[j], 4);
    if (rope) {
#pragma unroll
        for (int j = 0; j < 8; ++j) { const int dp = (sub & 3) * 8 + j;
            const float ang = ((dp < 16) ? grow : gcol) * __builtin_amdgcn_exp2f(-(float)(dp & 15) * (13.287712379549449f / 16.0f));
            const float cs = __cosf(ang), sn = __sinf(ang);
            f[j] = (sub < 4) ? (f[j] * cs - o[j] * sn) : (o[j] * sn + f[j] * cs); }
    }
#pragma unroll
    for (int j = 0; j < 8; ++j) f[j] *= oscale;
}
__device__ __forceinline__ void cdmid_phase(const Ctx& F, const Args& a, int li, int gw, int NGW) {
    const int lane = F.lane;
    GAS unsigned char* big = F.ws + WS_BIG;
    const bf16* Z = (const bf16*)(big + B_Z); bf16* QC = (bf16*)(big + B_QC); bf16* KC = (bf16*)(big + B_KC); bf16* CQN = (bf16*)(big + B_CQN); bf16* CKVN = (bf16*)(big + B_CKVN); unsigned char* KD8 = (unsigned char*)(big + B_KD); unsigned char* QD8 = (unsigned char*)(big + B_QD); unsigned char* QC8 = (unsigned char*)(big + B_QC8); unsigned char* KC8 = (unsigned char*)(big + B_KC8);
    const float* qg = a.in[I_CQGAIN] + li * 64; const float* kg = a.in[I_CKGAIN] + li * 64; const float* cqg = a.in[I_DCQGAIN] + li * 384; const float* ckvg = a.in[I_DCKVGAIN] + li * 256;
    float qgv[8], kgv[8], cq1[8], cq2[8], ckv[8];
    { const int c1 = (lane >= 32) ? (lane - 32) * 8 : 0, c2 = (lane < 16) ? 256 + lane * 8 : 0, c3 = (lane >= 16 && lane < 48) ? (lane - 16) * 8 : 0;
#pragma unroll
        for (int t = 0; t < 8; ++t) { qgv[t] = qg[(lane & 7) * 8 + t]; kgv[t] = kg[(lane & 7) * 8 + t]; cq1[t] = cqg[c1 + t]; cq2[t] = cqg[c2 + t]; ckv[t] = ckvg[c3 + t]; } }
    v4u nx0 = (v4u){0u, 0u, 0u, 0u}, nx1 = nx0, nx2 = nx0;
    if (gw < M) { const bf16* zn = Z + (size_t)gw * CD_INP; nx0 = *(const v4u*)(zn + lane * 8); nx1 = *(const v4u*)(zn + (64 + lane) * 8); nx2 = *(const v4u*)(zn + (128 + lane) * 8); }
    for (int row = gw; row < M; row += NGW) { const int b = row / ROWS_B, j = row - b * ROWS_B; const bool latent = j >= CTXL; const int s = j - CTXL;
        const float grow = (float)(s >> 6), gcol = (float)(s & 63);
        const v4u x0 = nx0, x1 = nx1, x2 = nx2;
        if (row + NGW < M) { const bf16* zn = Z + (size_t)(row + NGW) * CD_INP; nx0 = *(const v4u*)(zn + lane * 8); nx1 = *(const v4u*)(zn + (64 + lane) * 8); nx2 = *(const v4u*)(zn + (128 + lane) * 8); }
        float f0[8], f1[8], f2[8]; unpack8(x0, f0); unpack8(x1, f1); unpack8(x2, f2);
        head_norm_rope(f0, lane & 7, qgv, latent, grow, gcol, 0.125f * 1.4426950408889634f);
        { v2u q8; q8.x = pg8::pk4_fp8(f0[0], f0[1], f0[2], f0[3]); q8.y = pg8::pk4_fp8(f0[4], f0[5], f0[6], f0[7]); *(v2u*)(QC8 + (size_t)row * 512 + lane * 8) = q8; }
        float ssq = 0.f, sskv = 0.f;
        if (lane >= 32) {
#pragma unroll
            for (int t = 0; t < 8; ++t) ssq += f1[t] * f1[t]; }
        if (lane < 16) {
#pragma unroll
            for (int t = 0; t < 8; ++t) ssq += f2[t] * f2[t]; }
        else if (lane < 48) {
#pragma unroll
            for (int t = 0; t < 8; ++t) sskv += f2[t] * f2[t]; }
        { float fk[8];
#pragma unroll
            for (int t = 0; t < 8; ++t) fk[t] = f1[t];
            head_norm_rope(fk, lane & 7, kgv, latent, grow, gcol, 1.0f);
            if (lane < 16) { v2u k8; k8.x = pg8::pk4_fp8(fk[0], fk[1], fk[2], fk[3]); k8.y = pg8::pk4_fp8(fk[4], fk[5], fk[6], fk[7]); *(v2u*)(KC8 + (size_t)row * 128 + lane * 8) = k8; } }
        ssq = wave_sum(ssq); sskv = wave_sum(sskv);
        const float rq = 1.0f / sqrtf(ssq * (1.0f / 384.0f) + EPS), rkv = 1.0f / sqrtf(sskv * (1.0f / 256.0f) + EPS);
        if (lane >= 32) { float o[8]; const int c0 = (lane - 32) * 8;
#pragma unroll
            for (int t = 0; t < 8; ++t) o[t] = f1[t] * rq * cq1[t];
            *(v4u*)(CQN + (size_t)row * 384 + c0) = pack8(o); }
        if (lane < 16) { float o[8]; const int c0 = 256 + lane * 8;
#pragma unroll
            for (int t = 0; t < 8; ++t) o[t] = f2[t] * rq * cq2[t];
            *(v4u*)(CQN + (size_t)row * 384 + c0) = pack8(o); }
        else if (lane < 48) { float o[8]; const int c0 = (lane - 16) * 8;
#pragma unroll
            for (int t = 0; t < 8; ++t) o[t] = f2[t] * rkv * ckv[t];
            *(v4u*)(CKVN + (size_t)row * 256 + c0) = pack8(o); }
        { float o[8];
#pragma unroll
            for (int t = 0; t < 8; ++t) o[t] = __shfl_xor(f2[t], 2);
            if (lane >= 48 && lane < 52) { const int sub = lane - 48;
                if (latent) {
#pragma unroll
                    for (int t = 0; t < 8; ++t) { const int dp = (sub & 1) * 8 + t; const float ang = ((dp < 8) ? grow : gcol) * __builtin_amdgcn_exp2f(-(float)(dp & 7) * (13.287712379549449f / 8.0f));
                        const float cs = __cosf(ang), sn = __sinf(ang);
                        f2[t] = (sub < 2) ? (f2[t] * cs - o[t] * sn) : (o[t] * sn + f2[t] * cs); } }
                v2u w8; w8.x = pg8::pk4_fp8(f2[0], f2[1], f2[2], f2[3]); w8.y = pg8::pk4_fp8(f2[4], f2[5], f2[6], f2[7]);
#pragma unroll
                for (int h = 0; h < 8; ++h) *(v2u*)(KD8 + (size_t)row * 1024 + 128 * h + 64 + sub * 8) = w8; }
            if (lane < 16) { const v4u z = (v4u){0u, 0u, 0u, 0u};
                *(v4u*)(KD8 + (size_t)row * 1024 + 128 * (lane >> 1) + 96 + 16 * (lane & 1)) = z; *(v4u*)(QD8 + (size_t)row * 1024 + 128 * (lane >> 1) + 96 + 16 * (lane & 1)) = z; } }
    }
}

constexpr int RPB_MAX = 1056;
__device__ __forceinline__ void route_phase(const Ctx& F, const Args& a, int li, const float* modl) {
    LAS float* R = (LAS float*)F.lds;
    LAS unsigned* cnt = (LAS unsigned*)(F.lds + 40960);
    const float* rw = a.in[I_ROUTER] + (size_t)li * 1024 * 8;
    __syncthreads();
    for (int i = F.tid; i < 1024 * 8 / 4; i += NWAVES * 64) { const int c = i >> 1, hf = i & 1; *((LAS f32x4*)(R + (c >> 2) * 36 + (c & 3) * 8 + hf * 4)) = *((const f32x4*)rw + i); }
    if (F.tid < 8) cnt[F.tid] = 0u;
    __syncthreads();
    const int rpb = (M + F.G - 1) / F.G, rbeg = F.bx * rpb, rend = (rbeg + rpb < M) ? rbeg + rpb : M;
    const xs_t* XS = (const xs_t*)(F.ws + WS_XS); v4u* TOPK = (v4u*)(F.ws + WS_TOPK);
    v2u nx[4], ny[4];
    if (rbeg + F.wave < rend) {
#pragma unroll
        for (int q = 0; q < 4; ++q) nx[q] = xs_ld(XS, rbeg + F.wave, F.lane, q); }
    if (rbeg + F.wave + NWAVES < rend) {
#pragma unroll
        for (int q = 0; q < 4; ++q) ny[q] = xs_ld(XS, rbeg + F.wave + NWAVES, F.lane, q); }
    ModVec mv; int cur_mr = -1;
    for (int row = rbeg + F.wave; row < rend; row += NWAVES) { const int mr = modrow_of_row(row);
        if (mr != cur_mr) { modvec_load(mv, modl + (size_t)mr * 6144 + 3 * 1024, modl + (size_t)mr * 6144 + 4 * 1024, F.lane); cur_mr = mr; }
        f32x4 v[4];
#pragma unroll
        for (int q = 0; q < 4; ++q) { v[q] = xs_cvt(nx[q]); nx[q] = ny[q]; }
        if (row + 2 * NWAVES < rend) {
#pragma unroll
            for (int q = 0; q < 4; ++q) ny[q] = xs_ld(XS, row + 2 * NWAVES, F.lane, q); }
        const float rstd = row_rstd(v);
        float lg[8] = {0.f, 0.f, 0.f, 0.f, 0.f, 0.f, 0.f, 0.f};
#pragma unroll
        for (int q = 0; q < 4; ++q) { const f32x4 h = v[q] * rstd * mv.sc[q] + mv.sh[q];
#pragma unroll
            for (int t = 0; t < 4; ++t) { const LAS float* rp = R + (F.lane + 64 * q) * 36 + t * 8; const f32x4 r0 = *((const LAS f32x4*)rp), r1 = *((const LAS f32x4*)(rp + 4));
                lg[0] += h[t] * r0[0]; lg[1] += h[t] * r0[1]; lg[2] += h[t] * r0[2]; lg[3] += h[t] * r0[3]; lg[4] += h[t] * r1[0]; lg[5] += h[t] * r1[1]; lg[6] += h[t] * r1[2]; lg[7] += h[t] * r1[3]; } }
        { float t4[4], t2[2], t1;
#pragma unroll
            for (int i = 0; i < 4; ++i) { const float keep = (F.lane & 1) ? lg[4 + i] : lg[i], send = (F.lane & 1) ? lg[i] : lg[4 + i]; t4[i] = keep + __shfl_xor(send, 1); }
#pragma unroll
            for (int i = 0; i < 2; ++i) { const float keep = (F.lane & 2) ? t4[2 + i] : t4[i], send = (F.lane & 2) ? t4[i] : t4[2 + i]; t2[i] = keep + __shfl_xor(send, 2); }
            { const float keep = (F.lane & 4) ? t2[1] : t2[0], send = (F.lane & 4) ? t2[0] : t2[1]; t1 = keep + __shfl_xor(send, 4); }
            t1 += __shfl_xor(t1, 8); t1 += __shfl_xor(t1, 16); t1 += __shfl_xor(t1, 32);
#pragma unroll
            for (int e = 0; e < 8; ++e) lg[e] = __int_as_float(__builtin_amdgcn_readlane(__float_as_int(t1), (e >> 2) | (((e >> 1) & 1) << 1) | ((e & 1) << 2))); }
        int i0 = 0; float v0 = lg[0];
#pragma unroll
        for (int e = 1; e < 8; ++e) if (lg[e] > v0) { v0 = lg[e]; i0 = e; }
        int i1 = -1; float v1 = -3.0e38f;
#pragma unroll
        for (int e = 0; e < 8; ++e) if (e != i0 && (i1 < 0 || lg[e] > v1)) { v1 = lg[e]; i1 = e; }
        const float w0 = 1.0f / (1.0f + __expf(v1 - v0)), w1 = 1.0f - w0;
        const bool noslot_ = (li == 1) && (mr == 4);
        if (F.lane == 0) { TOPK[row] = (v4u){noslot_ ? 0xffu : (unsigned)i0, noslot_ ? 0xffu : (unsigned)i1, __float_as_uint(w0), __float_as_uint(w1)}; if (!noslot_) { __hip_atomic_fetch_add((unsigned*)&cnt[i0], 1u, __ATOMIC_RELAXED, __HIP_MEMORY_SCOPE_WORKGROUP); __hip_atomic_fetch_add((unsigned*)&cnt[i1], 1u, __ATOMIC_RELAXED, __HIP_MEMORY_SCOPE_WORKGROUP); } }
    }
    __syncthreads();
    if (F.tid < 8) __hip_atomic_store((unsigned*)(F.ws + WS_CNT) + F.bx * 8 + F.tid, cnt[F.tid], __ATOMIC_RELAXED, __HIP_MEMORY_SCOPE_AGENT);
}
__device__ __forceinline__ void slots_phase(const Ctx& F, const Args& a, const float* modl) {
    LAS unsigned* tot = (LAS unsigned*)F.lds;
    LAS unsigned* e01 = (LAS unsigned*)(F.lds + 256);
    LAS unsigned* sl0 = e01 + RPB_MAX; LAS unsigned* sl1 = sl0 + RPB_MAX;
    const int rpb = (M + F.G - 1) / F.G, rbeg = F.bx * rpb, rend = (rbeg + rpb < M) ? rbeg + rpb : M, nr = rend > rbeg ? rend - rbeg : 0;
    const unsigned* CNT = (const unsigned*)(F.ws + WS_CNT); const v4u* TOPK = (const v4u*)(F.ws + WS_TOPK); unsigned* PEXP = (unsigned*)(F.ws + WS_PEXP);
    __syncthreads();
    LAS unsigned* cl = sl1 + RPB_MAX;
    for (int i = F.tid; i < F.G * 8; i += NWAVES * 64) cl[i] = __hip_atomic_load(CNT + i, __ATOMIC_RELAXED, __HIP_MEMORY_SCOPE_AGENT);
    for (int r = F.tid; r < nr; r += NWAVES * 64) { const v4u tk = TOPK[rbeg + r]; e01[r] = tk.x | (tk.y << 8); }
    __syncthreads();
    if (F.tid < 8) { unsigned t = 0u, pre = 0u;
        for (int g = 0; g < F.G; ++g) { const unsigned cv = cl[g * 8 + F.tid]; t += cv; if (g < F.bx) pre += cv; }
        tot[F.tid] = t; tot[8 + F.tid] = pre; }
    __syncthreads();
    if (F.tid == 0) { unsigned pb = 0u;
        for (int e = 0; e < 8; ++e) { const unsigned np = (tot[e] + 255u) >> 8; tot[16 + e] = pb * 256u + tot[8 + e];
            if (F.bx == 0) for (unsigned p = 0; p < np; ++p) __hip_atomic_store(PEXP + pb + p, (unsigned)e, __ATOMIC_RELAXED, __HIP_MEMORY_SCOPE_AGENT);
            pb += np; }
        if (F.bx == 0) __hip_atomic_store(PEXP + 511, pb, __ATOMIC_RELAXED, __HIP_MEMORY_SCOPE_AGENT); }
    __syncthreads();
    if (F.tid < 8) { unsigned c = tot[16 + F.tid]; const unsigned e = (unsigned)F.tid;
        for (int r = 0; r < nr; ++r) { const unsigned w = e01[r]; if ((w & 0xffu) == e) sl0[r] = c++; else if ((w >> 8) == e) sl1[r] = c++; } }
    __syncthreads();
    const xs_t* XS = (const xs_t*)(F.ws + WS_XS); bf16* HS = (bf16*)(F.ws + WS_BIG + B_HS); v2u* TOKSLOT = (v2u*)(F.ws + WS_TOKSLOT);
    v2u nx[4], ny[4];
    if (F.wave < nr) {
#pragma unroll
        for (int q = 0; q < 4; ++q) nx[q] = xs_ld(XS, rbeg + F.wave, F.lane, q); }
    if (F.wave + NWAVES < nr) {
#pragma unroll
        for (int q = 0; q < 4; ++q) ny[q] = xs_ld(XS, rbeg + F.wave + NWAVES, F.lane, q); }
    ModVec mv; int cur_mr = -1;
    for (int r = F.wave; r < nr; r += NWAVES) { const int row = rbeg + r; const int mr = modrow_of_row(row);
        if (mr != cur_mr) { modvec_load(mv, modl + (size_t)mr * 6144 + 3 * 1024, modl + (size_t)mr * 6144 + 4 * 1024, F.lane); cur_mr = mr; }
        f32x4 v[4];
#pragma unroll
        for (int q = 0; q < 4; ++q) { v[q] = xs_cvt(nx[q]); nx[q] = ny[q]; }
        if (r + 2 * NWAVES < nr) {
#pragma unroll
            for (int q = 0; q < 4; ++q) ny[q] = xs_ld(XS, row + 2 * NWAVES, F.lane, q); }
        if (e01[r] == 0xffffu) continue;
        const float rstd = row_rstd(v); const unsigned s0 = sl0[r], s1 = sl1[r];
#pragma unroll
        for (int q = 0; q < 4; ++q) { const f32x4 h = v[q] * rstd * mv.sc[q] + mv.sh[q];
            if (FP8M) { const unsigned o8 = pg8::pk4_fp8(h[0], h[1], h[2], h[3]); *((unsigned*)((unsigned char*)HS + (size_t)s0 * D) + F.lane + 64 * q) = o8; *((unsigned*)((unsigned char*)HS + (size_t)s1 * D) + F.lane + 64 * q) = o8; }
            else { v2u o; o.x = pk2(h[0], h[1]); o.y = pk2(h[2], h[3]);
                *((v2u*)(HS + (size_t)s0 * D) + F.lane + 64 * q) = o; *((v2u*)(HS + (size_t)s1 * D) + F.lane + 64 * q) = o; } }
        if (F.lane == 0) TOKSLOT[row] = (v2u){s0, s1};
    }
}
__device__ __forceinline__ void combine_phase(const Ctx& F, const Args& a, const float* modl, bool final_layer, const float* modn, float gscale) {
    const int gw = F.vcu * NWAVES + F.wave, NGW = F.G * NWAVES;
    const int rpw = (M + NGW - 1) / NGW, rbeg = gw * rpw, rend = (rbeg + rpw < M) ? rbeg + rpw : M;
    xs_t* XS = (xs_t*)(F.ws + WS_XS); bf16* H = (bf16*)(F.ws + WS_BIG + B_H); const bf16* Y = (const bf16*)(F.ws + WS_BIG + B_HS);
    const v4u* TOPK = (const v4u*)(F.ws + WS_TOPK); const v2u* TOKSLOT = (const v2u*)(F.ws + WS_TOKSLOT);
    v2u nx[4]; v2u ny0[4], ny1[4]; v4u ntk = (v4u){0u, 0u, 0u, 0u}, ftk = ntk; v2u fts = (v2u){0u, 0u};
#define CB_DATA(row_, ts_) do { _Pragma("unroll") for (int q = 0; q < 4; ++q) { nx[q] = xs_ld(XS, (row_), F.lane, q); \
        ny0[q] = *((const v2u*)(Y + (size_t)(ts_).x * D) + F.lane + 64 * q); ny1[q] = *((const v2u*)(Y + (size_t)(ts_).y * D) + F.lane + 64 * q); } } while (0)
    if (rbeg < rend) { ntk = TOPK[rbeg]; const v2u ts0 = TOKSLOT[rbeg]; CB_DATA(rbeg, ts0); }
    if (rbeg + 1 < rend) { ftk = TOPK[rbeg + 1]; fts = TOKSLOT[rbeg + 1]; }
    ModVec mv; f32x4 gv[4], fg[4]; int cur_mr = -1;
    if (final_layer) {
#pragma unroll
        for (int q = 0; q < 4; ++q) fg[q] = *((const f32x4*)a.in[I_FGAIN] + F.lane + 64 * q); }
    for (int row = rbeg; row < rend; ++row) { const int b = row / ROWS_B, j = row - b * ROWS_B; const int mr = (j < CTXL) ? 4 : b;
        const v4u tk = ntk; f32x4 x[4]; v2u y0[4], y1[4];
#pragma unroll
        for (int q = 0; q < 4; ++q) { x[q] = xs_cvt(nx[q]); y0[q] = ny0[q]; y1[q] = ny1[q]; }
        if (row + 1 < rend) { ntk = ftk; const v2u ts1 = fts; CB_DATA(row + 1, ts1); }
        if (row + 2 < rend) { ftk = TOPK[row + 2]; fts = TOKSLOT[row + 2]; }
        if (final_layer && j < CTXL) continue;
        if (mr != cur_mr) { cur_mr = mr;
#pragma unroll
            for (int q = 0; q < 4; ++q) gv[q] = *((const f32x4*)(modl + (size_t)mr * 6144 + 5 * 1024) + F.lane + 64 * q) * gscale;
            if (!final_layer) modvec_load(mv, modn + (size_t)mr * 6144, modn + (size_t)mr * 6144 + 1024, F.lane); }
        const float w0 = __uint_as_float(tk.z), w1 = __uint_as_float(tk.w);
        f32x4 v[4];
#pragma unroll
        for (int q = 0; q < 4; ++q) {
            f32x4 y; y[0] = w0 * bf_lo(y0[q].x) + w1 * bf_lo(y1[q].x); y[1] = w0 * bf_hi(y0[q].x) + w1 * bf_hi(y1[q].x); y[2] = w0 * bf_lo(y0[q].y) + w1 * bf_lo(y1[q].y); y[3] = w0 * bf_hi(y0[q].y) + w1 * bf_hi(y1[q].y);
            v[q] = x[q] + gv[q] * y; }
        const float rstd = row_rstd(v);
        if (!final_layer) {
#pragma unroll
            for (int q = 0; q < 4; ++q) xs_st(XS, row, F.lane, q, v[q]);
            store_mod_row_v(v, rstd, mv, H + (size_t)row * D, F.lane);
        } else { float* orow = a.out + (size_t)(b * SEQ + j - CTXL) * D;
#pragma unroll
            for (int q = 0; q < 4; ++q) *((f32x4*)orow + F.lane + 64 * q) = v[q] * rstd * fg[q]; }
    }
#undef CB_DATA
}
template <bool F8, class E> __device__ __forceinline__ void ctx_gemm(const Ctx& F, const void* Av, const void* Btv, int Kb  , int N, const E& epi) {
    const int fr = F.lane & 15, fq = F.lane >> 4, ntn = N / 64, ntask = 16 * ntn, nks = Kb / 64;
    typedef const __attribute__((address_space(1))) bf16x8* gp8;
    const unsigned char* A = (const unsigned char*)Av; const unsigned char* Bt = (const unsigned char*)Btv;
    LAS pg8::f32x4* red = (LAS pg8::f32x4*)(F.lds + RING_OFF);
    for (int t = F.vcu; t < ntask; t += F.G) { const int rt = t / ntn, ct = t - rt * ntn; const int p = rt >> 2, rq = rt & 3;
        const int row0 = p * ROWS_B + rq * 64, col0 = ct * 64;
        const unsigned char* ap = A + (size_t)(row0 + fr) * Kb + 16 * fq; const unsigned char* bp = Bt + (size_t)(col0 + fr) * Kb + 16 * fq;
        pg8::f32x4 acc[4][4];
#pragma unroll
        for (int mb = 0; mb < 4; ++mb)
#pragma unroll
            for (int nb = 0; nb < 4; ++nb) acc[mb][nb] = (pg8::f32x4){0.f, 0.f, 0.f, 0.f};
#pragma unroll 2
        for (int s = F.wave; s < nks; s += NWAVES) { const int k = 64 * s; bf16x8 av[4], wv[4];
#pragma unroll
            for (int i = 0; i < 4; ++i) { av[i] = *(gp8)(ap + (size_t)(16 * i) * Kb + k); wv[i] = *(gp8)(bp + (size_t)(16 * i) * Kb + k); }
#pragma unroll
            for (int mb = 0; mb < 4; ++mb)
#pragma unroll
                for (int nb = 0; nb < 4; ++nb) {
                    if constexpr (F8) { typedef long l2_ __attribute__((ext_vector_type(2))); const l2_ b_ = __builtin_bit_cast(l2_, wv[nb]), a_ = __builtin_bit_cast(l2_, av[mb]);
                        acc[mb][nb] = __builtin_amdgcn_mfma_f32_16x16x32_fp8_fp8(b_[0], a_[0], acc[mb][nb], 0, 0, 0); acc[mb][nb] = __builtin_amdgcn_mfma_f32_16x16x32_fp8_fp8(b_[1], a_[1], acc[mb][nb], 0, 0, 0); }
                    else acc[mb][nb] = __builtin_amdgcn_mfma_f32_16x16x32_bf16(wv[nb], av[mb], acc[mb][nb], 0, 0, 0); } }
        __syncthreads();
#pragma unroll
        for (int mb = 0; mb < 4; ++mb)
#pragma unroll
            for (int nb = 0; nb < 4; ++nb) red[(F.wave * 16 + mb * 4 + nb) * 64 + F.lane] = acc[mb][nb];
        __syncthreads();
#pragma unroll
        for (int i = 0; i < 2; ++i) { const int tile = 2 * F.wave + i, mb = tile >> 2, nb = tile & 3; pg8::f32x4 v = red[tile * 64 + F.lane];
#pragma unroll
            for (int w = 1; w < 8; ++w) v = v + red[(w * 16 + tile) * 64 + F.lane];
            epi(row0 + 16 * mb + fr, col0 + 16 * nb + 4 * fq, v); }
    }
    __syncthreads();
}
template <bool F8, class E> __device__ __forceinline__ void ctx_gemm_gu(const Ctx& F, const void* Av, const void* Btv, int Kb, int NH  , const E& epi) {
    const int fr = F.lane & 15, fq = F.lane >> 4, ntn = NH / 64, ntask = 16 * ntn, nks = Kb / 64;
    typedef const __attribute__((address_space(1))) bf16x8* gp8;
    const unsigned char* A = (const unsigned char*)Av; const unsigned char* Bt = (const unsigned char*)Btv;
    LAS pg8::f32x4* red = (LAS pg8::f32x4*)(F.lds + RING_OFF);
    for (int t = F.vcu; t < ntask; t += F.G) { const int rt = t / ntn, ct = t - rt * ntn; const int p = rt >> 2, rq = rt & 3;
        const int row0 = p * ROWS_B + rq * 64, hc0 = ct * 64, brow = (hc0 >> 7) * 256 + (hc0 & 127);
        const unsigned char* ap = A + (size_t)(row0 + fr) * Kb + 16 * fq; const unsigned char* bp = Bt + (size_t)(brow + fr) * Kb + 16 * fq;
        pg8::f32x4 ag[4][4], au[4][4];
#pragma unroll
        for (int mb = 0; mb < 4; ++mb)
#pragma unroll
            for (int nb = 0; nb < 4; ++nb) { ag[mb][nb] = (pg8::f32x4){0.f, 0.f, 0.f, 0.f}; au[mb][nb] = (pg8::f32x4){0.f, 0.f, 0.f, 0.f}; }
        for (int s = F.wave; s < nks; s += NWAVES) { const int k = 64 * s; bf16x8 av[4], wg[4], wu[4];
#pragma unroll
            for (int i = 0; i < 4; ++i) { av[i] = *(gp8)(ap + (size_t)(16 * i) * Kb + k); wg[i] = *(gp8)(bp + (size_t)(16 * i) * Kb + k); wu[i] = *(gp8)(bp + (size_t)(128 + 16 * i) * Kb + k); }
#pragma unroll
            for (int mb = 0; mb < 4; ++mb)
#pragma unroll
                for (int nb = 0; nb < 4; ++nb) {
                    if constexpr (F8) { typedef long l2_ __attribute__((ext_vector_type(2))); const l2_ g_ = __builtin_bit_cast(l2_, wg[nb]), u_ = __builtin_bit_cast(l2_, wu[nb]), a_ = __builtin_bit_cast(l2_, av[mb]);
                        ag[mb][nb] = __builtin_amdgcn_mfma_f32_16x16x32_fp8_fp8(g_[0], a_[0], ag[mb][nb], 0, 0, 0); ag[mb][nb] = __builtin_amdgcn_mfma_f32_16x16x32_fp8_fp8(g_[1], a_[1], ag[mb][nb], 0, 0, 0);
                        au[mb][nb] = __builtin_amdgcn_mfma_f32_16x16x32_fp8_fp8(u_[0], a_[0], au[mb][nb], 0, 0, 0); au[mb][nb] = __builtin_amdgcn_mfma_f32_16x16x32_fp8_fp8(u_[1], a_[1], au[mb][nb], 0, 0, 0); }
                    else { ag[mb][nb] = __builtin_amdgcn_mfma_f32_16x16x32_bf16(wg[nb], av[mb], ag[mb][nb], 0, 0, 0); au[mb][nb] = __builtin_amdgcn_mfma_f32_16x16x32_bf16(wu[nb], av[mb], au[mb][nb], 0, 0, 0); } } }
        pg8::f32x4 vg[2], vu[2];
        __syncthreads();
#pragma unroll
        for (int mb = 0; mb < 4; ++mb)
#pragma unroll
            for (int nb = 0; nb < 4; ++nb) red[(F.wave * 16 + mb * 4 + nb) * 64 + F.lane] = ag[mb][nb];
        __syncthreads();
#pragma unroll
        for (int i = 0; i < 2; ++i) { const int tile = 2 * F.wave + i; pg8::f32x4 v = red[tile * 64 + F.lane];
#pragma unroll
            for (int w = 1; w < 8; ++w) v = v + red[(w * 16 + tile) * 64 + F.lane];
            vg[i] = v; }
        __syncthreads();
#pragma unroll
        for (int mb = 0; mb < 4; ++mb)
#pragma unroll
            for (int nb = 0; nb < 4; ++nb) red[(F.wave * 16 + mb * 4 + nb) * 64 + F.lane] = au[mb][nb];
        __syncthreads();
#pragma unroll
        for (int i = 0; i < 2; ++i) { const int tile = 2 * F.wave + i, mb = tile >> 2, nb = tile & 3; pg8::f32x4 v = red[tile * 64 + F.lane];
#pragma unroll
            for (int w = 1; w < 8; ++w) v = v + red[(w * 16 + tile) * 64 + F.lane];
            vu[i] = v; epi(row0 + 16 * mb + fr, hc0 + 16 * nb + 4 * fq, vg[i], vu[i]); }
    }
    __syncthreads();
}
struct CtxEpiSwiglu { void* O; int ldc; float iscale; bool out8;
    __device__ __forceinline__ void operator()(int row, int col, pg8::f32x4 g, pg8::f32x4 u) const {
        float h[4];
#pragma unroll
        for (int j = 0; j < 4; ++j) h[j] = pg8::silu_f(g[j] * iscale) * (u[j] * iscale);
        if (out8) *(unsigned*)((unsigned char*)O + (size_t)row * ldc + col) = pg8::pk4_fp8(h[0], h[1], h[2], h[3]);
        else { v2u o; o.x = pk2(h[0], h[1]); o.y = pk2(h[2], h[3]); *(v2u*)((bf16*)O + (size_t)row * ldc + col) = o; } } };
struct CtxEpiZ { bf16* O; int ldc; int gelu_cols;
    __device__ __forceinline__ void operator()(int row, int col, pg8::f32x4 v) const {
        if (col < gelu_cols) { const pg8::f32x2 a = pg8::gelu_pk((pg8::f32x2){v[0], v[1]}), b = pg8::gelu_pk((pg8::f32x2){v[2], v[3]}); v = (pg8::f32x4){a.x, a.y, b.x, b.y}; }
        v2u o; o.x = pk2(v[0], v[1]); o.y = pk2(v[2], v[3]); *(v2u*)(O + (size_t)row * ldc + col) = o; } };
struct CtxEpiResid { xs_t* X; const float* gate; float gscale;
    __device__ __forceinline__ void operator()(int row, int col, pg8::f32x4 v) const {
        xs_t* p = X + (size_t)row * D + col; const f32x4 g = *(const f32x4*)(gate + col) * gscale; f32x4 x = xs_cvt(*(const v2u*)p); x = x + g * v; v2u o; o.x = pk2(x[0], x[1]); o.y = pk2(x[2], x[3]); *(v2u*)p = o; } };
__device__ __forceinline__ void vtrans_phase(const Ctx& F) {
    GAS unsigned char* big = F.ws + WS_BIG;
    const bf16* Z = (const bf16*)(big + B_Z); const bf16* VD = (const bf16*)(big + B_VD); unsigned char* VT = (unsigned char*)(big + B_VT8);
    LAS unsigned char* T = F.lds + F.wave * 4096;
    const int gw = F.vcu * NWAVES + F.wave, NGW = F.G * NWAVES, lane = F.lane, NTL = ROWS_B / 64;
    const int k = lane, h = (k >> 2) & 1, jj = (k & 3) + 4 * ((k & 31) >> 3), pos = 32 * h + jj + 16 * (k >> 5);
    for (int it = gw; it < BATCH * 10 * NTL; it += NGW) { const int b = it / (10 * NTL), r = it - b * 10 * NTL, hd = r / NTL, tile = r - hd * NTL;
        const size_t row = (size_t)b * ROWS_B + tile * 64 + k;
        const bf16* src = (hd < 2) ? Z + row * CD_INP + 640 + hd * 64 : VD + row * 512 + (hd - 2) * 64;
        v4u x[8];
#pragma unroll
        for (int i = 0; i < 8; ++i) x[i] = *(const v4u*)(src + 8 * i);
#pragma unroll
        for (int i = 0; i < 8; ++i) { float f[8]; unpack8(x[i], f);
#pragma unroll
            for (int t = 0; t < 8; t += 2) { const int w = __builtin_amdgcn_cvt_pk_fp8_f32(f[t], f[t + 1], 0, false); const int d0 = 8 * i + t, d1 = d0 + 1;
                T[d0 * 64 + ((((pos >> 4) ^ ((d0 >> 2) & 3)) << 4) | (pos & 15))] = (unsigned char)(w & 0xff);
                T[d1 * 64 + ((((pos >> 4) ^ ((d1 >> 2) & 3)) << 4) | (pos & 15))] = (unsigned char)((w >> 8) & 0xff); } }
        LDS_WAIT(); asm volatile("" ::: "memory");
        unsigned char* dst = VT + (size_t)it * 4096;
#pragma unroll
        for (int i = 0; i < 4; ++i) *(v4u*)(dst + (i * 64 + lane) * 16) = *(const LAS v4u*)(T + (i * 64 + lane) * 16);
        LDS_WAIT(); asm volatile("" ::: "memory");
    }
}
__device__ __forceinline__ void attn_do_unit(const Ctx& F, int kind  , int b, int h, int qb  ) {
    GAS unsigned char* big = F.ws + WS_BIG;
    const size_t rowb = (size_t)b * ROWS_B, qrow = rowb + (qb < 0 ? 0 : CTXL + qb * 256); const int nkeys = qb < 0 ? CTXL : ROWS_B;
    bf16* O = (bf16*)(big + B_Y);
    if (kind == 0) { const bf16* QC = (const bf16*)(big + B_QC); const bf16* KC = (const bf16*)(big + B_KC); const bf16* Z = (const bf16*)(big + B_Z); const int kvh = h >> 2;
        att::attn_unit4<64, 512, 128, 1024, true>((const bf16*)((const unsigned char*)(big + B_QC8) + qrow * 512 + h * 64), (const bf16*)((const unsigned char*)(big + B_KC8) + rowb * 128 + kvh * 64), (const unsigned char*)(big + B_VT8) + (size_t)(b * 10 + kvh) * (ROWS_B / 64) * 4096, O + qrow * 1024 + h * 64, nkeys, (__attribute__((address_space(3))) char*)F.lds, F.tid); (void)Z; (void)QC; (void)KC;
    } else { const bf16* QD = (const bf16*)(big + B_QD); const bf16* KD = (const bf16*)(big + B_KD); const bf16* VD = (const bf16*)(big + B_VD);
        att::attn_unit4<96, 1024, 1024, 1024, true>((const bf16*)((const unsigned char*)(big + B_QD) + qrow * 1024 + h * 128), (const bf16*)((const unsigned char*)(big + B_KD) + rowb * 1024 + h * 128), (const unsigned char*)(big + B_VT8) + (size_t)(b * 10 + 2 + h) * (ROWS_B / 64) * 4096, O + qrow * 1024 + 512 + h * 64, nkeys, (__attribute__((address_space(3))) char*)F.lds, F.tid); (void)VD; (void)QD; (void)KD;
    }
}

__device__ __forceinline__ bool attn_deal(int G, int blk, int i, int ctx_shift, int& b, int& h, int& qb) {
    if (G == 256) { const int x = blk & 7, c = blk >> 3;
        if (i < 4) { const int pair = 4 * x + i; b = pair >> 3; h = pair & 7; qb = c; return true; }
        if (i == 4) { const int p = blk - ctx_shift; if (p >= 0 && p < 32) { b = p >> 3; h = p & 7; qb = -1; return true; } }
        return false; }
    const int L = i * G + blk;
    if (L < 1024) { const int pair = L >> 5; b = pair >> 3; h = pair & 7; qb = L & 31; return true; }
    if (L < 1056) { const int p = L - 1024; b = p >> 3; h = p & 7; qb = -1; return true; }
    return false;
}

#ifndef HDP_DUP
#define HDP_DUP 0u
#endif
#define NREP(k) (((HDP_DUP >> (k)) & 1u) ? 2 : 1)
#define GS(k) ((NREP(k) == 2) ? 0.5f : 1.0f)
#ifndef HDP_ONLY
#define PH_ON(k) true
#else
#define PH_ON(k) ((k) == HDP_ONLY)
#endif
constexpr int N_PHASES = 2 + 2 * 18;
__global__ void __launch_bounds__(NWAVES * 64, 2) hdp_fwd(Args args_k) {
    extern __shared__ __attribute__((aligned(16))) unsigned char lds[];
    Ctx F0;
    { Ctx& F = F0;
    F.ldsg = lds; F.lds = (LAS unsigned char*)lds;
    F.tid = threadIdx.x; F.lane = F.tid & 63; F.wave = __builtin_amdgcn_readfirstlane(F.tid >> 6);
    F.bx = blockIdx.x; F.G = gridDim.x; { const int bx = blockIdx.x; F.vcu = (F.G % 8 == 0) ? (bx % 8) * (F.G / 8) + bx / 8 : bx; }
    F.ws = (GAS unsigned char*)args_k.ws; }
    const Ctx& F = F0;
    volatile LAS unsigned* MISC = (volatile LAS unsigned*)(F.lds + MISC_OFF);
    for (int u = F.tid; u < (LDS_BYTES - LDSCTL_OFF) / 4; u += NWAVES * 64) ((LAS unsigned*)(F.lds + LDSCTL_OFF))[u] = 0u;
    __syncthreads();
    unsigned* barw = (unsigned*)(args_k.ws + WS_CTL) + 4096;
    XcdBarrier bar = xcd_barrier_post(barw, MISC + 8);
    const int lo = args_k.ph_lo, hi = args_k.ph_hi;
    int ph = 0;
#define IN() (lo <= ph && ph < hi)
#define FRESH() Ctx F = F0; F.lane = (int)__builtin_amdgcn_mbcnt_hi(~0u, __builtin_amdgcn_mbcnt_lo(~0u, 0u)); asm volatile("" : "+v"(F.lane)); F.tid = F.wave * 64 + F.lane; const Args& args = args_k; asm volatile("" : "+s"(F.ws), "+s"(F.G), "+s"(F.vcu), "+s"(F.bx)); GAS unsigned char* ws = F.ws; GAS unsigned char* big = ws + WS_BIG; xs_t* XS = (xs_t*)(ws + WS_XS); const float* MOD = (const float*)(ws + WS_MOD); bf16* H = (bf16*)(big + B_H); (void)XS; (void)MOD; (void)H; (void)big
#ifndef HDP_DBLBAR
#define HDP_DBLBAR 0
#endif
#define SEAM() do { if (lo <= ph && ph + 1 < hi) { xcd_barrier(bar); if (HDP_DBLBAR) xcd_barrier(bar); } ++ph; } while (0)

    for (int rep_ = 0; rep_ < NREP(0); ++rep_) if (PH_ON(0) && IN()) { FRESH(); convert_small(F, args); rope_table(F); adaln_phase(F, args); }
    SEAM();
    for (int rep_ = 0; rep_ < NREP(1); ++rep_) if (PH_ON(1) && IN()) { FRESH(); nm_phase(F, args, true, MOD, 0, 1024); }
    SEAM();

    for (int lp = 0; lp < 2; ++lp) {
#define LAYER_PTRS() const float* mode = MOD + (size_t)(2 * lp) * 5 * 6144; const float* modo = MOD + (size_t)(2 * lp + 1) * 5 * 6144; \
        GAS unsigned char* ev = ws + WS_WSMALL + (size_t)lp * EV_STRIDE; GAS unsigned char* od = ws + WS_WODD + (size_t)lp * OD_STRIDE; (void)mode; (void)modo; (void)ev; (void)od
        for (int rep_ = 0; rep_ < NREP(2); ++rep_) if (PH_ON(2) && IN()) { FRESH(); LAYER_PTRS(); pg8::Gemm g{H, (const bf16*)(ev + EV_WIN), MLAT, AB_IN, D, 0}; pg8::StaticOrder S; S.init(MLAT, AB_IN, F.G, F.bx, 1);
            pg8::EpiZ<true> E{(bf16*)(big + B_Z), AB_IN, 4, 1.0f};
            pg8::gemm_phase<pg8::EpiZ<true>, pg8::StaticOrder, true, true>(F.lds + RING_OFF, g, S, E, F.tid);
            ctx_gemm<false>(F, H, (const bf16*)(ev + EV_WIN), 2 * D, AB_IN, CtxEpiZ{(bf16*)(big + B_Z), AB_IN, 1024}); }
        SEAM();
        for (int rep_ = 0; rep_ < NREP(3); ++rep_) if (PH_ON(3) && IN()) { FRESH(); LAYER_PTRS(); int cur_g = -1;
            for (int u = F.vcu; u < (M / 128) * 4; u += F.G) abmid_unit(F, u >> 2, u & 3, (const bf16*)(big + B_Z), (bf16*)(big + B_Y), (const bf16*)(ev + EV_WS), (const bf16*)(ev + EV_WPOOL),
                args.in[I_AVGAIN] + lp * 512, args.in[I_ABS] + lp * 512, args.in[I_BSCALE] + lp * 512, cur_g); }
        SEAM();
        for (int rep_ = 0; rep_ < NREP(4); ++rep_) if (PH_ON(4) && IN()) { FRESH(); LAYER_PTRS(); pg8::Gemm g{(const bf16*)(big + B_Y), (const bf16*)(ev + EV_WOUT), MLAT, D, D, 0}; pg8::StaticOrder S; S.init(MLAT, D, F.G, F.bx, 1);
            pg8::EpiResid E{XS, mode + 2 * 1024, GS(4)};
            pg8::gemm_phase<pg8::EpiResid, pg8::StaticOrder, true, true>(F.lds + RING_OFF, g, S, E, F.tid);
            ctx_gemm<false>(F, (const bf16*)(big + B_Y), (const bf16*)(ev + EV_WOUT), 2 * D, D, CtxEpiResid{XS, mode + 4 * 6144 + 2 * 1024, GS(4)}); }
        SEAM();
        for (int rep_ = 0; rep_ < NREP(5); ++rep_) if (PH_ON(5) && IN()) { FRESH(); LAYER_PTRS(); nm_phase(F, args, false, mode, 3 * 1024, 4 * 1024, FP8F || (FP8G2 && lp == 1)); }
        SEAM();
        for (int rep_ = 0; rep_ < NREP(6); ++rep_) if (PH_ON(6) && IN()) { FRESH(); LAYER_PTRS(); const bool g8 = FP8F || (FP8G2 && lp == 1);
            pg8::Gemm g{H, (const bf16*)(ev + EV_WGU), M, 2 * DFF, g8 ? D / 2 : D, 0}; pg8::StaticOrder S; S.init(M, 2 * DFF, F.G, F.bx);
            pg8::EpiSwiglu<FP8D> E{(bf16*)(big + B_HB), DFF, g8 ? WSC_INV : 1.0f};
            if (FP8G2 && !FP8F) { if (lp == 1) pg8::gemm_phase<pg8::EpiSwiglu<FP8D>, pg8::StaticOrder, true, true, MXM>(F.lds + RING_OFF, g, S, E, F.tid);
                                  else pg8::gemm_phase<pg8::EpiSwiglu<FP8D>, pg8::StaticOrder, true, true, 0>(F.lds + RING_OFF, g, S, E, F.tid); }
            else pg8::gemm_phase<pg8::EpiSwiglu<FP8D>, pg8::StaticOrder, true, true, FP8F ? MXM : 0>(F.lds + RING_OFF, g, S, E, F.tid); }
        SEAM();
        for (int rep_ = 0; rep_ < NREP(7); ++rep_) if (PH_ON(7) && IN()) { FRESH(); LAYER_PTRS(); pg8::Gemm g{(const bf16*)(big + B_HB), (const bf16*)(ev + EV_WDN), MLAT, D, FP8D ? DFF / 2 : DFF, 0}; pg8::StaticOrder S; S.init(MLAT, D, F.G, F.bx, 1);
            pg8::EpiResid E{XS, mode + 5 * 1024, GS(7) * (FP8D ? WSC_INV : 1.0f)};
            pg8::gemm_phase<pg8::EpiResid, pg8::StaticOrder, true, true, FP8D ? MXM : 0>(F.lds + RING_OFF, g, S, E, F.tid);
            ctx_gemm<FP8D>(F, (const void*)(big + B_HB), (const void*)(ev + EV_WDN), FP8D ? DFF : 2 * DFF, D, CtxEpiResid{XS, mode + 4 * 6144 + 5 * 1024, GS(7) * (FP8D ? WSC_INV : 1.0f)}); }
        SEAM();
        for (int rep_ = 0; rep_ < NREP(8); ++rep_) if (PH_ON(8) && IN()) { FRESH(); LAYER_PTRS(); nm_phase(F, args, false, modo, 0, 1024); }
        SEAM();
        for (int rep_ = 0; rep_ < NREP(9); ++rep_) if (PH_ON(9) && IN()) { FRESH(); LAYER_PTRS(); pg8::Gemm g{H, (const bf16*)(od + OD_WCD), MLAT, CD_INP, D, 0}; pg8::StaticOrder S; S.init(MLAT, CD_INP, F.G, F.bx, 1);
            pg8::EpiZ<false> E{(bf16*)(big + B_Z), CD_INP, 0, 1.0f};
            pg8::gemm_phase<pg8::EpiZ<false>, pg8::StaticOrder, true, true>(F.lds + RING_OFF, g, S, E, F.tid);
            ctx_gemm<false>(F, H, (const bf16*)(od + OD_WCD), 2 * D, CD_INP, CtxEpiZ{(bf16*)(big + B_Z), CD_INP, 0}); }
        SEAM();
        for (int rep_ = 0; rep_ < NREP(10); ++rep_) if (PH_ON(10) && IN()) { FRESH();
              if (FP8M) { if (F.wave < 4) cdmid_phase(F, args, lp, F.vcu * 4 + F.wave, F.G * 4); else convert_moe(F, args, lp, F.vcu * 4 + (F.wave - 4), F.G * 4); }
              else { cdmid_phase(F, args, lp, F.vcu * NWAVES + F.wave, F.G * NWAVES); convert_moe(F, args, lp, F.vcu * NWAVES + F.wave, F.G * NWAVES); } }
        SEAM();
        for (int rep_ = 0; rep_ < NREP(11); ++rep_) if (PH_ON(11) && IN()) { FRESH(); LAYER_PTRS(); pg8::Gemm g{(const bf16*)(big + B_CQN), (const bf16*)(od + OD_WUQ), M, 768, 384, 0}; pg8::StaticOrder S; S.init(M, 768, F.G, F.bx);
              pg8::EpiQD E{(unsigned char*)(big + B_QD), (const float*)(ws + WS_ROPE)};
              pg8::gemm_phase<pg8::EpiQD, pg8::StaticOrder, true, true>(F.lds + RING_OFF, g, S, E, F.tid); }
        for (int rep_ = 0; rep_ < NREP(12); ++rep_) if (PH_ON(12) && IN()) { FRESH(); LAYER_PTRS(); pg8::Gemm g{(const bf16*)(big + B_CKVN), (const bf16*)(od + OD_WUKV), M, 1024, 256, 0}; pg8::StaticOrder S; S.init(M, 1024, F.G, F.bx);
              pg8::EpiKVD E{(unsigned char*)(big + B_KD), (bf16*)(big + B_VD)};
              pg8::gemm_phase<pg8::EpiKVD, pg8::StaticOrder, true, true>(F.lds + RING_OFF, g, S, E, F.tid); }
        SEAM();
        for (int rep_ = 0; rep_ < NREP(21); ++rep_) if (PH_ON(21) && IN()) { FRESH(); vtrans_phase(F); }
        SEAM();
        for (int rep_ = 0; rep_ < NREP(13); ++rep_) if (PH_ON(13) && IN()) { FRESH(); int b, h, qb;
            for (int i = 0; attn_deal(F.G, F.bx, i, 0, b, h, qb); ++i) attn_do_unit(F, 0, b, h, qb); }
        for (int rep_ = 0; rep_ < NREP(14); ++rep_) if (PH_ON(14) && IN()) { FRESH(); int b, h, qb;
            for (int i = 0; attn_deal(F.G, F.bx, i, 32, b, h, qb); ++i) attn_do_unit(F, 1, b, h, qb); }
        SEAM();
        for (int rep_ = 0; rep_ < NREP(15); ++rep_) if (PH_ON(15) && IN()) { FRESH(); LAYER_PTRS(); pg8::Gemm g{(const bf16*)(big + B_Y), (const bf16*)(od + OD_WCDO), MLAT, D, D, 0}; pg8::StaticOrder S; S.init(MLAT, D, F.G, F.bx, 1);
            pg8::EpiResid E{XS, modo + 2 * 1024, GS(15)};
            pg8::gemm_phase<pg8::EpiResid, pg8::StaticOrder, true, true>(F.lds + RING_OFF, g, S, E, F.tid);
            ctx_gemm<false>(F, (const bf16*)(big + B_Y), (const bf16*)(od + OD_WCDO), 2 * D, D, CtxEpiResid{XS, modo + 4 * 6144 + 2 * 1024, GS(15)}); }
        SEAM();
        for (int rep_ = 0; rep_ < NREP(16); ++rep_) if (PH_ON(16) && IN()) { FRESH(); LAYER_PTRS(); route_phase(F, args, lp, modo); }
        SEAM();
        for (int rep_ = 0; rep_ < NREP(17); ++rep_) if (PH_ON(17) && IN()) { FRESH(); LAYER_PTRS(); slots_phase(F, args, modo); }
        SEAM();
        for (int rep_ = 0; rep_ < NREP(18); ++rep_) if (PH_ON(18) && IN()) { FRESH(); const unsigned* pexp = (const unsigned*)(ws + WS_PEXP);
            const int npan = __builtin_amdgcn_readfirstlane((int)__hip_atomic_load(pexp + 511, __ATOMIC_RELAXED, __HIP_MEMORY_SCOPE_AGENT));
            pg8::Gemm g{(const bf16*)(big + B_HS), (const bf16*)(ws + WS_WMOE), npan * 256, 2 * DFF, FP8M ? D / 2 : D, FP8M ? MOE_WGU8 : MOE_WGU}; pg8::MoeOrder S; S.init(npan, 2 * DFF, F.G, F.bx, pexp, F.lane);
            pg8::EpiSwiglu<FP8M> E{(bf16*)(big + B_HM), DFF, FP8M ? WSC_INV : 1.0f};
            pg8::gemm_phase<pg8::EpiSwiglu<FP8M>, pg8::MoeOrder, MOE_ALIGN, MOE_SP2, FP8M ? MXM : 0>(F.lds + RING_OFF, g, S, E, F.tid); }
        SEAM();
        for (int rep_ = 0; rep_ < NREP(19); ++rep_) if (PH_ON(19) && IN()) { FRESH(); const unsigned* pexp = (const unsigned*)(ws + WS_PEXP);
            const int npan = __builtin_amdgcn_readfirstlane((int)__hip_atomic_load(pexp + 511, __ATOMIC_RELAXED, __HIP_MEMORY_SCOPE_AGENT));
            pg8::Gemm g{(const bf16*)(big + B_HM), (const bf16*)(ws + WS_WMOE + (FP8M ? MOE_WDN_OFF8 : MOE_WDN_OFF)), npan * 256, D, FP8M ? DFF / 2 : DFF, FP8M ? MOE_WDN8 : MOE_WDN}; pg8::MoeOrder S; S.init(npan, D, F.G, F.bx, pexp, F.lane);
            pg8::EpiZ<false> E{(bf16*)(big + B_HS), D, 0, FP8M ? WSC_INV : 1.0f};
            pg8::gemm_phase<pg8::EpiZ<false>, pg8::MoeOrder, MOE_ALIGN, MOE_SP2, FP8M ? MXM : 0>(F.lds + RING_OFF, g, S, E, F.tid); }
        SEAM();
        for (int rep_ = 0; rep_ < NREP(20); ++rep_) if (PH_ON(20) && IN()) { FRESH(); LAYER_PTRS(); combine_phase(F, args, modo, lp == 1, MOD + (size_t)(2 * lp + 2 < 4 ? 2 * lp + 2 : 0) * 5 * 6144, (NREP(20) == 2 && rep_ == 0) ? 0.0f : 1.0f); }
        SEAM();
    }
    if (hi == N_PHASES) { if (__hip_atomic_load(barw + XB_TMO, __ATOMIC_RELAXED, __HIP_MEMORY_SCOPE_AGENT) != 0u) {
        const float q = __builtin_nanf("");
        const int tid_e = F0.wave * 64 + (int)__builtin_amdgcn_mbcnt_hi(~0u, __builtin_amdgcn_mbcnt_lo(~0u, 0u));
        for (size_t i = (size_t)blockIdx.x * (NWAVES * 64) + tid_e; i < (size_t)BATCH * SEQ * D; i += (size_t)F.G * NWAVES * 64) args_k.out[i] = q; } }
#undef IN
#undef SEAM
}

#ifndef HDP_N_LAUNCHES
#define HDP_N_LAUNCHES 1
#endif
extern "C" void kernel_launch(void* const* d_in, const int* in_sizes, int n_in, void* d_out, int out_size, void* d_ws, size_t ws_size, hipStream_t stream) {
    static int grid = 0;
    if (grid == 0) {
        int dev = 0, cus = 0;
        if (n_in != 29 || out_size != BATCH * SEQ * D || hipGetDevice(&dev) != hipSuccess || hipDeviceGetAttribute(&cus, hipDeviceAttributeMultiprocessorCount, dev) != hipSuccess) { fprintf(stderr, "kernel_launch: unexpected problem shape or device query failure\n"); grid = -1; }
        else if (hipFuncSetAttribute((const void*)hdp_fwd, hipFuncAttributeMaxDynamicSharedMemorySize, LDS_BYTES) != hipSuccess) { fprintf(stderr, "kernel_launch: hipFuncSetAttribute failed\n"); grid = -1; }
        else { int per_cu = 0; (void)hipOccupancyMaxActiveBlocksPerMultiprocessor(&per_cu, (const void*)hdp_fwd, NWAVES * 64, LDS_BYTES); (void)hipGetLastError();
            grid = (per_cu >= 1 && cus >= 32) ? cus : -1; if (grid > 1024) grid = 1024; }
    }
    if (grid < 0 || ws_size < WS_END) {
        (void)hipMemsetAsync(d_out, 0xFF, (size_t)out_size * 4, stream); return; }
    (void)hipMemsetAsync((char*)d_ws + WS_CTL, 0, CTL_ZERO_BYTES, stream);
    Args a{};
    for (int i = 0; i < 29; ++i) a.in[i] = (const float*)d_in[i];
    a.out = (float*)d_out; a.ws = (unsigned char*)d_ws;
#if HDP_N_LAUNCHES == 1
    a.ph_lo = 0; a.ph_hi = N_PHASES;
    hipLaunchKernelGGL(hdp_fwd, dim3(grid), dim3(NWAVES * 64), LDS_BYTES, stream, a);
#else
    for (int p = 0; p < N_PHASES; ++p) { a.ph_lo = p; a.ph_hi = p + 1; hipLaunchKernelGGL(hdp_fwd, dim3(grid), dim3(NWAVES * 64), LDS_BYTES, stream, a); }
#endif
}
```
